# Optimizing an MI355X kernel written in HIP

```python
import math
import jax, jax.numpy as jnp
from jax import lax
import numpy as np

D_MODEL = 1024
BATCH = 8
SEQ = 2048
DEPTH = 2

MIX_WIDTH = D_MODEL
M_HEADS = 4
M_HEAD_DIM = (MIX_WIDTH // 2) // M_HEADS
M_WIDTH = M_HEADS * M_HEAD_DIM
A_HEADS = 8
A_HEAD_DIM = (MIX_WIDTH - M_WIDTH) // A_HEADS
A_WIDTH = A_HEADS * A_HEAD_DIM
D_FF = 4 * D_MODEL
CONV_WIDTH = 5
M_CHUNK = 64
DILATED_PATTERNS = ((128, 1), (512, 4), (2048, 16))
BAND_BLOCK = 64
ROPE_THETA = 10000.0
NORM_EPS = 1e-6
NEG_INF = -1e30
IN_SPLITS = (M_WIDTH, M_WIDTH, M_WIDTH, M_WIDTH, 2 * M_HEADS, 2 * M_HEADS, A_WIDTH, A_WIDTH, A_WIDTH)
IN_WIDTH = 4 * M_WIDTH + 4 * M_HEADS + 3 * A_WIDTH

kernel_name = "hybrid_mlstm_dilated_attn_encoder"


def rms_norm(x, g):
    xf = x.astype(jnp.float32)
    y = xf * lax.rsqrt(jnp.mean(xf * xf, axis=-1, keepdims=True) + NORM_EPS)
    return (y * g.astype(jnp.float32)).astype(x.dtype)


def rope(t):
    S, D = t.shape[1], t.shape[-1]
    half = D // 2
    inv_freq = ROPE_THETA ** (-jnp.arange(half, dtype=jnp.float32) / half)
    ang = jnp.arange(S, dtype=jnp.float32)[:, None] * inv_freq[None, :]
    cos = jnp.cos(ang)[None, :, None, :]
    sin = jnp.sin(ang)[None, :, None, :]
    tf = t.astype(jnp.float32)
    t1, t2 = tf[..., :half], tf[..., half:]
    return jnp.concatenate([t1 * cos - t2 * sin, t1 * sin + t2 * cos], axis=-1)


def centred_depthwise_conv(x, w):
    K, C = w.shape
    return lax.conv_general_dilated(
        x, w[:, None, :], window_strides=(1,), padding=[(K // 2, K // 2)],
        dimension_numbers=("NWC", "WIO", "NWC"), feature_group_count=C)


def mlstm_chunkwise(q, k, v, li, lf):
    B, H, S, D = q.shape
    L = M_CHUNK
    NC = S // L
    q = q.reshape(B, H, NC, L, D)
    k = k.reshape(B, H, NC, L, D)
    v = v.reshape(B, H, NC, L, D)
    li = li.reshape(B, H, NC, L)
    lf = lf.reshape(B, H, NC, L)
    b = jnp.cumsum(lf, axis=-1)
    b_last = b[..., -1]
    g = b_last[..., None] - b + li
    g_max = jnp.max(g, axis=-1)

    def step(carry, inp):
        C, n, m = carry
        k_c, v_c, g_c, gmax_c, bl_c = inp
        m_new = jnp.maximum(bl_c + m, gmax_c)
        decay = jnp.exp(bl_c + m - m_new)
        w = jnp.exp(g_c - m_new[..., None])
        C_new = decay[..., None, None] * C + jnp.einsum("bhs,bhsk,bhsv->bhkv", w, k_c, v_c)
        n_new = decay[..., None] * n + jnp.einsum("bhs,bhsk->bhk", w, k_c)
        return (C_new, n_new, m_new), (C, n, m)

    init = (jnp.zeros((B, H, D, D), jnp.float32), jnp.zeros((B, H, D), jnp.float32),
            jnp.full((B, H), NEG_INF, jnp.float32))
    xs = (jnp.moveaxis(k, 2, 0), jnp.moveaxis(v, 2, 0), jnp.moveaxis(g, 2, 0),
          jnp.moveaxis(g_max, 2, 0), jnp.moveaxis(b_last, 2, 0))
    _, (C_prev, n_prev, m_prev) = lax.scan(step, init, xs)
    C_prev = jnp.moveaxis(C_prev, 0, 2)
    n_prev = jnp.moveaxis(n_prev, 0, 2)
    m_prev = jnp.moveaxis(m_prev, 0, 2)

    a = b + m_prev[..., None]
    lower = jnp.tril(jnp.ones((L, L), dtype=bool))
    dmat = jnp.where(lower, b[..., :, None] - b[..., None, :] + li[..., None, :], NEG_INF)
    m_t = jnp.maximum(a, jnp.max(dmat, axis=-1))
    s = jnp.einsum("bhnqd,bhnkd->bhnqk", q, k) * jnp.exp(dmat - m_t[..., None])
    inter = jnp.exp(a - m_t)
    num = (jnp.einsum("bhnqk,bhnkd->bhnqd", s, v)
           + inter[..., None] * jnp.einsum("bhnqk,bhnkv->bhnqv", q, C_prev))
    den = jnp.sum(s, axis=-1) + inter * jnp.einsum("bhnqk,bhnk->bhnq", q, n_prev)
    h = num / jnp.maximum(jnp.abs(den), jnp.exp(-m_t))[..., None]
    return h.reshape(B, H, S, D)


def strided_band_attention(q, k, v, dilation, half):
    B, H, S, D = q.shape
    L = S // dilation
    qb_len = math.gcd(L, BAND_BLOCK)
    nb = L // qb_len
    span = qb_len + 2 * half

    def to_strided(t):
        return t.reshape(B, H, L, dilation, D).transpose(0, 1, 3, 2, 4)

    qs = to_strided(q).reshape(B, H, dilation, nb, qb_len, D)
    pad = ((0, 0), (0, 0), (0, 0), (half, half), (0, 0))
    kp = jnp.pad(to_strided(k), pad)
    vp = jnp.pad(to_strided(v), pad)
    idx = (jnp.arange(nb) * qb_len)[:, None] + jnp.arange(span)[None, :]
    kb = kp[:, :, :, idx, :]
    vb = vp[:, :, :, idx, :]
    qpos = (jnp.arange(nb) * qb_len)[:, None, None] + jnp.arange(qb_len)[None, :, None]
    kpos = idx[:, None, :] - half
    valid = (jnp.abs(kpos - qpos) <= half) & (kpos >= 0) & (kpos < L)
    s = jnp.einsum("bhrnqd,bhrnkd->bhrnqk", qs, kb) * (1.0 / math.sqrt(D))
    s = jnp.where(valid, s, NEG_INF)
    m = jnp.max(s, axis=-1)
    p = jnp.exp(s - m[..., None])
    l = jnp.sum(p, axis=-1)
    o = jnp.einsum("bhrnqk,bhrnkd->bhrnqd", p, vb) / l[..., None]

    def from_strided(t):
        tail = t.shape[5:]
        t = jnp.moveaxis(t.reshape((B, H, dilation, L) + tail), 2, 3)
        return t.reshape((B, H, S) + tail)

    return from_strided(o), from_strided(m), from_strided(l)


def dilated_attention(q, k, v):
    outs = [strided_band_attention(q, k, v, d, w // (2 * d)) for (w, d) in DILATED_PATTERNS]
    m_all = jnp.max(jnp.stack([m for (_, m, _) in outs]), axis=0)
    weights = [l * jnp.exp(m - m_all) for (_, m, l) in outs]
    num = sum(w[..., None] * o for w, (o, _, _) in zip(weights, outs))
    return num / sum(weights)[..., None]


def hybrid_layer(x, norm1_g, w_in, conv_w, gate_i_b, gate_f_b, head_norm_g, w_out,
                 norm2_g, w_up, w_down):
    B, S, _ = x.shape
    h = rms_norm(x, norm1_g)
    proj = h @ w_in
    mq, mk, mv, mo, mi, mf, aq, ak, av = jnp.split(
        proj, list(np.cumsum(IN_SPLITS)[:-1]), axis=-1)

    qk = jax.nn.silu(centred_depthwise_conv(jnp.concatenate([mq, mk], axis=-1), conv_w))
    mq, mk = qk[..., :M_WIDTH], qk[..., M_WIDTH:]

    def m_heads(t):
        return t.reshape(B, S, M_HEADS, M_HEAD_DIM).transpose(0, 2, 1, 3).astype(jnp.float32)

    q_m = m_heads(mq)
    k_m = m_heads(mk) * (1.0 / math.sqrt(M_HEAD_DIM))
    v_m = m_heads(mv)
    gi = (mi + gate_i_b).astype(jnp.float32).reshape(B, S, 2, M_HEADS).transpose(2, 0, 3, 1)
    gf = jax.nn.log_sigmoid((mf + gate_f_b).astype(jnp.float32)).reshape(
        B, S, 2, M_HEADS).transpose(2, 0, 3, 1)
    h_fwd = mlstm_chunkwise(q_m, k_m, v_m, gi[0], gf[0])
    flip = lambda t: jnp.flip(t, axis=2)
    h_bwd = flip(mlstm_chunkwise(flip(q_m), flip(k_m), flip(v_m), flip(gi[1]), flip(gf[1])))
    hm = h_fwd + h_bwd
    hm = hm * lax.rsqrt(jnp.mean(hm * hm, axis=-1, keepdims=True) + NORM_EPS)
    hm = hm.transpose(0, 2, 1, 3).reshape(B, S, M_WIDTH) * head_norm_g.astype(jnp.float32)
    y_m = (hm * jax.nn.sigmoid(mo.astype(jnp.float32))).astype(x.dtype)

    def a_heads(t, rotate):
        t = t.reshape(B, S, A_HEADS, A_HEAD_DIM)
        t = rope(t) if rotate else t.astype(jnp.float32)
        return t.transpose(0, 2, 1, 3)

    o_a = dilated_attention(a_heads(aq, True), a_heads(ak, True), a_heads(av, False))
    y_a = o_a.transpose(0, 2, 1, 3).reshape(B, S, A_WIDTH).astype(x.dtype)

    x = x + jnp.concatenate([y_m, y_a], axis=-1) @ w_out

    u = jax.nn.relu(rms_norm(x, norm2_g) @ w_up)
    return x + (u * u) @ w_down


def setup_inputs(seed: int = 0) -> dict:
    key = jax.random.key(seed)
    ks = jax.random.split(key, 13)
    f32 = jnp.float32
    nrm = lambda k, shape: jax.random.normal(k, shape, f32)
    x = nrm(ks[0], (BATCH, SEQ, D_MODEL))
    norm1_g = 1.0 + 0.02 * nrm(ks[1], (DEPTH, D_MODEL))
    w_in = nrm(ks[2], (DEPTH, D_MODEL, IN_WIDTH)) * D_MODEL ** -0.5
    conv_w = nrm(ks[3], (DEPTH, CONV_WIDTH, 2 * M_WIDTH)) * CONV_WIDTH ** -0.5
    gate_i_b = 0.1 * nrm(ks[4], (DEPTH, 2 * M_HEADS))
    gate_f_b = (jnp.tile(jnp.linspace(3.0, 6.0, M_HEADS, dtype=f32), 2)[None, :]
                + 0.1 * nrm(ks[5], (DEPTH, 2 * M_HEADS)))
    head_norm_g = 1.0 + 0.02 * nrm(ks[6], (DEPTH, M_WIDTH))
    w_out = nrm(ks[7], (DEPTH, MIX_WIDTH, D_MODEL)) * MIX_WIDTH ** -0.5
    norm2_g = 1.0 + 0.02 * nrm(ks[8], (DEPTH, D_MODEL))
    w_up = nrm(ks[9], (DEPTH, D_MODEL, D_FF)) * D_MODEL ** -0.5
    w_down = nrm(ks[10], (DEPTH, D_FF, D_MODEL)) * D_FF ** -0.5
    final_g = 1.0 + 0.02 * nrm(ks[11], (D_MODEL,))
    return {"x": x, "norm1_g": norm1_g, "w_in": w_in, "conv_w": conv_w,
            "gate_i_b": gate_i_b, "gate_f_b": gate_f_b, "head_norm_g": head_norm_g,
            "w_out": w_out, "norm2_g": norm2_g, "w_up": w_up, "w_down": w_down,
            "final_g": final_g}


def reference(x, norm1_g, w_in, conv_w, gate_i_b, gate_f_b, head_norm_g, w_out,
              norm2_g, w_up, w_down, final_g):
    for layer in range(DEPTH):
        x = hybrid_layer(x, norm1_g[layer], w_in[layer], conv_w[layer], gate_i_b[layer],
                         gate_f_b[layer], head_norm_g[layer], w_out[layer], norm2_g[layer],
                         w_up[layer], w_down[layer])
    return rms_norm(x, final_g)
```

```cpp
#include <hip/hip_runtime.h>
#include <hip/hip_cooperative_groups.h>
#include <cstdio>
#include <cstdint>
#include <cmath>
namespace cg = cooperative_groups;
namespace pg8 {
#define PG8_LAS __attribute__((address_space(3)))
typedef unsigned short bf16_t;
typedef short bf16x8 __attribute__((ext_vector_type(8)));
typedef float f32x4 __attribute__((ext_vector_type(4)));
typedef unsigned u32x4 __attribute__((ext_vector_type(4)));
constexpr int BM = 256, BK = 64, HALF = 128, HTB = HALF * BK * 2  , STAGE_BYTES = 8 * HTB, NXCD = 8, WGM = 8;

__host__ __device__ __forceinline__ int lds_byte(int r, int c) { const int st = (r >> 4) * 2 + (c >> 5), rr = r & 15, cc = c & 31, ob = rr * 64 + cc * 2; return st * 1024 + (ob ^ (((ob >> 9) & 1) << 5)); }
__host__ __device__ __forceinline__ void stage_rc(int b, int& R, int& C) { const int st = b / 1024, sb = b % 1024, swz = sb ^ (((sb >> 9) & 1) << 5); R = (st >> 1) * 16 + swz / 64; C = (st & 1) * 32 + (swz % 64) / 2; }
__host__ __device__ __forceinline__ int perm32(int rho) { const int n = rho >> 4, i = rho & 15; return 8 * (i >> 2) + 4 * n + (i & 3); }

struct Unit { int pm, pn; };
struct Gemm { const bf16_t* A; const bf16_t* Bt; int M, N, K; };

struct StaticOrder {
    int nM, nN, nwg, G, c;
    __host__ __device__ void init(int M, int N, int G_, int c_) { nM = M / BM; nN = N / BM; nwg = nM * nN; G = G_; c = c_; }
    __host__ __device__ bool next(int i, Unit& u) const {
        const long L = (long)i * G + c; if (L >= nwg) return false;
        int wgid = (int)L; { const int q = nwg / NXCD, r = nwg % NXCD, xcd = wgid % NXCD, off = wgid / NXCD; wgid = (xcd < r ? xcd * (q + 1) : r * (q + 1) + (xcd - r) * q) + off; }
        const int nig = WGM * nN, gid = wgid / nig, fm = gid * WGM, gsz = (nM - fm) < WGM ? (nM - fm) : WGM;
        u.pm = fm + ((wgid % nig) % gsz); u.pn = (wgid % nig) / gsz; return true;
    }
    __device__ __forceinline__ void a_ready(const Unit&) const {}
    __device__ __forceinline__ void done(const Unit&) const {}
};

typedef float f32x2c_t __attribute__((ext_vector_type(2))); typedef __bf16 bf16x2c_t __attribute__((ext_vector_type(2)));
__device__ __forceinline__ unsigned cvt_pk_bf16(float lo, float hi) { f32x2c_t v = {lo, hi}; bf16x2c_t b = __builtin_convertvector(v, bf16x2c_t); return __builtin_bit_cast(unsigned, b); }
typedef float f32x2 __attribute__((ext_vector_type(2)));
__device__ __forceinline__ unsigned short bf16_1(float v) { return (unsigned short)(cvt_pk_bf16(v, v) & 0xffffu); }
__device__ __forceinline__ float row_ss(const float* ssp, int row) { const f32x4* q = (const f32x4*)(ssp + (size_t)row * 16); const f32x4 a = q[0], b = q[1], c = q[2], d = q[3];
    return (((a[0] + a[1]) + (a[2] + a[3])) + ((b[0] + b[1]) + (b[2] + b[3]))) + (((c[0] + c[1]) + (c[2] + c[3])) + ((d[0] + d[1]) + (d[2] + d[3]))); }
__device__ __forceinline__ float row_ss_q(const float* ssp, int row, int fq) { const f32x4 a = *(const f32x4*)(ssp + (size_t)row * 16 + 4 * fq); float t = (a[0] + a[1]) + (a[2] + a[3]);
    t += __shfl_xor(t, 16); t += __shfl_xor(t, 32); return t; }
struct EpiIn {
    static constexpr bool PERM = true, AFTER_DRAIN = false;
    const float* ss; unsigned char* ws; const float* gib; const float* gfb;
    static constexpr size_t O_ROPE = 512 * 1024, O_G = 3u << 20, O_QKM = 120u << 20, O_KTM = 152u << 20, O_VTM = 168u << 20, O_AK = 184u << 20, O_VT16 = 200u << 20, O_Y = 216u << 20;
    __device__ __forceinline__ void operator()(const f32x4 (&acc)[2][2][4][2], const Unit& u, int wr, int wc, int fr_, int fq_) const {
        int fr = fr_, fq = fq_; asm volatile("" : "+v"(fr), "+v"(fq));
        const int pn = u.pn;
        const int rbase = u.pm * BM + wr * 64 + fr;
        float rsv[2][4];
#pragma unroll
        for (int ai = 0; ai < 2; ++ai)
#pragma unroll
            for (int m = 0; m < 4; ++m) rsv[ai][m] = row_ss_q(ss, rbase + ai * HALF + m * 16, fq);
#pragma unroll
        for (int ai = 0; ai < 2; ++ai)
#pragma unroll
            for (int m = 0; m < 4; ++m) rsv[ai][m] = rsqrtf(rsv[ai][m] * (1.0f / 1024.0f) + 1e-6f);
        if (pn < 4) {
            bf16_t* QKm = (bf16_t*)(ws + O_QKM);
#pragma unroll
            for (int ai = 0; ai < 2; ++ai)
#pragma unroll
                for (int m = 0; m < 4; ++m) { const int row = rbase + ai * HALF + m * 16; const float r = rsv[ai][m]; bf16_t* rowp = QKm + (size_t)row * 1024 + pn * 256 + wc * 32 + 8 * fq;
#pragma unroll
                    for (int bj = 0; bj < 2; ++bj) { const f32x4 v0 = acc[ai][bj][m][0] * r, v1 = acc[ai][bj][m][1] * r; u32x4 w;
                        w.x = cvt_pk_bf16(v0[0], v0[1]); w.y = cvt_pk_bf16(v0[2], v0[3]); w.z = cvt_pk_bf16(v1[0], v1[1]); w.w = cvt_pk_bf16(v1[2], v1[3]);
                        *(u32x4*)(rowp + bj * HALF) = w; }
                    asm volatile("" ::: "memory"); }
        }
        if ((pn >= 2 && pn < 6)) {
            const int row0 = u.pm * BM; const int b = row0 >> 11;
            unsigned char* ub = ws + ((pn < 4) ? O_KTM : O_VTM) + ((size_t)(((b * 4 + 2 * (pn & 1)) * 128 + wc * 32) * 2048 + (row0 & 2047) + wr * 64)) * 2;
            const unsigned voff = (unsigned)((8 * fq) * 2048 + fr) * 2u;
#pragma unroll
            for (int ai = 0; ai < 2; ++ai)
#pragma unroll
                for (int m = 0; m < 4; m += 2) { const float r0 = rsv[ai][m], r1 = rsv[ai][m + 1];
#pragma unroll
                    for (int bj = 0; bj < 2; ++bj)
#pragma unroll
                        for (int n = 0; n < 2; ++n)
#pragma unroll
                            for (int j = 0; j < 4; ++j) { const unsigned w = cvt_pk_bf16(acc[ai][bj][m][n][j] * r0, acc[ai][bj][m + 1][n][j] * r1);
                                unsigned char* q = ub + (size_t)(((bj * 128 + 4 * n + j) * 2048 + ai * HALF + m * 16) * 2) + voff;
                                *(bf16_t*)q = (bf16_t)(w & 0xffffu); *(bf16_t*)(q + 32) = (bf16_t)(w >> 16); }
                    asm volatile("" ::: "memory"); }
        } else if (pn == 6 || pn == 7) {
            bf16_t* Y = (bf16_t*)(ws + O_Y);
#pragma unroll
            for (int ai = 0; ai < 2; ++ai)
#pragma unroll
                for (int m = 0; m < 4; ++m) { const int row = rbase + ai * HALF + m * 16; const float r = rsv[ai][m]; bf16_t* rowp = Y + (size_t)row * 1024 + (pn - 6) * 256 + wc * 32 + 8 * fq;
#pragma unroll
                    for (int bj = 0; bj < 2; ++bj) { f32x4 v0 = acc[ai][bj][m][0] * r, v1 = acc[ai][bj][m][1] * r;
#pragma unroll
                        for (int j = 0; j < 4; ++j) { v0[j] = __builtin_amdgcn_rcpf(1.0f + __expf(-v0[j])); v1[j] = __builtin_amdgcn_rcpf(1.0f + __expf(-v1[j])); }
                        u32x4 w; w.x = cvt_pk_bf16(v0[0], v0[1]); w.y = cvt_pk_bf16(v0[2], v0[3]); w.z = cvt_pk_bf16(v1[0], v1[1]); w.w = cvt_pk_bf16(v1[2], v1[3]);
                        *(u32x4*)(rowp + bj * HALF) = w; }
                    asm volatile("" ::: "memory"); }
        } else if (pn >= 8 && pn < 12) {
            const bool isk = pn >= 10; const int head = 4 * (pn & 1) + wc; const float qs = isk ? 1.0f : 0.125f * 1.4426950408889634f;
            const float* ropeC = (const float*)(ws + O_ROPE) + 8 * fq; const float* ropeS = ropeC + 2048 * 32;
            f32x4 tb[2][4];
            { const int pos = rbase & 2047; tb[0][0] = *(const f32x4*)(ropeC + pos * 32); tb[0][1] = *(const f32x4*)(ropeC + pos * 32 + 4); tb[0][2] = *(const f32x4*)(ropeS + pos * 32); tb[0][3] = *(const f32x4*)(ropeS + pos * 32 + 4); }
#pragma unroll
            for (int it = 0; it < 8; ++it) { const int ai = it >> 2, m = it & 3; const int row = rbase + ai * HALF + m * 16; const float r = rsv[ai][m] * qs;
                if (it < 7) { const int pos2 = (rbase + ((it + 1) >> 2) * HALF + ((it + 1) & 3) * 16) & 2047;
                    tb[(it + 1) & 1][0] = *(const f32x4*)(ropeC + pos2 * 32); tb[(it + 1) & 1][1] = *(const f32x4*)(ropeC + pos2 * 32 + 4); tb[(it + 1) & 1][2] = *(const f32x4*)(ropeS + pos2 * 32); tb[(it + 1) & 1][3] = *(const f32x4*)(ropeS + pos2 * 32 + 4); }
                const f32x4 c0 = tb[it & 1][0], c1 = tb[it & 1][1], s0 = tb[it & 1][2], s1 = tb[it & 1][3];
                const f32x4 a0 = acc[ai][0][m][0] * r, a1 = acc[ai][0][m][1] * r, b0 = acc[ai][1][m][0] * r, b1 = acc[ai][1][m][1] * r;
                const f32x4 o10 = a0 * c0 - b0 * s0, o11 = a1 * c1 - b1 * s1, o20 = a0 * s0 + b0 * c0, o21 = a1 * s1 + b1 * c1;
                bf16_t* dst = isk ? ((bf16_t*)(ws + O_AK) + (size_t)row * 512 + head * 64 + 8 * fq) : ((bf16_t*)(ws + O_Y) + (size_t)row * 1024 + 512 + head * 64 + 8 * fq);
                u32x4 w; w.x = cvt_pk_bf16(o10[0], o10[1]); w.y = cvt_pk_bf16(o10[2], o10[3]); w.z = cvt_pk_bf16(o11[0], o11[1]); w.w = cvt_pk_bf16(o11[2], o11[3]);
                *(u32x4*)(dst) = w;
                w.x = cvt_pk_bf16(o20[0], o20[1]); w.y = cvt_pk_bf16(o20[2], o20[3]); w.z = cvt_pk_bf16(o21[0], o21[1]); w.w = cvt_pk_bf16(o21[2], o21[3]);
                *(u32x4*)(dst + 32) = w;
                asm volatile("" ::: "memory"); }
        } else if (pn == 12 || pn == 13) {
            const int row0 = u.pm * BM; const int b = row0 >> 11;
            typedef unsigned u32x2v __attribute__((ext_vector_type(2)));
            unsigned char* ub = ws + O_VT16 + ((size_t)((((b * 8 + 4 * (pn - 12) + (wc >> 1)) * 16 * 32 + ((row0 & 2047) >> 6) + wr) * 256) + (wc & 1) * 128)) * 2;
            const unsigned voff = (unsigned)(fr * 32 * 256 + 8 * fq * 4) * 2u;
#pragma unroll
            for (int ai = 0; ai < 2; ++ai) { const float r0 = rsv[ai][0], r1 = rsv[ai][1], r2 = rsv[ai][2], r3 = rsv[ai][3];
#pragma unroll
                for (int bj = 0; bj < 2; ++bj)
#pragma unroll
                    for (int n = 0; n < 2; ++n)
#pragma unroll
                        for (int j = 0; j < 4; ++j) { u32x2v w; w.x = cvt_pk_bf16(acc[ai][bj][0][n][j] * r0, acc[ai][bj][1][n][j] * r1); w.y = cvt_pk_bf16(acc[ai][bj][2][n][j] * r2, acc[ai][bj][3][n][j] * r3);
                            *(u32x2v*)(ub + (size_t)((bj * 262144 + 2 * ai * 256 + (4 * n + j) * 4) * 2) + voff) = w; }
                asm volatile("" ::: "memory"); }
        } else if (pn == 14) {
            if (wc == 0 && fq < 2) {
                float* G = (float*)(ws + O_G);
#pragma unroll
                for (int ai = 0; ai < 2; ++ai)
#pragma unroll
                    for (int m = 0; m < 4; ++m) { const int row = rbase + ai * HALF + m * 16; const float r = rsv[ai][m];
#pragma unroll
                        for (int n = 0; n < 2; ++n) { f32x4 v = acc[ai][0][m][n] * r; f32x4 o;
#pragma unroll
                            for (int j = 0; j < 4; ++j) { const int c8 = 4 * n + j;
                                if (fq == 0) o[j] = v[j] + gib[c8];
                                else { const float x = v[j] + gfb[c8]; o[j] = fminf(x, 0.0f) - __logf(1.0f + __expf(-fabsf(x))); } }
                            *(f32x4*)(G + (size_t)row * 16 + 8 * fq + 4 * n) = o; }
                        asm volatile("" ::: "memory"); }
            }
        }
    }
};
struct EpiRes {
    static constexpr bool PERM = true, AFTER_DRAIN = false;
    bf16_t* xb; float* ssn;
    __device__ __forceinline__ void operator()(const f32x4 (&acc)[2][2][4][2], const Unit& u, int wr, int wc, int fr, int fq) const {
        const int col0 = u.pn * BM + wc * 32 + 8 * fq;
#pragma unroll
        for (int ai = 0; ai < 2; ++ai)
#pragma unroll
            for (int m = 0; m < 4; ++m) { const int row = u.pm * BM + ai * HALF + wr * 64 + m * 16 + fr; bf16_t* rp = xb + (size_t)row * 1024 + col0; float sq = 0.f;
#pragma unroll
                for (int bj = 0; bj < 2; ++bj) { const u32x4 b = *(const u32x4*)(rp + bj * HALF);
                    const f32x4 v0 = acc[ai][bj][m][0], v1 = acc[ai][bj][m][1];
                    const float o0 = __uint_as_float(b.x << 16) + v0[0], o1 = __uint_as_float(b.x & 0xffff0000u) + v0[1], o2 = __uint_as_float(b.y << 16) + v0[2], o3 = __uint_as_float(b.y & 0xffff0000u) + v0[3];
                    const float o4 = __uint_as_float(b.z << 16) + v1[0], o5 = __uint_as_float(b.z & 0xffff0000u) + v1[1], o6 = __uint_as_float(b.w << 16) + v1[2], o7 = __uint_as_float(b.w & 0xffff0000u) + v1[3];
                    u32x4 w; w.x = cvt_pk_bf16(o0, o1); w.y = cvt_pk_bf16(o2, o3); w.z = cvt_pk_bf16(o4, o5); w.w = cvt_pk_bf16(o6, o7);
                    *(u32x4*)(rp + bj * HALF) = w;
                    sq += ((o0 * o0 + o1 * o1) + (o2 * o2 + o3 * o3)) + ((o4 * o4 + o5 * o5) + (o6 * o6 + o7 * o7)); }
                sq += __shfl_xor(sq, 16); sq += __shfl_xor(sq, 32);
                if (fq == 0) ssn[(size_t)row * 16 + u.pn * 4 + wc] = sq; }
    }
};
struct EpiUp {
    static constexpr bool PERM = true, AFTER_DRAIN = false;
    const float* ss; bf16_t* U;
    __device__ __forceinline__ void operator()(const f32x4 (&acc)[2][2][4][2], const Unit& u, int wr, int wc, int fr, int fq) const {
        const int rbase = u.pm * BM + wr * 64 + fr;
        float rsv[2][4];
#pragma unroll
        for (int ai = 0; ai < 2; ++ai)
#pragma unroll
            for (int m = 0; m < 4; ++m) rsv[ai][m] = row_ss_q(ss, rbase + ai * HALF + m * 16, fq);
#pragma unroll
        for (int ai = 0; ai < 2; ++ai)
#pragma unroll
            for (int m = 0; m < 4; ++m) { const int row = rbase + ai * HALF + m * 16; const float r = rsqrtf(rsv[ai][m] * (1.0f / 1024.0f) + 1e-6f);
                bf16_t* rowp = U + (size_t)row * 4096 + u.pn * BM + wc * 32 + 8 * fq;
#pragma unroll
                for (int bj = 0; bj < 2; ++bj) { f32x4 v0 = acc[ai][bj][m][0] * r, v1 = acc[ai][bj][m][1] * r;
#pragma unroll
                    for (int j = 0; j < 4; ++j) { v0[j] = fmaxf(v0[j], 0.f); v0[j] *= v0[j]; v1[j] = fmaxf(v1[j], 0.f); v1[j] *= v1[j]; }
                    u32x4 w; w.x = cvt_pk_bf16(v0[0], v0[1]); w.y = cvt_pk_bf16(v0[2], v0[3]); w.z = cvt_pk_bf16(v1[0], v1[1]); w.w = cvt_pk_bf16(v1[2], v1[3]);
                    *(u32x4*)(rowp + bj * HALF) = w; } }
    }
};
template <class Epi, class Sched, bool ALIGN_EPI = false, bool SP2 = false>
__device__ __forceinline__ void gemm_phase(PG8_LAS unsigned char* lds, const Gemm g, const Sched& S, const Epi& E) {
    int tid_ = threadIdx.x; asm volatile("" : "+v"(tid_));
    const int tid = tid_, wid = __builtin_amdgcn_readfirstlane(tid >> 6), lane = tid & 63, wr = wid >> 2, wc = wid & 3, fr = lane & 15, fq = lane >> 4;
    const int K = g.K, nt = K / BK;
    unsigned voffA[2], voffB[2];
#pragma unroll
    for (int i = 0; i < 2; ++i) { int R, C; stage_rc(tid * 16 + i * 8192, R, C); const int Rb = Epi::PERM ? ((R & ~31) + perm32(R & 31)) : R;
        voffA[i] = (unsigned)(R * K + C) * 2u; voffB[i] = (unsigned)(Rb * K + C) * 2u; }
    const size_t kstep = (size_t)(BK * 2);
    const size_t hstep = (size_t)HALF * K * 2;
    const size_t tstep = 2 * hstep;
    const unsigned ldsw = (unsigned)wid * 1024u;
    const int aoff = lds_byte(wr * 64 + fr, fq * 8), boff = lds_byte(wc * 32 + fr, fq * 8);
#define PG8_SA(b, h) (((b) * 2 + (h)) * HTB)
#define PG8_SB(b, h) ((4 + (b) * 2 + (h)) * HTB)
#define PG8_STAGE(bufoff, gbase, voff) do { _Pragma("unroll") for (int _i = 0; _i < 2; ++_i) \
        __builtin_amdgcn_global_load_lds((const unsigned*)((const char*)(gbase) + (voff)[_i]), (PG8_LAS unsigned*)(lds + (bufoff) + ldsw + _i * 8192), 16, 0, 0); } while (0)
#define PG8_LDA(dst, b, h) do { _Pragma("unroll") for (int m = 0; m < 4; ++m) _Pragma("unroll") for (int k = 0; k < 2; ++k) dst[m][k] = *(const PG8_LAS bf16x8*)(lds + PG8_SA(b, h) + aoff + m * 2048 + k * 1024); } while (0)
#define PG8_LDB(dst, b, h) do { _Pragma("unroll") for (int n = 0; n < 2; ++n) _Pragma("unroll") for (int k = 0; k < 2; ++k) dst[n][k] = *(const PG8_LAS bf16x8*)(lds + PG8_SB(b, h) + boff + n * 2048 + k * 1024); } while (0)
#define PG8_MMA(ai, bj, At, Bt) do { __builtin_amdgcn_s_setprio(1); _Pragma("unroll") for (int m = 0; m < 4; ++m) _Pragma("unroll") for (int n = 0; n < 2; ++n) _Pragma("unroll") for (int k = 0; k < 2; ++k) \
        acc[ai][bj][m][n] = __builtin_amdgcn_mfma_f32_16x16x32_bf16(Bt[n][k], At[m][k], acc[ai][bj][m][n], 0, 0, 0); __builtin_amdgcn_s_setprio(0); } while (0)
#define PG8_WAIT_V(n) asm volatile("s_waitcnt vmcnt(" #n ")" ::: "memory")
#define PG8_WAIT_L(n) asm volatile("s_waitcnt lgkmcnt(" #n ")" ::: "memory")
#define PG8_BAR __builtin_amdgcn_s_barrier()
#define PG8_SCHED __builtin_amdgcn_sched_barrier(0)
    Unit cur, nxt; int ui = 0;
    if (!S.next(0, cur)) return;
    f32x4 acc[2][2][4][2];
#pragma unroll
    for (int a = 0; a < 2; ++a)
#pragma unroll
        for (int b = 0; b < 2; ++b)
#pragma unroll
            for (int m = 0; m < 4; ++m)
#pragma unroll
                for (int n = 0; n < 2; ++n) acc[a][b][m][n] = (f32x4){0.f, 0.f, 0.f, 0.f};
    bf16x8 At[4][2], B0[2][2], B1[2][2];
    const char* cA = (const char*)g.A + (size_t)cur.pm * tstep; const char* cB = (const char*)g.Bt + (size_t)cur.pn * tstep;
    S.a_ready(cur);
    if constexpr (SP2) {
        PG8_STAGE(PG8_SB(0, 0), cB, voffB); PG8_STAGE(PG8_SB(0, 1), cB + hstep, voffB); PG8_STAGE(PG8_SA(0, 0), cA, voffA); PG8_STAGE(PG8_SA(0, 1), cA + hstep, voffA);
        if (wr == 1) PG8_BAR;
        PG8_WAIT_V(2); PG8_BAR;
        PG8_STAGE(PG8_SB(1, 0), cB + kstep, voffB); PG8_STAGE(PG8_SA(1, 0), cA + kstep, voffA); PG8_STAGE(PG8_SB(1, 1), cB + hstep + kstep, voffB);
        PG8_WAIT_V(6); PG8_BAR;
    } else {
        PG8_STAGE(PG8_SB(0, 0), cB, voffB); PG8_STAGE(PG8_SA(0, 0), cA, voffA); PG8_STAGE(PG8_SB(0, 1), cB + hstep, voffB); PG8_STAGE(PG8_SA(0, 1), cA + hstep, voffA);
        if (wr == 1) PG8_BAR;
        PG8_WAIT_V(4); PG8_BAR;
        PG8_STAGE(PG8_SB(1, 0), cB + kstep, voffB); PG8_STAGE(PG8_SA(1, 0), cA + kstep, voffA); PG8_STAGE(PG8_SB(1, 1), cB + hstep + kstep, voffB);
        PG8_WAIT_V(6); PG8_BAR;
    }
    for (;;) {
        const bool has_next = S.next(ui + 1, nxt);
        const char* nA = has_next ? (const char*)g.A + (size_t)nxt.pm * tstep : cA; const char* nB = has_next ? (const char*)g.Bt + (size_t)nxt.pn * tstep : cB;
        for (int t = 0; t < nt; t += 2) {
            const bool last = (t == nt - 2);
            const char* a1 = cA + (size_t)(t + 1) * kstep;
            const char* a2 = last ? nA : cA + (size_t)(t + 2) * kstep; const char* b2 = last ? nB : cB + (size_t)(t + 2) * kstep;
            const char* a3 = a2 + kstep; const char* b3 = b2 + kstep;
            if (last && has_next) S.a_ready(nxt);
            if constexpr (SP2) {
            PG8_LDB(B0, 0, 0); PG8_LDB(B1, 0, 1); PG8_SCHED; PG8_LDA(At, 0, 0); PG8_STAGE(PG8_SA(1, 1), a1 + hstep, voffA);
            PG8_WAIT_V(8); PG8_WAIT_L(0); PG8_BAR; PG8_MMA(0, 0, At, B0); PG8_MMA(0, 1, At, B1); PG8_BAR; PG8_SCHED;
            PG8_LDA(At, 0, 1); PG8_STAGE(PG8_SB(0, 0), b2, voffB); PG8_STAGE(PG8_SB(0, 1), b2 + hstep, voffB); PG8_STAGE(PG8_SA(0, 0), a2, voffA);
            PG8_WAIT_V(8); PG8_WAIT_L(0); PG8_BAR; PG8_MMA(1, 0, At, B0); PG8_MMA(1, 1, At, B1); PG8_BAR; PG8_SCHED;
            PG8_LDB(B0, 1, 0); PG8_LDB(B1, 1, 1); PG8_SCHED; PG8_LDA(At, 1, 0); PG8_STAGE(PG8_SA(0, 1), a2 + hstep, voffA);
            PG8_WAIT_V(8); PG8_WAIT_L(0); PG8_BAR; PG8_MMA(0, 0, At, B0); PG8_MMA(0, 1, At, B1); PG8_BAR; PG8_SCHED;
            PG8_LDA(At, 1, 1); PG8_STAGE(PG8_SB(1, 0), b3, voffB); PG8_STAGE(PG8_SB(1, 1), b3 + hstep, voffB); PG8_STAGE(PG8_SA(1, 0), a3, voffA);
            PG8_WAIT_V(8); PG8_WAIT_L(0); PG8_BAR; PG8_MMA(1, 0, At, B0); PG8_MMA(1, 1, At, B1); PG8_BAR; PG8_SCHED;
            } else {
            PG8_LDB(B0, 0, 0); PG8_SCHED; PG8_LDA(At, 0, 0); PG8_STAGE(PG8_SA(1, 1), a1 + hstep, voffA);
            PG8_WAIT_L(8); PG8_BAR; PG8_WAIT_L(0); PG8_MMA(0, 0, At, B0); PG8_BAR; PG8_SCHED;
            PG8_LDB(B1, 0, 1); PG8_STAGE(PG8_SB(0, 0), b2, voffB);
            PG8_BAR; PG8_WAIT_L(0); PG8_MMA(0, 1, At, B1); PG8_BAR;
            PG8_LDA(At, 0, 1); PG8_STAGE(PG8_SA(0, 0), a2, voffA);
            PG8_BAR; PG8_WAIT_L(0); PG8_MMA(1, 0, At, B0); PG8_BAR; PG8_SCHED;
            PG8_STAGE(PG8_SB(0, 1), b2 + hstep, voffB);
            PG8_WAIT_V(6); PG8_BAR; PG8_MMA(1, 1, At, B1); PG8_BAR;
            PG8_LDB(B0, 1, 0); PG8_SCHED; PG8_LDA(At, 1, 0); PG8_STAGE(PG8_SA(0, 1), a2 + hstep, voffA);
            PG8_WAIT_L(8); PG8_BAR; PG8_WAIT_L(0); PG8_MMA(0, 0, At, B0); PG8_BAR; PG8_SCHED;
            PG8_LDB(B1, 1, 1); PG8_STAGE(PG8_SB(1, 0), b3, voffB);
            PG8_BAR; PG8_WAIT_L(0); PG8_MMA(0, 1, At, B1); PG8_BAR;
            PG8_LDA(At, 1, 1); PG8_STAGE(PG8_SA(1, 0), a3, voffA);
            PG8_BAR; PG8_WAIT_L(0); PG8_MMA(1, 0, At, B0); PG8_BAR; PG8_SCHED;
            PG8_STAGE(PG8_SB(1, 1), b3 + hstep, voffB);
            PG8_WAIT_V(6); PG8_BAR; PG8_MMA(1, 1, At, B1); PG8_BAR;
            }
        }
        if constexpr (ALIGN_EPI) { if (wr == 0) PG8_BAR; }
        if constexpr (!Epi::AFTER_DRAIN) { E(acc, cur, wr, wc, fr, fq); S.done(cur); }
        if (!has_next) break;
#pragma unroll
        for (int a = 0; a < 2; ++a)
#pragma unroll
            for (int b = 0; b < 2; ++b)
#pragma unroll
                for (int m = 0; m < 4; ++m)
#pragma unroll
                    for (int n = 0; n < 2; ++n) acc[a][b][m][n] = (f32x4){0.f, 0.f, 0.f, 0.f};
        cur = nxt; cA = nA; cB = nB; ++ui;
        if constexpr (ALIGN_EPI) { if (wr == 1) PG8_BAR; }
    }
    PG8_WAIT_V(0);
    if constexpr (!ALIGN_EPI) { if (wr == 0) PG8_BAR; }
    PG8_BAR;
    if constexpr (Epi::AFTER_DRAIN) { E.fused(acc, cur, wr, wc, fr, fq, lds, wid, lane); S.done(cur); }
#undef PG8_SA
#undef PG8_SB
#undef PG8_STAGE
#undef PG8_LDA
#undef PG8_LDB
#undef PG8_MMA
#undef PG8_WAIT_V
#undef PG8_WAIT_L
#undef PG8_BAR
#undef PG8_SCHED
}
}
#define LAS __attribute__((address_space(3)))
typedef unsigned short bf16;
typedef short bf16x8 __attribute__((ext_vector_type(8)));
typedef float f32x4 __attribute__((ext_vector_type(4)));
typedef unsigned u32x4 __attribute__((ext_vector_type(4)));
typedef unsigned u32x2 __attribute__((ext_vector_type(2)));
constexpr int SEQ = 2048, DM = 1024, MROWS = 16384, FF = 4096, NINP = 3840, NINL = 3600, NTHR = 512, NWAVE = 8;
constexpr size_t MiB = 1u << 20;
constexpr size_t WS_SS = 0, WS_ROPE = 512 * 1024, WS_N = 1 * MiB, WS_MST = 2 * MiB, WS_G = 3 * MiB;
constexpr size_t WS_WIN = 4 * MiB, WS_WOUT = 19 * MiB, WS_WUP = 23 * MiB, WS_WDN = 39 * MiB;
constexpr size_t WS_XB = 56 * MiB;
constexpr size_t WS_SSP = 88 * MiB;
constexpr size_t WS_P1O = 93 * MiB, WS_P1ML = 109 * MiB;
constexpr size_t WS_U = 120 * MiB;
constexpr size_t WS_QKM = 120 * MiB, WS_KTM = 152 * MiB, WS_VTM = 168 * MiB, WS_AK = 184 * MiB, WS_VT16 = 200 * MiB, WS_Y = 216 * MiB, WS_END = 248 * MiB;
constexpr size_t WS_CTL = 2 * MiB + 256 * 1024, CTL_BYTES = 16384;
constexpr int LDS_BYTES = 147456, LDS_MISC = 131072 + 320;

struct Params {
    const float *x, *norm1_g, *w_in, *conv_w, *gate_i_b, *gate_f_b, *head_norm_g, *w_out, *norm2_g, *w_up, *w_down, *final_g;
    float* out; unsigned char* ws;
};

__device__ __forceinline__ unsigned pk2(float lo, float hi) { return pg8::cvt_pk_bf16(lo, hi); }
__device__ __forceinline__ float bflo(unsigned w) { return __uint_as_float(w << 16); }
__device__ __forceinline__ float bfhi(unsigned w) { return __uint_as_float(w & 0xffff0000u); }
__device__ __forceinline__ float wave_sum(float v) {
#pragma unroll
    for (int o = 1; o < 64; o <<= 1) v += __shfl_xor(v, o);
    return v;
}
__device__ __forceinline__ float wave_max(float v) {
#pragma unroll
    for (int o = 1; o < 64; o <<= 1) v = fmaxf(v, __shfl_xor(v, o));
    return v;
}
__device__ __forceinline__ float wave_incl_scan(float v, int lane) {
#pragma unroll
    for (int o = 1; o < 64; o <<= 1) { const float t = __shfl_up(v, o); if (lane >= o) v += t; }
    return v;
}

#define DPP_STEP_ADD(v, ctrl, rm) do { const int t_ = __builtin_amdgcn_update_dpp(0, __float_as_int(v), (ctrl), (rm), 0xf, false); v += __int_as_float(t_); } while (0)
#define DPP_STEP_MAX(v, ctrl, rm) do { const int t_ = __builtin_amdgcn_update_dpp((int)0xff800000, __float_as_int(v), (ctrl), (rm), 0xf, false); v = fmaxf(v, __int_as_float(t_)); } while (0)
__device__ __forceinline__ float wave_incl_scan_dpp(float v) {
    DPP_STEP_ADD(v, 0x111, 0xf); DPP_STEP_ADD(v, 0x112, 0xf); DPP_STEP_ADD(v, 0x114, 0xf); DPP_STEP_ADD(v, 0x118, 0xf); DPP_STEP_ADD(v, 0x142, 0xa); DPP_STEP_ADD(v, 0x143, 0xc);
    return v;
}
__device__ __forceinline__ float wave_max_dpp(float v) {
    DPP_STEP_MAX(v, 0x111, 0xf); DPP_STEP_MAX(v, 0x112, 0xf); DPP_STEP_MAX(v, 0x114, 0xf); DPP_STEP_MAX(v, 0x118, 0xf); DPP_STEP_MAX(v, 0x142, 0xa); DPP_STEP_MAX(v, 0x143, 0xc);
    return __int_as_float(__builtin_amdgcn_readlane(__float_as_int(v), 63));
}
#define MFMA16(a, b, c) __builtin_amdgcn_mfma_f32_16x16x32_bf16((a), (b), (c), 0, 0, 0)

__device__ __forceinline__ int win_src_col(int nb, int& nvalid) {
    nvalid = 32;
    if (nb < 2048) return nb;
    if (nb < 3072) { int xx = nb - 2048; const int isk = xx >> 9; xx &= 511; const int T = xx >> 8, bj = (xx >> 7) & 1, hl = (xx >> 5) & 3; return 2064 + isk * 512 + 64 * (4 * T + hl) + 32 * bj; }
    if (nb < 3584) return 3088 + (nb - 3072);
    if (nb == 3584) { nvalid = 16; return 2048; }
    nvalid = 0; return 0;
}
__device__ __forceinline__ void transpose_item(const float* W, int K, int Nsrc, int src_col, int nvalid, const float* g, bf16* WT, int dst_row, int k0, LAS float* scr, int lane) {
    const int c = lane & 31;
    float wv[32];
#pragma unroll
    for (int i = 0; i < 32; ++i) { const int kk = 2 * i + (lane >> 5); wv[i] = (c < nvalid) ? W[(size_t)(k0 + kk) * Nsrc + src_col + c] : 0.f; }
    if (g) {
#pragma unroll
        for (int i = 0; i < 32; ++i) wv[i] *= g[k0 + 2 * i + (lane >> 5)]; }
#pragma unroll
    for (int i = 0; i < 32; ++i) scr[(2 * i + (lane >> 5)) * 33 + c] = wv[i];
    asm volatile("s_waitcnt lgkmcnt(0)" ::: "memory");
    const int ch = lane & 7;
#pragma unroll
    for (int j = 0; j < 4; ++j) { const int n = (lane >> 3) + 8 * j; const LAS float* s = scr + (8 * ch) * 33 + n;
        u32x4 o; o.x = pk2(s[0 * 33], s[1 * 33]); o.y = pk2(s[2 * 33], s[3 * 33]); o.z = pk2(s[4 * 33], s[5 * 33]); o.w = pk2(s[6 * 33], s[7 * 33]);
        *(u32x4*)(WT + (size_t)(dst_row + n) * K + k0 + 8 * ch) = o; }
    asm volatile("s_waitcnt lgkmcnt(0)" ::: "memory");
}
constexpr int I_IN = 16 * (NINP / 32), I_OUT = 16 * 32, I_UP = 16 * 128, I_DN = 64 * 32, I_L = I_IN + I_OUT + I_UP + I_DN;
__device__ __forceinline__ void convert_item(const Params& p, int it, LAS float* scr, int lane) {
    const int l = it / I_L; int r = it % I_L;
    if (r < I_IN) { const int nblk = NINP / 32, kb = r / nblk, nb = (r % nblk) * 32; int nv; const int sc = win_src_col(nb, nv);
        transpose_item(p.w_in + (size_t)l * DM * NINL, DM, NINL, sc, nv, p.norm1_g + l * DM, (bf16*)(p.ws + WS_WIN) + (size_t)l * NINP * DM, nb, kb * 64, scr, lane); return; }
    r -= I_IN;
    if (r < I_OUT) { const int kb = r / 32, nb = (r % 32) * 32;
        transpose_item(p.w_out + (size_t)l * DM * DM, DM, DM, nb, 32, nullptr, (bf16*)(p.ws + WS_WOUT) + (size_t)l * DM * DM, nb, kb * 64, scr, lane); return; }
    r -= I_OUT;
    if (r < I_UP) { const int kb = r / 128, nb = (r % 128) * 32;
        transpose_item(p.w_up + (size_t)l * DM * FF, DM, FF, nb, 32, p.norm2_g + l * DM, (bf16*)(p.ws + WS_WUP) + (size_t)l * FF * DM, nb, kb * 64, scr, lane); return; }
    r -= I_UP;
    { const int kb = r / 32, nb = (r % 32) * 32;
        transpose_item(p.w_down + (size_t)l * FF * DM, FF, DM, nb, 32, nullptr, (bf16*)(p.ws + WS_WDN) + (size_t)l * DM * FF, nb, kb * 64, scr, lane); }
}
__device__ __forceinline__ void p0_prologue(const Params& p, LAS unsigned char* lds, int wave, int lane, int G, int n_items) {
    LAS float* scr = (LAS float*)(lds + wave * 16384);
    const int gw = blockIdx.x * NWAVE + wave, NGW = G * NWAVE;
    if (n_items < 0) { constexpr int I_A = I_IN + I_OUT;
        for (int j = gw; j < 2 * I_A; j += NGW) convert_item(p, (j / I_A) * I_L + (j % I_A), scr, lane); }
    else for (int it = gw; it < n_items; it += NGW) convert_item(p, it, scr, lane);
    float* ss = (float*)(p.ws + WS_SSP); bf16* xb = (bf16*)(p.ws + WS_XB);
    for (int m0 = gw; m0 < MROWS; m0 += 2 * NGW) {
        f32x4 v[2][4];
#pragma unroll
        for (int q = 0; q < 2; ++q) { const int m = (m0 + q * NGW < MROWS) ? m0 + q * NGW : m0; const f32x4* xr = (const f32x4*)(p.x + (size_t)m * DM) + lane;
#pragma unroll
            for (int j = 0; j < 4; ++j) v[q][j] = xr[64 * j]; }
#pragma unroll
        for (int q = 0; q < 2; ++q) { const int m = m0 + q * NGW; if (m < MROWS) { float s = 0.f; u32x2* o8 = (u32x2*)(xb + (size_t)m * DM) + lane;
#pragma unroll
            for (int j = 0; j < 4; ++j) { const f32x4 t = v[q][j]; s += (t[0] * t[0] + t[1] * t[1]) + (t[2] * t[2] + t[3] * t[3]); u32x2 w; w.x = pk2(t[0], t[1]); w.y = pk2(t[2], t[3]); o8[64 * j] = w; }
            s = wave_sum(s); if (lane < 16) ss[(size_t)m * 16 + lane] = (lane == 0) ? s : 0.f; } }
    }
    const int gt = blockIdx.x * NTHR + threadIdx.x, NGT = G * NTHR;
    float* rc = (float*)(p.ws + WS_ROPE); float* rsn = rc + SEQ * 32;
    for (int i = gt; i < SEQ * 32; i += NGT) { const int pos = i >> 5, fi = i & 31;
        const float inv = exp2f(-(float)fi * (13.287712379549449f / 32.0f)); const float ang = (float)pos * inv;
        const float n = rintf(ang * 0.15915494309189535f); float rr = fmaf(-n, 6.2831854820251465f, ang); rr = fmaf(-n, -1.7484555e-7f, rr);
        rc[i] = __cosf(rr); rsn[i] = __sinf(rr); }
}

struct ScanLd { u32x4 kc[2]; unsigned kb[2], ka[2]; float li, lf; };
__device__ __forceinline__ void scan_load(ScanLd& L, const bf16* Krow, const bf16* Vrow, const float* Gp, int tok0, int fq, int lane, int gcol) {
    L.li = Gp[(size_t)(tok0 + lane) * 16 + gcol]; L.lf = Gp[(size_t)(tok0 + lane) * 16 + 8 + gcol];
#pragma unroll
    for (int ks = 0; ks < 2; ++ks) { const int base = tok0 + 32 * ks + 8 * fq;
        L.kc[ks] = *(const u32x4*)(Krow + base);
        L.kb[ks] = (base >= 2) ? *(const unsigned*)(Krow + base - 2) : 0u;
        L.ka[ks] = (base + 8 < SEQ) ? *(const unsigned*)(Krow + base + 8) : 0u; }
}
__device__ __forceinline__ void scan_wave(const Params& p, int layer, int sw, LAS float* wl, int lane, bool bar_mid) {
    const int ksl = sw & 7, dir = (sw >> 3) & 1, hh = (sw >> 4) & 3, b = sw >> 6;
    const int fr = lane & 15, fq = lane >> 4, kdim = 16 * ksl + fr;
    const float* cw = p.conv_w + (size_t)layer * 5 * 1024 + 512 + hh * 128 + kdim;
    float cwt[5];
#pragma unroll
    for (int t = 0; t < 5; ++t) cwt[t] = cw[t * 1024];
    const bf16* Krow = (const bf16*)(p.ws + WS_KTM) + ((size_t)((b * 4 + hh) * 128 + kdim)) * SEQ;
    const bf16* Vrow = (const bf16*)(p.ws + WS_VTM) + ((size_t)((b * 4 + hh) * 128 + fr)) * SEQ;
    const float* Gp = (const float*)(p.ws + WS_G) + (size_t)b * SEQ * 16;
    const int gcol = dir * 4 + hh;
    bf16* Ct = (bf16*)p.out; float* Nst = (float*)(p.ws + WS_N); float* Mst = (float*)(p.ws + WS_MST);
    const f32x4 z4 = {0.f, 0.f, 0.f, 0.f};
    f32x4 C[8], CN = z4; float mrun = -1e30f;
#pragma unroll
    for (int nt = 0; nt < 8; ++nt) C[nt] = z4;
    const bf16x8 ones = {0x3F80, 0x3F80, 0x3F80, 0x3F80, 0x3F80, 0x3F80, 0x3F80, 0x3F80};
    ScanLd cur, nxt;
    scan_load(cur, Krow, Vrow, Gp, (dir ? 31 : 0) * 64, fq, lane, gcol);
    for (int cs = 0; cs < 32; ++cs) {
        if (bar_mid && cs == 14) __syncthreads();
        const int pc = dir ? 31 - cs : cs;
        bf16x8 vv[8][2];
#pragma unroll
        for (int ks = 0; ks < 2; ++ks)
#pragma unroll
            for (int nt = 0; nt < 8; ++nt) vv[nt][ks] = *(const bf16x8*)(Vrow + (size_t)nt * 16 * SEQ + pc * 64 + 32 * ks + 8 * fq);
        if (cs + 1 < 32) scan_load(nxt, Krow, Vrow, Gp, (dir ? 30 - cs : cs + 1) * 64, fq, lane, gcol); else nxt = cur;
        const float pre = wave_incl_scan_dpp(cur.lf); const float total = __int_as_float(__builtin_amdgcn_readlane(__float_as_int(pre), 63));
        const float g = dir ? (pre - cur.lf + cur.li) : (total - pre + cur.li);
        const float gmax = wave_max_dpp(g);
        const float mn = fmaxf(total + mrun, gmax); const float decay = __expf(total + mrun - mn); const float w = __expf(g - mn);
        const size_t sidx = (size_t)((b * 4 + hh) * 2 + dir) * 32 + pc;
        { bf16* Cd = Ct + sidx * 16384 + (size_t)fr * 128 + 16 * ksl + 4 * fq;
#pragma unroll
          for (int nt = 0; nt < 8; ++nt) { u32x2 w0; w0.x = pk2(C[nt][0], C[nt][1]); w0.y = pk2(C[nt][2], C[nt][3]); *(u32x2*)(Cd + nt * 16 * 128) = w0; }
          if (fr == 0) *(f32x4*)(Nst + sidx * 128 + 16 * ksl + 4 * fq) = CN;
          if (ksl == 0 && lane == 0) Mst[sidx] = mrun; }
        wl[lane] = w;
        asm volatile("s_waitcnt lgkmcnt(0)" ::: "memory");
        bf16x8 afr[2];
#pragma unroll
        for (int ks = 0; ks < 2; ++ks) {
            const f32x4 wa = *(const LAS f32x4*)(wl + 32 * ks + 8 * fq), wb = *(const LAS f32x4*)(wl + 32 * ks + 8 * fq + 4);
            float r[12]; r[0] = bflo(cur.kb[ks]); r[1] = bfhi(cur.kb[ks]);
#pragma unroll
            for (int q = 0; q < 4; ++q) { r[2 + 2 * q] = bflo(cur.kc[ks][q]); r[3 + 2 * q] = bfhi(cur.kc[ks][q]); }
            r[10] = bflo(cur.ka[ks]); r[11] = bfhi(cur.ka[ks]);
            float o[8];
#pragma unroll
            for (int j = 0; j < 8; ++j) { float a = 0.f;
#pragma unroll
                for (int t = 0; t < 5; ++t) a = fmaf(cwt[t], r[j + t], a);
                a = a * __builtin_amdgcn_rcpf(1.0f + __expf(-a)); o[j] = a * 0.08838834764831845f * (j < 4 ? wa[j] : wb[j - 4]); }
            u32x4 pw; pw.x = pk2(o[0], o[1]); pw.y = pk2(o[2], o[3]); pw.z = pk2(o[4], o[5]); pw.w = pk2(o[6], o[7]);
            afr[ks] = __builtin_bit_cast(bf16x8, pw);
        }
        asm volatile("" ::: "memory");
        CN = CN * decay;
#pragma unroll
        for (int nt = 0; nt < 8; ++nt) { C[nt] = C[nt] * decay; C[nt] = MFMA16(afr[0], vv[nt][0], C[nt]); C[nt] = MFMA16(afr[1], vv[nt][1], C[nt]); }
        CN = MFMA16(afr[0], ones, CN); CN = MFMA16(afr[1], ones, CN);
        mrun = mn; cur = nxt;
    }
}

__device__ __forceinline__ void tile_par(int T, int f, int r, int L0, int& R, int& Lb, int& dsh) {
    if (T < 10) { dsh = 4; R = r; Lb = L0 - 64 + 16 * T + 4 * f; }
    else if (T < 22) { dsh = 2; R = 4 * f + (r & 3); Lb = L0 - 16 + 4 * (T - 10); }
    else { const int xx = T - 22; dsh = 0; R = 4 * (xx & 3) + f; Lb = L0 - 4 + 4 * (xx >> 2); }
}
template <int LIM> __device__ __forceinline__ void attn_step(f32x4 (&O)[4], float& mrun, float& lsum, const bf16x8 (&qf)[2], const bf16x8 k00, const bf16x8 k01, const bf16x8 k10, const bf16x8 k11,
                                                             const u32x2 (&v0)[4], const u32x2 (&v1)[4], int D0, int D1, bool ok0, bool ok1) {
    const f32x4 z4 = {0.f, 0.f, 0.f, 0.f};
    f32x4 s0 = MFMA16(k00, qf[0], z4); s0 = MFMA16(k01, qf[1], s0);
    f32x4 s1 = MFMA16(k10, qf[0], z4); s1 = MFMA16(k11, qf[1], s1);
    bool va[4], vb[4];
#pragma unroll
    for (int j = 0; j < 4; ++j) { va[j] = ok0 && ((unsigned)(D0 + 16 * j) <= (unsigned)(2 * LIM)); vb[j] = ok1 && ((unsigned)(D1 + 16 * j) <= (unsigned)(2 * LIM));
        s0[j] = va[j] ? s0[j] : -1e30f; s1[j] = vb[j] ? s1[j] : -1e30f; }
    float tm = fmaxf(fmaxf(fmaxf(s0[0], s0[1]), fmaxf(s0[2], s0[3])), fmaxf(fmaxf(s1[0], s1[1]), fmaxf(s1[2], s1[3])));
    tm = fmaxf(tm, __shfl_xor(tm, 16)); tm = fmaxf(tm, __shfl_xor(tm, 32));
    const float mn = fmaxf(mrun, tm);
    if (__any(mn > mrun)) { const float sc = __builtin_amdgcn_exp2f(mrun - mn); lsum *= sc;
#pragma unroll
        for (int d = 0; d < 4; ++d) O[d] = O[d] * sc; }
    mrun = mn;
    float pv[8]; float ps = 0.f;
#pragma unroll
    for (int j = 0; j < 4; ++j) { pv[j] = va[j] ? __builtin_amdgcn_exp2f(s0[j] - mn) : 0.f; pv[4 + j] = vb[j] ? __builtin_amdgcn_exp2f(s1[j] - mn) : 0.f; ps += pv[j] + pv[4 + j]; }
    lsum += ps;
    u32x4 pw; pw.x = pk2(pv[0], pv[1]); pw.y = pk2(pv[2], pv[3]); pw.z = pk2(pv[4], pv[5]); pw.w = pk2(pv[6], pv[7]);
    const bf16x8 pb = __builtin_bit_cast(bf16x8, pw);
#pragma unroll
    for (int d = 0; d < 4; ++d) { u32x4 vw; vw.x = v0[d].x; vw.y = v0[d].y; vw.z = v1[d].x; vw.w = v1[d].y; O[d] = MFMA16(__builtin_bit_cast(bf16x8, vw), pb, O[d]); }
}
#define KLD(ptr, lo, hi) do { lo = *(const bf16x8*)(ptr); hi = *(const bf16x8*)((ptr) + 32); } while (0)
#define VLD(ptr, v) do { _Pragma("unroll") for (int d_ = 0; d_ < 4; ++d_) v[d_] = *(const u32x2*)((ptr) + d_ * 64); } while (0)
__device__ __forceinline__ void attn_pair(const Params& p, int b, int h, int p0, int r0, int lane) {
    const int fr = lane & 15, fq = lane >> 4, fK = fr >> 2, jK = fr & 3; const int L0 = p0 >> 4;
    const f32x4 z4 = {0.f, 0.f, 0.f, 0.f};
    bf16* Yrow[2]; bf16x8 qf[2][2]; f32x4 O[2][4]; float mrun[2], lsum[2];
    const bf16* Kb = (const bf16*)(p.ws + WS_AK) + (ptrdiff_t)b * SEQ * 512 + h * 64 + 8 * fq;
    const bf16* Vb = (const bf16*)(p.ws + WS_VT16) + (ptrdiff_t)(b * 8 + h) * 131072 + fr * 4;
#pragma unroll
    for (int u = 0; u < 2; ++u) { const int pq = p0 + 16 * fr + r0 + 4 * u; Yrow[u] = (bf16*)(p.ws + WS_Y) + ((size_t)(b * SEQ + pq)) * 1024 + 512 + h * 64;
        qf[u][0] = *(const bf16x8*)(Yrow[u] + 8 * fq); qf[u][1] = *(const bf16x8*)(Yrow[u] + 32 + 8 * fq); mrun[u] = -1e30f; lsum[u] = 0.f;
#pragma unroll
        for (int d = 0; d < 4; ++d) O[u][d] = z4; }
    {
        const bf16* kp = Kb + (ptrdiff_t)(16 * (L0 - 64 + 4 * fK + jK) + r0) * 512;
        const bf16* vp = Vb + (ptrdiff_t)(r0 * 32 + (L0 >> 2) - 16 + fq) * 256;
        for (int pp = 0; pp < 5; ++pp) { const int T0 = 2 * pp; const int lq = L0 - 64 + 16 * T0;
            if (lq + 31 < 0 || lq >= 128) continue;
            const int D0 = 16 * (-64 + 16 * T0 + 4 * fq - fr) + 1024; const bool ok0 = (unsigned)(lq + 4 * fq) < 128u, ok1 = (unsigned)(lq + 16 + 4 * fq) < 128u;
            const bf16* k0p = kp + (ptrdiff_t)T0 * 256 * 512; const bf16* v0p = vp + (ptrdiff_t)T0 * 4 * 256;
#pragma unroll
            for (int u = 0; u < 2; ++u) { bf16x8 k00, k01, k10, k11; u32x2 v0[4], v1[4];
                KLD(k0p + u * 4 * 512, k00, k01); VLD(v0p + u * 4 * 32 * 256, v0);
                if (pp < 4) { KLD(k0p + u * 4 * 512 + 256 * 512, k10, k11); VLD(v0p + u * 4 * 32 * 256 + 4 * 256, v1); }
                else { k10 = k00; k11 = k01;
#pragma unroll
                    for (int d_ = 0; d_ < 4; ++d_) v1[d_] = v0[d_]; }
                attn_step<1024>(O[u], mrun[u], lsum[u], qf[u], k00, k01, k10, k11, v0, v1, D0, D0 + 256, ok0, ok1 && (pp < 4)); }
        }
    }
    {
        const bf16* kp = Kb + (ptrdiff_t)(16 * (L0 - 16 + jK) + 4 * fK + (r0 & 3)) * 512;
        const bf16* vp = Vb + (ptrdiff_t)((4 * fq + (r0 & 3)) * 32 + (L0 >> 2) - 4) * 256;
        for (int pp = 0; pp < 6; ++pp) { const int T0 = 2 * pp; const int lb = L0 - 16 + 4 * T0;
            const bool ok0 = (unsigned)lb < 128u, ok1 = (unsigned)(lb + 4) < 128u; if (!ok0 && !ok1) continue;
            const int D0 = 16 * (-16 + 4 * T0 - fr) + 4 * fq - (r0 & ~3) + 256;
            const bf16* k0p = kp + (ptrdiff_t)T0 * 64 * 512; const bf16* v0p = vp + (ptrdiff_t)T0 * 256;
            { bf16x8 k00, k01, k10, k11; u32x2 v0[4], v1[4];
                KLD(k0p, k00, k01); KLD(k0p + 64 * 512, k10, k11); VLD(v0p, v0); VLD(v0p + 256, v1);
                attn_step<256>(O[0], mrun[0], lsum[0], qf[0], k00, k01, k10, k11, v0, v1, D0, D0 + 64, ok0, ok1);
                attn_step<256>(O[1], mrun[1], lsum[1], qf[1], k00, k01, k10, k11, v0, v1, D0 - 4, D0 + 60, ok0, ok1); }
        }
    }
#pragma unroll
    for (int u = 0; u < 2; ++u) { float l2 = lsum[u]; l2 += __shfl_xor(l2, 16); l2 += __shfl_xor(l2, 32); const int pq = p0 + 16 * fr + r0 + 4 * u; const size_t qrow = (size_t)(b * SEQ + pq);
        const float* ml = (const float*)(p.ws + WS_P1ML) + (qrow * 8 + h) * 2; const float m1 = ml[0], l1 = ml[1];
        const float m = fmaxf(mrun[u], m1); const float a2 = __builtin_amdgcn_exp2f(mrun[u] - m), a1 = __builtin_amdgcn_exp2f(m1 - m) * l1; const float rden = 1.0f / (l2 * a2 + a1);
        const bf16* o1p = (const bf16*)(p.ws + WS_P1O) + qrow * 512 + h * 64 + 4 * fq;
#pragma unroll
        for (int d = 0; d < 4; ++d) { const u32x2 ow = *(const u32x2*)(o1p + 16 * d); u32x2 w;
            w.x = pk2((O[u][d][0] * a2 + bflo(ow.x) * a1) * rden, (O[u][d][1] * a2 + bfhi(ow.x) * a1) * rden); w.y = pk2((O[u][d][2] * a2 + bflo(ow.y) * a1) * rden, (O[u][d][3] * a2 + bfhi(ow.y) * a1) * rden);
            *(u32x2*)(Yrow[u] + 16 * d + 4 * fq) = w; } }
}
__device__ __forceinline__ void attn_quad_d1(const Params& p, int b, int h, int L, int lane) {
    const int fr = lane & 15, fq = lane >> 4, fK = fr >> 2, jK = fr & 3;
    const f32x4 z4 = {0.f, 0.f, 0.f, 0.f};
    bf16x8 qf[4][2]; f32x4 O[4][4]; float mrun[4], lsum[4];
    const bf16* Kb = (const bf16*)(p.ws + WS_AK) + (ptrdiff_t)b * SEQ * 512 + h * 64 + 8 * fq;
    const bf16* Vb = (const bf16*)(p.ws + WS_VT16) + (ptrdiff_t)(b * 8 + h) * 131072 + fr * 4;
#pragma unroll
    for (int i = 0; i < 4; ++i) { const bf16* qrow = (const bf16*)(p.ws + WS_Y) + ((size_t)(b * SEQ + 16 * (L + i) + fr)) * 1024 + 512 + h * 64;
        qf[i][0] = *(const bf16x8*)(qrow + 8 * fq); qf[i][1] = *(const bf16x8*)(qrow + 32 + 8 * fq); mrun[i] = -1e30f; lsum[i] = 0.f;
#pragma unroll
        for (int d = 0; d < 4; ++d) O[i][d] = z4; }
    const bf16* kp = Kb + (ptrdiff_t)(16 * (L - 4 + jK) + fK) * 512;
    const bf16* vp = Vb + (ptrdiff_t)(fq * 32 + (L >> 2) - 1) * 256;
    for (int kb = 0; kb < 3; ++kb) { const int lb = L - 4 + 4 * kb; if ((unsigned)lb >= 128u) continue;
#pragma unroll
        for (int th = 0; th < 2; ++th) { const int t0 = 2 * th;
            const int D0 = 16 * (-4 + 4 * kb) + 4 * t0 + fq - fr + 64;
            const bf16* k0p = kp + (ptrdiff_t)(64 * kb + 4 * t0) * 512; const bf16* v0p = vp + (ptrdiff_t)(128 * t0 + kb) * 256;
            bf16x8 k00, k01, k10, k11; u32x2 v0[4], v1[4];
            KLD(k0p, k00, k01); KLD(k0p + 4 * 512, k10, k11); VLD(v0p, v0); VLD(v0p + 128 * 256, v1);
#pragma unroll
            for (int i = 0; i < 4; ++i) { attn_step<64>(O[i], mrun[i], lsum[i], qf[i], k00, k01, k10, k11, v0, v1, D0 - 16 * i, D0 - 16 * i + 4, true, true); if (i & 1) __builtin_amdgcn_sched_barrier(0); } }
    }
#pragma unroll
    for (int i = 0; i < 4; ++i) { float l = lsum[i]; l += __shfl_xor(l, 16); l += __shfl_xor(l, 32); const float rl = 1.0f / l; const size_t qrow = (size_t)(b * SEQ + 16 * (L + i) + fr);
        bf16* o1p = (bf16*)(p.ws + WS_P1O) + qrow * 512 + h * 64 + 4 * fq;
#pragma unroll
        for (int d = 0; d < 4; ++d) { u32x2 w; w.x = pk2(O[i][d][0] * rl, O[i][d][1] * rl); w.y = pk2(O[i][d][2] * rl, O[i][d][3] * rl); *(u32x2*)(o1p + 16 * d) = w; }
        if (fq == 0) { float* ml = (float*)(p.ws + WS_P1ML) + (qrow * 8 + h) * 2; ml[0] = mrun[i]; ml[1] = l; } }
}
constexpr int QS_OFF = 0, KS_OFF = 17408, PF_OFF = 34816, PB_OFF = 44032, FL_OFF = 53248, QPITCH = 272, PPITCH = 144;
__device__ __forceinline__ void mout_unit(const Params& p, int layer, int u, LAS unsigned char* lds, int tid, int wave, int lane) {
    const int b = u >> 7, hh = (u >> 5) & 3, pc = u & 31, tok0 = pc * 64;
    const int fr = lane & 15, fq = lane >> 4;
    LAS float* FL = (LAS float*)(lds + FL_OFF);
    const float* Gp = (const float*)(p.ws + WS_G) + (size_t)(b * SEQ + tok0) * 16;
    const float* Mst = (const float*)(p.ws + WS_MST); const float* Nst = (const float*)(p.ws + WS_N);
    const bf16* Ct = (const bf16*)p.out;
    const size_t sid0 = (size_t)((b * 4 + hh) * 2 + 0) * 32 + pc, sid1 = (size_t)((b * 4 + hh) * 2 + 1) * 32 + pc;
    bf16x8 vaf[2], caf[2][4];
    { const bf16* Vr = (const bf16*)(p.ws + WS_VTM) + ((size_t)((b * 4 + hh) * 128 + 16 * wave + fr)) * SEQ + tok0;
#pragma unroll
      for (int ks = 0; ks < 2; ++ks) vaf[ks] = *(const bf16x8*)(Vr + 32 * ks + 8 * fq);
#pragma unroll
      for (int d = 0; d < 2; ++d) { const bf16* Cr = Ct + (d ? sid1 : sid0) * 16384 + (size_t)(16 * wave + fr) * 128;
#pragma unroll
          for (int kk = 0; kk < 4; ++kk) caf[d][kk] = *(const bf16x8*)(Cr + 32 * kk + 8 * fq); } }
    if (wave < 2) {
        const int dir = wave; const float li = Gp[lane * 16 + dir * 4 + hh], lf = Gp[lane * 16 + 8 + dir * 4 + hh];
        const float pre = wave_incl_scan(lf, lane); const float total = __shfl(pre, 63);
        const float bt = dir ? (total - pre + lf) : pre; const float uu = li - bt;
        float pm = uu;
#pragma unroll
        for (int o = 1; o < 64; o <<= 1) { if (dir == 0) { const float t = __shfl_up(pm, o); if (lane >= o) pm = fmaxf(pm, t); } else { const float t = __shfl_down(pm, o); if (lane + o < 64) pm = fmaxf(pm, t); } }
        const float mprev = Mst[dir ? sid1 : sid0]; const float a = bt + mprev; const float mt = fmaxf(a, bt + pm);
        FL[(0 + 2 * dir) * 64 + lane] = bt - mt; FL[(1 + 2 * dir) * 64 + lane] = uu; FL[(4 + dir) * 64 + lane] = __expf(a - mt); FL[(6 + dir) * 64 + lane] = __expf(-mt);
    }
    {
        const bf16* QKm = (const bf16*)(p.ws + WS_QKM); const float* cwl = p.conv_w + (size_t)layer * 5 * 1024;
#pragma unroll
        for (int it4 = 0; it4 < 4; ++it4) { const int it = tid + it4 * NTHR; const int mat = it >> 10, rem = it & 1023, tok = rem >> 4, dg = rem & 15; const int col = mat * 512 + hh * 128 + 8 * dg;
            float a8[8];
#pragma unroll
            for (int j = 0; j < 8; ++j) a8[j] = 0.f;
#pragma unroll
            for (int t = 0; t < 5; ++t) { const int tt = tok0 + tok + t - 2;
                if (tt >= 0 && tt < SEQ) { const u32x4 xx = *(const u32x4*)(QKm + (size_t)(b * SEQ + tt) * 1024 + col);
                    const f32x4 w0 = *(const f32x4*)(cwl + t * 1024 + col), w1 = *(const f32x4*)(cwl + t * 1024 + col + 4);
                    a8[0] = fmaf(w0[0], bflo(xx.x), a8[0]); a8[1] = fmaf(w0[1], bfhi(xx.x), a8[1]); a8[2] = fmaf(w0[2], bflo(xx.y), a8[2]); a8[3] = fmaf(w0[3], bfhi(xx.y), a8[3]);
                    a8[4] = fmaf(w1[0], bflo(xx.z), a8[4]); a8[5] = fmaf(w1[1], bfhi(xx.z), a8[5]); a8[6] = fmaf(w1[2], bflo(xx.w), a8[6]); a8[7] = fmaf(w1[3], bfhi(xx.w), a8[7]); } }
            const float sc = mat ? 0.08838834764831845f : 1.0f;
#pragma unroll
            for (int j = 0; j < 8; ++j) a8[j] = a8[j] * __builtin_amdgcn_rcpf(1.0f + __expf(-a8[j])) * sc;
            u32x4 w; w.x = pk2(a8[0], a8[1]); w.y = pk2(a8[2], a8[3]); w.z = pk2(a8[4], a8[5]); w.w = pk2(a8[6], a8[7]);
            *(LAS u32x4*)(lds + (mat ? KS_OFF : QS_OFF) + tok * QPITCH + dg * 16) = w; }
    }
    __syncthreads();
    if (wave < 2) {
        const float* np = Nst + (wave ? sid1 : sid0) * 128; float acc = 0.f;
#pragma unroll
        for (int dg = 0; dg < 16; ++dg) { const u32x4 xx = *(const LAS u32x4*)(lds + QS_OFF + lane * QPITCH + dg * 16); const f32x4 n0 = *(const f32x4*)(np + 8 * dg), n1 = *(const f32x4*)(np + 8 * dg + 4);
            acc += bflo(xx.x) * n0[0] + bfhi(xx.x) * n0[1] + bflo(xx.y) * n0[2] + bfhi(xx.y) * n0[3] + bflo(xx.z) * n1[0] + bfhi(xx.z) * n1[1] + bflo(xx.w) * n1[2] + bfhi(xx.w) * n1[3]; }
        FL[(16 + wave) * 64 + lane] = acc;
    }
    {
        const int st = wave >> 1, tt0 = 2 * (wave & 1); const f32x4 z4 = {0.f, 0.f, 0.f, 0.f};
        bf16x8 ka[4];
#pragma unroll
        for (int ks = 0; ks < 4; ++ks) ka[ks] = *(const LAS bf16x8*)(lds + KS_OFF + (16 * st + fr) * QPITCH + (32 * ks + 8 * fq) * 2);
#pragma unroll
        for (int q = 0; q < 2; ++q) { const int t = 16 * (tt0 + q) + fr; f32x4 s = z4;
#pragma unroll
            for (int ks = 0; ks < 4; ++ks) { const bf16x8 qb = *(const LAS bf16x8*)(lds + QS_OFF + t * QPITCH + (32 * ks + 8 * fq) * 2); s = MFMA16(ka[ks], qb, s); }
            const float cf = FL[0 * 64 + t], cb = FL[2 * 64 + t]; float pf[4], pb[4]; float rf = 0.f, rb = 0.f;
#pragma unroll
            for (int j = 0; j < 4; ++j) { const int si = 16 * st + 4 * fq + j; const float uf = FL[1 * 64 + si], ub = FL[3 * 64 + si];
                pf[j] = (si <= t) ? s[j] * __expf(cf + uf) : 0.f; pb[j] = (si >= t) ? s[j] * __expf(cb + ub) : 0.f; rf += pf[j]; rb += pb[j]; }
            u32x2 w; w.x = pk2(pf[0], pf[1]); w.y = pk2(pf[2], pf[3]); *(LAS u32x2*)(lds + PF_OFF + t * PPITCH + (16 * st + 4 * fq) * 2) = w;
            w.x = pk2(pb[0], pb[1]); w.y = pk2(pb[2], pb[3]); *(LAS u32x2*)(lds + PB_OFF + t * PPITCH + (16 * st + 4 * fq) * 2) = w;
            rf += __shfl_xor(rf, 16); rf += __shfl_xor(rf, 32); rb += __shfl_xor(rb, 16); rb += __shfl_xor(rb, 32);
            if (fq == 0) { FL[(8 + st) * 64 + t] = rf; FL[(12 + st) * 64 + t] = rb; } }
    }
    __syncthreads();
    f32x4 aI[2][4], aX[2][4];
    {
        const f32x4 z4 = {0.f, 0.f, 0.f, 0.f};
#pragma unroll
        for (int d = 0; d < 2; ++d)
#pragma unroll
            for (int tt = 0; tt < 4; ++tt) { aI[d][tt] = z4; aX[d][tt] = z4; }
#pragma unroll
        for (int ks = 0; ks < 2; ++ks) { const bf16x8 va = vaf[ks];
#pragma unroll
            for (int tt = 0; tt < 4; ++tt) { const bf16x8 pfb = *(const LAS bf16x8*)(lds + PF_OFF + (16 * tt + fr) * PPITCH + (32 * ks + 8 * fq) * 2);
                const bf16x8 pbb = *(const LAS bf16x8*)(lds + PB_OFF + (16 * tt + fr) * PPITCH + (32 * ks + 8 * fq) * 2);
                aI[0][tt] = MFMA16(va, pfb, aI[0][tt]); aI[1][tt] = MFMA16(va, pbb, aI[1][tt]); } }
#pragma unroll
        for (int d = 0; d < 2; ++d) {
#pragma unroll
            for (int kk = 0; kk < 4; ++kk) { const bf16x8 ca = caf[d][kk];
#pragma unroll
                for (int tt = 0; tt < 4; ++tt) { const bf16x8 qb = *(const LAS bf16x8*)(lds + QS_OFF + (16 * tt + fr) * QPITCH + (32 * kk + 8 * fq) * 2); aX[d][tt] = MFMA16(ca, qb, aX[d][tt]); } } }
    }
    f32x4 hs[4];
#pragma unroll
    for (int tt = 0; tt < 4; ++tt) { const int t = 16 * tt + fr; const f32x4 z4 = {0.f, 0.f, 0.f, 0.f}; hs[tt] = z4;
#pragma unroll
        for (int d = 0; d < 2; ++d) { const float in = FL[(4 + d) * 64 + t]; const float den = ((FL[(8 + 4 * d) * 64 + t] + FL[(9 + 4 * d) * 64 + t]) + (FL[(10 + 4 * d) * 64 + t] + FL[(11 + 4 * d) * 64 + t])) + in * FL[(16 + d) * 64 + t];
            const float rd = 1.0f / fmaxf(fabsf(den), FL[(6 + d) * 64 + t]); hs[tt] += (aI[d][tt] + aX[d][tt] * in) * rd; }
        float sq = (hs[tt][0] * hs[tt][0] + hs[tt][1] * hs[tt][1]) + (hs[tt][2] * hs[tt][2] + hs[tt][3] * hs[tt][3]);
        sq += __shfl_xor(sq, 16); sq += __shfl_xor(sq, 32);
        if (fq == 0) FL[(18 + wave) * 64 + t] = sq; }
    __syncthreads();
    {
        const f32x4 hg = *(const f32x4*)(p.head_norm_g + layer * 512 + hh * 128 + 16 * wave + 4 * fq);
#pragma unroll
        for (int tt = 0; tt < 4; ++tt) { const int t = 16 * tt + fr; const float ssq = ((FL[18 * 64 + t] + FL[19 * 64 + t]) + (FL[20 * 64 + t] + FL[21 * 64 + t])) + ((FL[22 * 64 + t] + FL[23 * 64 + t]) + (FL[24 * 64 + t] + FL[25 * 64 + t])); const float rsd = rsqrtf(ssq * (1.0f / 128.0f) + 1e-6f);
            bf16* yp = (bf16*)(p.ws + WS_Y) + (size_t)(b * SEQ + tok0 + t) * 1024 + hh * 128 + 16 * wave + 4 * fq;
            const u32x2 gt = *(const u32x2*)yp;
            u32x2 w; w.x = pk2(hs[tt][0] * rsd * hg[0] * bflo(gt.x), hs[tt][1] * rsd * hg[1] * bfhi(gt.x)); w.y = pk2(hs[tt][2] * rsd * hg[2] * bflo(gt.y), hs[tt][3] * rsd * hg[3] * bfhi(gt.y));
            *(u32x2*)yp = w; }
    }
    __syncthreads();
}

#define XB_TMO      128
#define XB_XCNT(j)  (256  + 64 * (j))
#define XB_XSUB(j)  (1280 + 64 * (j))
#define XB_XGEN(j)  (2304 + 64 * (j))
#define XB_TOP      3328
#define XB_TOPGEN   3392
#define XCD_BAR_WORDS 3456
#define XB_SPIN_CAP (1u << 18)

__device__ __forceinline__ unsigned xb_ld(unsigned* p)              { return __hip_atomic_load(p, __ATOMIC_RELAXED, __HIP_MEMORY_SCOPE_AGENT); }
__device__ __forceinline__ unsigned xb_add(unsigned* p, unsigned v) { return __hip_atomic_fetch_add(p, v, __ATOMIC_RELAXED, __HIP_MEMORY_SCOPE_AGENT); }
__device__ __forceinline__ unsigned xb_xcc_id() { return (unsigned)__builtin_amdgcn_s_getreg((3 << 11) | 20) & 0xFu; }
#define XB_SPIN(cond, bar) do { unsigned _sp = 0; while (cond) { __builtin_amdgcn_s_sleep(1); \
    if ((++_sp & 255u) == 0u) { if (xb_ld(&(bar)[XB_TMO])) break; if (_sp > XB_SPIN_CAP) { atomicAdd(&(bar)[XB_TMO], 1u); break; } } } } while (0)

struct XcdBarrier {
    unsigned* bar; unsigned x;
    volatile LAS unsigned* st;
};

__device__ __forceinline__ XcdBarrier xcd_barrier_post(unsigned* bar, volatile LAS unsigned* st) {
    XcdBarrier b; b.bar = bar; b.x = xb_xcc_id(); b.st = st;
    if (threadIdx.x == 0) (void)xb_add(&bar[XB_XCNT(b.x)], 1u);
    return b;
}
__device__ __forceinline__ void xcd_barrier_complete(unsigned* bar, unsigned x, unsigned& nloc, unsigned& nx) {
    const unsigned G = gridDim.x * gridDim.y * gridDim.z;
    unsigned sum, cnt, mine, sp = 0u;
    for (;;) {
        sum = 0u; cnt = 0u; mine = 0u;
#pragma unroll
        for (unsigned j = 0; j < 16; ++j) { const unsigned c = xb_ld(&bar[XB_XCNT(j)]); sum += c; cnt += (c > 0u) ? 1u : 0u; mine = (j == x) ? c : mine; }
        if (sum == G) break;
        __builtin_amdgcn_s_sleep(1);
        if ((++sp & 255u) == 0u) { if (xb_ld(&bar[XB_TMO])) break; if (sp > XB_SPIN_CAP) { atomicAdd(&bar[XB_TMO], 1u); break; } }
    }
    nloc = mine > 0u ? mine : 1u; nx = cnt > 0u ? cnt : 1u;
}

__device__ __forceinline__ void xcd_barrier(const XcdBarrier& b) {
    asm volatile("s_waitcnt vmcnt(0)" ::: "memory");
    __syncthreads();
    if (threadIdx.x == 0) {
        unsigned* bar = b.bar;
        __builtin_amdgcn_s_waitcnt(0);
        unsigned nloc = b.st[0], nx = b.st[1];
        if (nloc == 0u) { xcd_barrier_complete(bar, b.x, nloc, nx); b.st[0] = nloc; b.st[1] = nx; }
        const unsigned old = xb_add(&bar[XB_XSUB(b.x)], 1u);
        const unsigned gen = old / nloc;
        if (old + 1u == (gen + 1u) * nloc) {
            __builtin_amdgcn_fence(__ATOMIC_RELEASE, "agent");
            asm volatile("s_waitcnt vmcnt(0)" ::: "memory");
            const unsigned og = xb_add(&bar[XB_TOP], 1u);
            const unsigned tg = og / nx;
            if (og + 1u == (tg + 1u) * nx) xb_add(&bar[XB_TOPGEN], 1u);
            else XB_SPIN(xb_ld(&bar[XB_TOPGEN]) == tg, bar);
            __builtin_amdgcn_fence(__ATOMIC_ACQUIRE, "agent");
            xb_add(&bar[XB_XGEN(b.x)], 1u);
            asm volatile("s_waitcnt vmcnt(0)" ::: "memory");
        } else {
            XB_SPIN(xb_ld(&bar[XB_XGEN(b.x)]) == gen, bar);
            __builtin_amdgcn_fence(__ATOMIC_ACQUIRE, "agent");
            asm volatile("s_waitcnt vmcnt(0)" ::: "memory");
        }
    }
    __syncthreads();
}

__global__ void __launch_bounds__(NTHR, 2) fwd_megakernel(Params p) {
    extern __shared__ __attribute__((aligned(16))) unsigned char lds_raw[];
    LAS unsigned char* lds = (LAS unsigned char*)lds_raw;
    cg::grid_group grid = cg::this_grid();
#define GRID_SYNC_CG() do { asm volatile("s_waitcnt vmcnt(0) lgkmcnt(0)" ::: "memory"); grid.sync(); \
        __builtin_amdgcn_fence(__ATOMIC_ACQUIRE, "agent"); asm volatile("s_waitcnt vmcnt(0)" ::: "memory"); __syncthreads(); } while (0)
#define GRID_SYNC() do { XcdBarrier xb_; xb_.bar = (unsigned*)(p.ws + WS_CTL); xb_.x = xb_xcc_id(); xb_.st = (volatile LAS unsigned*)(lds + LDS_MISC); xcd_barrier(xb_); } while (0)
    const int tid = threadIdx.x, lane = tid & 63, wave = __builtin_amdgcn_readfirstlane(tid >> 6), G = gridDim.x, bid = blockIdx.x;
    float* ss = (float*)(p.ws + WS_SSP);
    { volatile LAS unsigned* st0 = (volatile LAS unsigned*)(lds + LDS_MISC); if (threadIdx.x < 2) st0[threadIdx.x] = 0u; __syncthreads(); }
    (void)xcd_barrier_post((unsigned*)(p.ws + WS_CTL), (volatile LAS unsigned*)(lds + LDS_MISC));
    bf16* xb = (bf16*)(p.ws + WS_XB);

    const bool defer = (G == 256);
    p0_prologue(p, lds, wave, lane, G, defer ? -1 : 2 * I_L);
    if (G == 0x7fffffff) GRID_SYNC_CG();
    GRID_SYNC();

    for (int layer = 0; layer < 2; ++layer) {
#define RELANE() int tid = threadIdx.x; asm volatile("" : "+v"(tid)); const int lane = tid & 63, wave = __builtin_amdgcn_readfirstlane(tid >> 6)
        {
            pg8::Gemm g{xb, (const bf16*)(p.ws + WS_WIN) + (size_t)layer * NINP * DM, MROWS, NINP, DM};
            pg8::StaticOrder S; S.init(MROWS, NINP, G, bid);
            pg8::EpiIn E{ss + (size_t)(2 * layer) * MROWS * 16, p.ws, p.gate_i_b + layer * 8, p.gate_f_b + layer * 8};
            static_assert(pg8::EpiIn::O_ROPE == WS_ROPE && pg8::EpiIn::O_G == WS_G && pg8::EpiIn::O_QKM == WS_QKM && pg8::EpiIn::O_KTM == WS_KTM && pg8::EpiIn::O_VTM == WS_VTM && pg8::EpiIn::O_AK == WS_AK && pg8::EpiIn::O_VT16 == WS_VT16 && pg8::EpiIn::O_Y == WS_Y, "ws map");
            pg8::gemm_phase<pg8::EpiIn, pg8::StaticOrder, true, true>(lds, g, S, E);
            if (defer && bid >= 192) { RELANE(); LAS float* scr = (LAS float*)(lds + wave * 16384);
                for (int it = layer * I_L + I_IN + I_OUT + (bid - 192) * NWAVE + wave; it < (layer + 1) * I_L; it += 64 * NWAVE) convert_item(p, it, scr, lane); }
        }
        GRID_SYNC();
        {
            RELANE();
            volatile LAS unsigned* ctr = (volatile LAS unsigned*)(lds + LDS_MISC + 16);
            if (tid == 0) *ctr = 0u;
            const int nU = (512 - bid + G - 1) / G;
            const bool fast = (G * 2 == 512);
            if (fast && wave < 2) {
                __builtin_amdgcn_s_setprio(3);
                scan_wave(p, layer, bid * 2 + wave, (LAS float*)(lds + wave * 256), lane, true);
                __builtin_amdgcn_s_setprio(0);
            } else {
                const int w0 = fast ? 2 : 0, nw = fast ? 6 : NWAVE;
                for (int I = wave - w0; I < 4 * nU; I += nw) { const int au = bid + G * (I >> 2); const int b = au >> 6, h = (au >> 3) & 7, p0 = (au & 7) * 256;
                    attn_quad_d1(p, b, h, (p0 >> 4) + 4 * (I & 3), lane); }
                asm volatile("s_waitcnt vmcnt(0)" ::: "memory");
                __syncthreads();
                if (!fast && wave < 2) for (int sw = bid * 2 + wave; sw < 512; sw += G * 2) scan_wave(p, layer, sw, (LAS float*)(lds + wave * 256), lane, false);
            }
            {
                const int nQ = 8 * nU;
                for (;;) { unsigned Q = 0; if (lane == 0) Q = atomicAdd((unsigned*)(lds_raw + LDS_MISC + 16), 1u); Q = (unsigned)__builtin_amdgcn_readfirstlane((int)Q);
                    if ((int)Q >= nQ) break;
                    const int au = bid + G * (int)(Q >> 3); const int b = au >> 6, h = (au >> 3) & 7, p0 = (au & 7) * 256; attn_pair(p, b, h, p0, (int)((Q & 3) + 8 * ((Q >> 2) & 1)), lane); }
            }
        }
        GRID_SYNC();
        { RELANE(); for (int u = bid; u < 1024; u += G) mout_unit(p, layer, u, lds, tid, wave, lane); }
        GRID_SYNC();
        {
            pg8::Gemm g{(const bf16*)(p.ws + WS_Y), (const bf16*)(p.ws + WS_WOUT) + (size_t)layer * DM * DM, MROWS, DM, DM};
            pg8::StaticOrder S; S.init(MROWS, DM, G, bid);
            pg8::EpiRes E{xb, ss + (size_t)(2 * layer + 1) * MROWS * 16};
            pg8::gemm_phase<pg8::EpiRes, pg8::StaticOrder, true, true>(lds, g, S, E);
        }
        GRID_SYNC();
        {
            pg8::Gemm g{xb, (const bf16*)(p.ws + WS_WUP) + (size_t)layer * FF * DM, MROWS, FF, DM};
            pg8::StaticOrder S; S.init(MROWS, FF, G, bid);
            pg8::EpiUp E{ss + (size_t)(2 * layer + 1) * MROWS * 16, (bf16*)(p.ws + WS_U)};
            pg8::gemm_phase<pg8::EpiUp, pg8::StaticOrder, true, true>(lds, g, S, E);
        }
        GRID_SYNC();
        {
            pg8::Gemm g{(const bf16*)(p.ws + WS_U), (const bf16*)(p.ws + WS_WDN) + (size_t)layer * DM * FF, MROWS, DM, FF};
            pg8::StaticOrder S; S.init(MROWS, DM, G, bid);
            pg8::EpiRes E{xb, ss + (size_t)(2 * layer + 2) * MROWS * 16};
            pg8::gemm_phase<pg8::EpiRes, pg8::StaticOrder, true, true>(lds, g, S, E);
        }
        GRID_SYNC();
    }
    {
        RELANE();
        const int gw = bid * NWAVE + wave, NGW = G * NWAVE;
        for (int m = gw; m < MROWS; m += NGW) { const float rsd = rsqrtf(pg8::row_ss(ss + (size_t)4 * MROWS * 16, m) * (1.0f / 1024.0f) + 1e-6f);
            const u32x2* xr = (const u32x2*)(xb + (size_t)m * DM) + lane; f32x4* orow = (f32x4*)(p.out + (size_t)m * DM) + lane; const f32x4* gr = (const f32x4*)p.final_g + lane;
#pragma unroll
            for (int j = 0; j < 4; ++j) { const u32x2 w = xr[64 * j]; const f32x4 g4 = gr[64 * j]; f32x4 o; o[0] = bflo(w.x) * rsd * g4[0]; o[1] = bfhi(w.x) * rsd * g4[1]; o[2] = bflo(w.y) * rsd * g4[2]; o[3] = bfhi(w.y) * rsd * g4[3]; orow[64 * j] = o; } }
    }
}

extern "C" void kernel_launch(void* const* d_in, const int* in_sizes, int n_in, void* d_out, int out_size, void* d_ws, size_t ws_size, hipStream_t stream) {
    static int grid = 0;
    if (grid == 0) {
        int dev = 0, cus = 0, per_cu = 0;
        (void)hipGetDevice(&dev);
        (void)hipDeviceGetAttribute(&cus, hipDeviceAttributeMultiprocessorCount, dev);
        (void)hipFuncSetAttribute((const void*)fwd_megakernel, hipFuncAttributeMaxDynamicSharedMemorySize, LDS_BYTES);
        (void)hipOccupancyMaxActiveBlocksPerMultiprocessor(&per_cu, (const void*)fwd_megakernel, NTHR, LDS_BYTES);
        if (per_cu < 1) per_cu = 1;
        grid = cus * per_cu;
        if (ws_size < WS_END) { fprintf(stderr, "kernel_launch: workspace too small (%zu)\n", ws_size); grid = -1; }
    }
    if (grid < 0) return;
    Params p{};
    p.x = (const float*)d_in[0]; p.norm1_g = (const float*)d_in[1]; p.w_in = (const float*)d_in[2]; p.conv_w = (const float*)d_in[3];
    p.gate_i_b = (const float*)d_in[4]; p.gate_f_b = (const float*)d_in[5]; p.head_norm_g = (const float*)d_in[6]; p.w_out = (const float*)d_in[7];
    p.norm2_g = (const float*)d_in[8]; p.w_up = (const float*)d_in[9]; p.w_down = (const float*)d_in[10]; p.final_g = (const float*)d_in[11];
    p.out = (float*)d_out; p.ws = (unsigned char*)d_ws;
    (void)hipMemsetAsync((char*)d_ws + WS_CTL, 0, CTL_BYTES, stream);
    void* args[] = {&p};
    hipError_t e = hipLaunchCooperativeKernel((void*)fwd_megakernel, dim3(grid), dim3(NTHR), args, LDS_BYTES, stream);
    if (e != hipSuccess) fprintf(stderr, "cooperative launch failed: %s (grid %d)\n", hipGetErrorString(e), grid);
}
```

```cpp
#include <hip/hip_runtime.h>
#include <hip/hip_cooperative_groups.h>
#include <cstdio>
#include <cstdint>
#include <cmath>
namespace cg = cooperative_groups;
namespace pg8 {
#define PG8_LAS __attribute__((address_space(3)))
typedef unsigned short bf16_t;
typedef short bf16x8 __attribute__((ext_vector_type(8)));
typedef float f32x4 __attribute__((ext_vector_type(4)));
typedef unsigned u32x4 __attribute__((ext_vector_type(4)));
constexpr int BM = 256, BK = 64, HALF = 128, HTB = HALF * BK * 2  , STAGE_BYTES = 8 * HTB, NXCD = 8, WGM = 8;

__host__ __device__ __forceinline__ int lds_byte(int r, int c) { const int st = (r >> 4) * 2 + (c >> 5), rr = r & 15, cc = c & 31, ob = rr * 64 + cc * 2; return st * 1024 + (ob ^ (((ob >> 9) & 1) << 5)); }
__host__ __device__ __forceinline__ void stage_rc(int b, int& R, int& C) { const int st = b / 1024, sb = b % 1024, swz = sb ^ (((sb >> 9) & 1) << 5); R = (st >> 1) * 16 + swz / 64; C = (st & 1) * 32 + (swz % 64) / 2; }
__host__ __device__ __forceinline__ int perm32(int rho) { const int n = rho >> 4, i = rho & 15; return 8 * (i >> 2) + 4 * n + (i & 3); }

struct Unit { int pm, pn; };
struct Gemm { const bf16_t* A; const bf16_t* Bt; int M, N, K; };

struct StaticOrder {
    int nM, nN, nwg, G, c;
    __host__ __device__ void init(int M, int N, int G_, int c_) { nM = M / BM; nN = N / BM; nwg = nM * nN; G = G_; c = c_; }
    __host__ __device__ bool next(int i, Unit& u) const {
        const long L = (long)i * G + c; if (L >= nwg) return false;
        int wgid = (int)L; { const int q = nwg / NXCD, r = nwg % NXCD, xcd = wgid % NXCD, off = wgid / NXCD; wgid = (xcd < r ? xcd * (q + 1) : r * (q + 1) + (xcd - r) * q) + off; }
        const int nig = WGM * nN, gid = wgid / nig, fm = gid * WGM, gsz = (nM - fm) < WGM ? (nM - fm) : WGM;
        u.pm = fm + ((wgid % nig) % gsz); u.pn = (wgid % nig) / gsz; return true;
    }
    __device__ __forceinline__ void a_ready(const Unit&) const {}
    __device__ __forceinline__ void done(const Unit&) const {}
};

typedef float f32x2c_t __attribute__((ext_vector_type(2))); typedef __bf16 bf16x2c_t __attribute__((ext_vector_type(2)));
__device__ __forceinline__ unsigned cvt_pk_bf16(float lo, float hi) { f32x2c_t v = {lo, hi}; bf16x2c_t b = __builtin_convertvector(v, bf16x2c_t); return __builtin_bit_cast(unsigned, b); }
typedef float f32x2 __attribute__((ext_vector_type(2)));
__device__ __forceinline__ unsigned short bf16_1(float v) { return (unsigned short)(cvt_pk_bf16(v, v) & 0xffffu); }
__device__ __forceinline__ float row_ss(const float* ssp, int row) { const f32x4* q = (const f32x4*)(ssp + (size_t)row * 16); const f32x4 a = q[0], b = q[1], c = q[2], d = q[3];
    return (((a[0] + a[1]) + (a[2] + a[3])) + ((b[0] + b[1]) + (b[2] + b[3]))) + (((c[0] + c[1]) + (c[2] + c[3])) + ((d[0] + d[1]) + (d[2] + d[3]))); }
__device__ __forceinline__ float row_ss_q(const float* ssp, int row, int fq) { const f32x4 a = *(const f32x4*)(ssp + (size_t)row * 16 + 4 * fq); float t = (a[0] + a[1]) + (a[2] + a[3]);
    t += __shfl_xor(t, 16); t += __shfl_xor(t, 32); return t; }
struct EpiIn {
    static constexpr bool PERM = true, AFTER_DRAIN = false;
    const float* ss; unsigned char* ws; const float* gib; const float* gfb;
    static constexpr size_t O_ROPE = 512 * 1024, O_G = 3u << 20, O_QKM = 120u << 20, O_KTM = 152u << 20, O_VTM = 168u << 20, O_AK = 184u << 20, O_VT16 = 200u << 20, O_Y = 216u << 20;
    __device__ __forceinline__ void operator()(const f32x4 (&acc)[2][2][4][2], const Unit& u, int wr, int wc, int fr_, int fq_) const {
        int fr = fr_, fq = fq_; asm volatile("" : "+v"(fr), "+v"(fq));
        const int pn = u.pn;
        const int rbase = u.pm * BM + wr * 64 + fr;
        float rsv[2][4];
#pragma unroll
        for (int ai = 0; ai < 2; ++ai)
#pragma unroll
            for (int m = 0; m < 4; ++m) rsv[ai][m] = row_ss_q(ss, rbase + ai * HALF + m * 16, fq);
#pragma unroll
        for (int ai = 0; ai < 2; ++ai)
#pragma unroll
            for (int m = 0; m < 4; ++m) rsv[ai][m] = rsqrtf(rsv[ai][m] * (1.0f / 1024.0f) + 1e-6f);
        if (pn < 4) {
            bf16_t* QKm = (bf16_t*)(ws + O_QKM);
#pragma unroll
            for (int ai = 0; ai < 2; ++ai)
#pragma unroll
                for (int m = 0; m < 4; ++m) { const int row = rbase + ai * HALF + m * 16; const float r = rsv[ai][m]; bf16_t* rowp = QKm + (size_t)row * 1024 + pn * 256 + wc * 32 + 8 * fq;
#pragma unroll
                    for (int bj = 0; bj < 2; ++bj) { const f32x4 v0 = acc[ai][bj][m][0] * r, v1 = acc[ai][bj][m][1] * r; u32x4 w;
                        w.x = cvt_pk_bf16(v0[0], v0[1]); w.y = cvt_pk_bf16(v0[2], v0[3]); w.z = cvt_pk_bf16(v1[0], v1[1]); w.w = cvt_pk_bf16(v1[2], v1[3]);
                        *(u32x4*)(rowp + bj * HALF) = w; }
                    asm volatile("" ::: "memory"); }
        }
        if ((pn >= 2 && pn < 6)) {
            const int row0 = u.pm * BM; const int b = row0 >> 11;
            unsigned char* ub = ws + ((pn < 4) ? O_KTM : O_VTM) + ((size_t)(((b * 4 + 2 * (pn & 1)) * 128 + wc * 32) * 2048 + (row0 & 2047) + wr * 64)) * 2;
            const unsigned voff = (unsigned)((8 * fq) * 2048 + fr) * 2u;
#pragma unroll
            for (int ai = 0; ai < 2; ++ai)
#pragma unroll
                for (int m = 0; m < 4; m += 2) { const float r0 = rsv[ai][m], r1 = rsv[ai][m + 1];
#pragma unroll
                    for (int bj = 0; bj < 2; ++bj)
#pragma unroll
                        for (int n = 0; n < 2; ++n)
#pragma unroll
                            for (int j = 0; j < 4; ++j) { const unsigned w = cvt_pk_bf16(acc[ai][bj][m][n][j] * r0, acc[ai][bj][m + 1][n][j] * r1);
                                unsigned char* q = ub + (size_t)(((bj * 128 + 4 * n + j) * 2048 + ai * HALF + m * 16) * 2) + voff;
                                *(bf16_t*)q = (bf16_t)(w & 0xffffu); *(bf16_t*)(q + 32) = (bf16_t)(w >> 16); }
                    asm volatile("" ::: "memory"); }
        } else if (pn == 6 || pn == 7) {
            bf16_t* Y = (bf16_t*)(ws + O_Y);
#pragma unroll
            for (int ai = 0; ai < 2; ++ai)
#pragma unroll
                for (int m = 0; m < 4; ++m) { const int row = rbase + ai * HALF + m * 16; const float r = rsv[ai][m]; bf16_t* rowp = Y + (size_t)row * 1024 + (pn - 6) * 256 + wc * 32 + 8 * fq;
#pragma unroll
                    for (int bj = 0; bj < 2; ++bj) { f32x4 v0 = acc[ai][bj][m][0] * r, v1 = acc[ai][bj][m][1] * r;
#pragma unroll
                        for (int j = 0; j < 4; ++j) { v0[j] = __builtin_amdgcn_rcpf(1.0f + __expf(-v0[j])); v1[j] = __builtin_amdgcn_rcpf(1.0f + __expf(-v1[j])); }
                        u32x4 w; w.x = cvt_pk_bf16(v0[0], v0[1]); w.y = cvt_pk_bf16(v0[2], v0[3]); w.z = cvt_pk_bf16(v1[0], v1[1]); w.w = cvt_pk_bf16(v1[2], v1[3]);
                        *(u32x4*)(rowp + bj * HALF) = w; }
                    asm volatile("" ::: "memory"); }
        } else if (pn >= 8 && pn < 12) {
            const bool isk = pn >= 10; const int head = 4 * (pn & 1) + wc; const float qs = isk ? 1.0f : 0.125f * 1.4426950408889634f;
            const float* ropeC = (const float*)(ws + O_ROPE) + 8 * fq; const float* ropeS = ropeC + 2048 * 32;
            f32x4 tb[2][4];
            { const int pos = rbase & 2047; tb[0][0] = *(const f32x4*)(ropeC + pos * 32); tb[0][1] = *(const f32x4*)(ropeC + pos * 32 + 4); tb[0][2] = *(const f32x4*)(ropeS + pos * 32); tb[0][3] = *(const f32x4*)(ropeS + pos * 32 + 4); }
#pragma unroll
            for (int it = 0; it < 8; ++it) { const int ai = it >> 2, m = it & 3; const int row = rbase + ai * HALF + m * 16; const float r = rsv[ai][m] * qs;
                if (it < 7) { const int pos2 = (rbase + ((it + 1) >> 2) * HALF + ((it + 1) & 3) * 16) & 2047;
                    tb[(it + 1) & 1][0] = *(const f32x4*)(ropeC + pos2 * 32); tb[(it + 1) & 1][1] = *(const f32x4*)(ropeC + pos2 * 32 + 4); tb[(it + 1) & 1][2] = *(const f32x4*)(ropeS + pos2 * 32); tb[(it + 1) & 1][3] = *(const f32x4*)(ropeS + pos2 * 32 + 4); }
                const f32x4 c0 = tb[it & 1][0], c1 = tb[it & 1][1], s0 = tb[it & 1][2], s1 = tb[it & 1][3];
                const f32x4 a0 = acc[ai][0][m][0] * r, a1 = acc[ai][0][m][1] * r, b0 = acc[ai][1][m][0] * r, b1 = acc[ai][1][m][1] * r;
                const f32x4 o10 = a0 * c0 - b0 * s0, o11 = a1 * c1 - b1 * s1, o20 = a0 * s0 + b0 * c0, o21 = a1 * s1 + b1 * c1;
                bf16_t* dst = isk ? ((bf16_t*)(ws + O_AK) + (size_t)row * 512 + head * 64 + 8 * fq) : ((bf16_t*)(ws + O_Y) + (size_t)row * 1024 + 512 + head * 64 + 8 * fq);
                u32x4 w; w.x = cvt_pk_bf16(o10[0], o10[1]); w.y = cvt_pk_bf16(o10[2], o10[3]); w.z = cvt_pk_bf16(o11[0], o11[1]); w.w = cvt_pk_bf16(o11[2], o11[3]);
                *(u32x4*)(dst) = w;
                w.x = cvt_pk_bf16(o20[0], o20[1]); w.y = cvt_pk_bf16(o20[2], o20[3]); w.z = cvt_pk_bf16(o21[0], o21[1]); w.w = cvt_pk_bf16(o21[2], o21[3]);
                *(u32x4*)(dst + 32) = w;
                asm volatile("" ::: "memory"); }
        } else if (pn == 12 || pn == 13) {
            const int row0 = u.pm * BM; const int b = row0 >> 11;
            typedef unsigned u32x2v __attribute__((ext_vector_type(2)));
            unsigned char* ub = ws + O_VT16 + ((size_t)((((b * 8 + 4 * (pn - 12) + (wc >> 1)) * 16 * 32 + ((row0 & 2047) >> 6) + wr) * 256) + (wc & 1) * 128)) * 2;
            const unsigned voff = (unsigned)(fr * 32 * 256 + 8 * fq * 4) * 2u;
#pragma unroll
            for (int ai = 0; ai < 2; ++ai) { const float r0 = rsv[ai][0], r1 = rsv[ai][1], r2 = rsv[ai][2], r3 = rsv[ai][3];
#pragma unroll
                for (int bj = 0; bj < 2; ++bj)
#pragma unroll
                    for (int n = 0; n < 2; ++n)
#pragma unroll
                        for (int j = 0; j < 4; ++j) { u32x2v w; w.x = cvt_pk_bf16(acc[ai][bj][0][n][j] * r0, acc[ai][bj][1][n][j] * r1); w.y = cvt_pk_bf16(acc[ai][bj][2][n][j] * r2, acc[ai][bj][3][n][j] * r3);
                            *(u32x2v*)(ub + (size_t)((bj * 262144 + 2 * ai * 256 + (4 * n + j) * 4) * 2) + voff) = w; }
                asm volatile("" ::: "memory"); }
        } else if (pn == 14) {
            if (wc == 0 && fq < 2) {
                float* G = (float*)(ws + O_G);
#pragma unroll
                for (int ai = 0; ai < 2; ++ai)
#pragma unroll
                    for (int m = 0; m < 4; ++m) { const int row = rbase + ai * HALF + m * 16; const float r = rsv[ai][m];
#pragma unroll
                        for (int n = 0; n < 2; ++n) { f32x4 v = acc[ai][0][m][n] * r; f32x4 o;
#pragma unroll
                            for (int j = 0; j < 4; ++j) { const int c8 = 4 * n + j;
                                if (fq == 0) o[j] = v[j] + gib[c8];
                                else { const float x = v[j] + gfb[c8]; o[j] = fminf(x, 0.0f) - __logf(1.0f + __expf(-fabsf(x))); } }
                            *(f32x4*)(G + (size_t)row * 16 + 8 * fq + 4 * n) = o; }
                        asm volatile("" ::: "memory"); }
            }
        }
    }
};
struct EpiRes {
    static constexpr bool PERM = true, AFTER_DRAIN = false;
    bf16_t* xb; float* ssn;
    __device__ __forceinline__ void operator()(const f32x4 (&acc)[2][2][4][2], const Unit& u, int wr, int wc, int fr, int fq) const {
        const int col0 = u.pn * BM + wc * 32 + 8 * fq;
#pragma unroll
        for (int ai = 0; ai < 2; ++ai)
#pragma unroll
            for (int m = 0; m < 4; ++m) { const int row = u.pm * BM + ai * HALF + wr * 64 + m * 16 + fr; bf16_t* rp = xb + (size_t)row * 1024 + col0; float sq = 0.f;
#pragma unroll
                for (int bj = 0; bj < 2; ++bj) { const u32x4 b = *(const u32x4*)(rp + bj * HALF);
                    const f32x4 v0 = acc[ai][bj][m][0], v1 = acc[ai][bj][m][1];
                    const float o0 = __uint_as_float(b.x << 16) + v0[0], o1 = __uint_as_float(b.x & 0xffff0000u) + v0[1], o2 = __uint_as_float(b.y << 16) + v0[2], o3 = __uint_as_float(b.y & 0xffff0000u) + v0[3];
                    const float o4 = __uint_as_float(b.z << 16) + v1[0], o5 = __uint_as_float(b.z & 0xffff0000u) + v1[1], o6 = __uint_as_float(b.w << 16) + v1[2], o7 = __uint_as_float(b.w & 0xffff0000u) + v1[3];
                    u32x4 w; w.x = cvt_pk_bf16(o0, o1); w.y = cvt_pk_bf16(o2, o3); w.z = cvt_pk_bf16(o4, o5); w.w = cvt_pk_bf16(o6, o7);
                    *(u32x4*)(rp + bj * HALF) = w;
                    sq += ((o0 * o0 + o1 * o1) + (o2 * o2 + o3 * o3)) + ((o4 * o4 + o5 * o5) + (o6 * o6 + o7 * o7)); }
                sq += __shfl_xor(sq, 16); sq += __shfl_xor(sq, 32);
                if (fq == 0) ssn[(size_t)row * 16 + u.pn * 4 + wc] = sq; }
    }
};
struct EpiUp {
    static constexpr bool PERM = true, AFTER_DRAIN = false;
    const float* ss; bf16_t* U;
    __device__ __forceinline__ void operator()(const f32x4 (&acc)[2][2][4][2], const Unit& u, int wr, int wc, int fr, int fq) const {
        const int rbase = u.pm * BM + wr * 64 + fr;
        float rsv[2][4];
#pragma unroll
        for (int ai = 0; ai < 2; ++ai)
#pragma unroll
            for (int m = 0; m < 4; ++m) rsv[ai][m] = row_ss_q(ss, rbase + ai * HALF + m * 16, fq);
#pragma unroll
        for (int ai = 0; ai < 2; ++ai)
#pragma unroll
            for (int m = 0; m < 4; ++m) { const int row = rbase + ai * HALF + m * 16; const float r = rsqrtf(rsv[ai][m] * (1.0f / 1024.0f) + 1e-6f);
                bf16_t* rowp = U + (size_t)row * 4096 + u.pn * BM + wc * 32 + 8 * fq;
#pragma unroll
                for (int bj = 0; bj < 2; ++bj) { f32x4 v0 = acc[ai][bj][m][0] * r, v1 = acc[ai][bj][m][1] * r;
#pragma unroll
                    for (int j = 0; j < 4; ++j) { v0[j] = fmaxf(v0[j], 0.f); v0[j] *= v0[j]; v1[j] = fmaxf(v1[j], 0.f); v1[j] *= v1[j]; }
                    u32x4 w; w.x = cvt_pk_bf16(v0[0], v0[1]); w.y = cvt_pk_bf16(v0[2], v0[3]); w.z = cvt_pk_bf16(v1[0], v1[1]); w.w = cvt_pk_bf16(v1[2], v1[3]);
                    *(u32x4*)(rowp + bj * HALF) = w; } }
    }
};
template <class Epi, class Sched, bool ALIGN_EPI = false, bool SP2 = false>
__device__ __forceinline__ void gemm_phase(PG8_LAS unsigned char* lds, const Gemm g, const Sched& S, const Epi& E) {
    int tid_ = threadIdx.x; asm volatile("" : "+v"(tid_));
    const int tid = tid_, wid = __builtin_amdgcn_readfirstlane(tid >> 6), lane = tid & 63, wr = wid >> 2, wc = wid & 3, fr = lane & 15, fq = lane >> 4;
    const int K = g.K, nt = K / BK;
    unsigned voffA[2], voffB[2];
#pragma unroll
    for (int i = 0; i < 2; ++i) { int R, C; stage_rc(tid * 16 + i * 8192, R, C); const int Rb = Epi::PERM ? ((R & ~31) + perm32(R & 31)) : R;
        voffA[i] = (unsigned)(R * K + C) * 2u; voffB[i] = (unsigned)(Rb * K + C) * 2u; }
    const size_t kstep = (size_t)(BK * 2);
    const size_t hstep = (size_t)HALF * K * 2;
    const size_t tstep = 2 * hstep;
    const unsigned ldsw = (unsigned)wid * 1024u;
    const int aoff = lds_byte(wr * 64 + fr, fq * 8), boff = lds_byte(wc * 32 + fr, fq * 8);
#define PG8_SA(b, h) (((b) * 2 + (h)) * HTB)
#define PG8_SB(b, h) ((4 + (b) * 2 + (h)) * HTB)
#define PG8_STAGE(bufoff, gbase, voff) do { _Pragma("unroll") for (int _i = 0; _i < 2; ++_i) \
        __builtin_amdgcn_global_load_lds((const unsigned*)((const char*)(gbase) + (voff)[_i]), (PG8_LAS unsigned*)(lds + (bufoff) + ldsw + _i * 8192), 16, 0, 0); } while (0)
#define PG8_LDA(dst, b, h) do { _Pragma("unroll") for (int m = 0; m < 4; ++m) _Pragma("unroll") for (int k = 0; k < 2; ++k) dst[m][k] = *(const PG8_LAS bf16x8*)(lds + PG8_SA(b, h) + aoff + m * 2048 + k * 1024); } while (0)
#define PG8_LDB(dst, b, h) do { _Pragma("unroll") for (int n = 0; n < 2; ++n) _Pragma("unroll") for (int k = 0; k < 2; ++k) dst[n][k] = *(const PG8_LAS bf16x8*)(lds + PG8_SB(b, h) + boff + n * 2048 + k * 1024); } while (0)
#define PG8_MMA(ai, bj, At, Bt) do { __builtin_amdgcn_s_setprio(1); _Pragma("unroll") for (int m = 0; m < 4; ++m) _Pragma("unroll") for (int n = 0; n < 2; ++n) _Pragma("unroll") for (int k = 0; k < 2; ++k) \
        acc[ai][bj][m][n] = __builtin_amdgcn_mfma_f32_16x16x32_bf16(Bt[n][k], At[m][k], acc[ai][bj][m][n], 0, 0, 0); __builtin_amdgcn_s_setprio(0); } while (0)
#define PG8_WAIT_V(n) asm volatile("s_waitcnt vmcnt(" #n ")" ::: "memory")
#define PG8_WAIT_L(n) asm volatile("s_waitcnt lgkmcnt(" #n ")" ::: "memory")
#define PG8_BAR __builtin_amdgcn_s_barrier()
#define PG8_SCHED __builtin_amdgcn_sched_barrier(0)
    Unit cur, nxt; int ui = 0;
    if (!S.next(0, cur)) return;
    f32x4 acc[2][2][4][2];
#pragma unroll
    for (int a = 0; a < 2; ++a)
#pragma unroll
        for (int b = 0; b < 2; ++b)
#pragma unroll
            for (int m = 0; m < 4; ++m)
#pragma unroll
                for (int n = 0; n < 2; ++n) acc[a][b][m][n] = (f32x4){0.f, 0.f, 0.f, 0.f};
    bf16x8 At[4][2], B0[2][2], B1[2][2];
    const char* cA = (const char*)g.A + (size_t)cur.pm * tstep; const char* cB = (const char*)g.Bt + (size_t)cur.pn * tstep;
    S.a_ready(cur);
    if constexpr (SP2) {
        PG8_STAGE(PG8_SB(0, 0), cB, voffB); PG8_STAGE(PG8_SB(0, 1), cB + hstep, voffB); PG8_STAGE(PG8_SA(0, 0), cA, voffA); PG8_STAGE(PG8_SA(0, 1), cA + hstep, voffA);
        if (wr == 1) PG8_BAR;
        PG8_WAIT_V(2); PG8_BAR;
        PG8_STAGE(PG8_SB(1, 0), cB + kstep, voffB); PG8_STAGE(PG8_SA(1, 0), cA + kstep, voffA); PG8_STAGE(PG8_SB(1, 1), cB + hstep + kstep, voffB);
        PG8_WAIT_V(6); PG8_BAR;
    } else {
        PG8_STAGE(PG8_SB(0, 0), cB, voffB); PG8_STAGE(PG8_SA(0, 0), cA, voffA); PG8_STAGE(PG8_SB(0, 1), cB + hstep, voffB); PG8_STAGE(PG8_SA(0, 1), cA + hstep, voffA);
        if (wr == 1) PG8_BAR;
        PG8_WAIT_V(4); PG8_BAR;
        PG8_STAGE(PG8_SB(1, 0), cB + kstep, voffB); PG8_STAGE(PG8_SA(1, 0), cA + kstep, voffA); PG8_STAGE(PG8_SB(1, 1), cB + hstep + kstep, voffB);
        PG8_WAIT_V(6); PG8_BAR;
    }
    for (;;) {
        const bool has_next = S.next(ui + 1, nxt);
        const char* nA = has_next ? (const char*)g.A + (size_t)nxt.pm * tstep : cA; const char* nB = has_next ? (const char*)g.Bt + (size_t)nxt.pn * tstep : cB;
        for (int t = 0; t < nt; t += 2) {
            const bool last = (t == nt - 2);
            const char* a1 = cA + (size_t)(t + 1) * kstep;
            const char* a2 = last ? nA : cA + (size_t)(t + 2) * kstep; const char* b2 = last ? nB : cB + (size_t)(t + 2) * kstep;
            const char* a3 = a2 + kstep; const char* b3 = b2 + kstep;
            if (last && has_next) S.a_ready(nxt);
            if constexpr (SP2) {
            PG8_LDB(B0, 0, 0); PG8_LDB(B1, 0, 1); PG8_SCHED; PG8_LDA(At, 0, 0); PG8_STAGE(PG8_SA(1, 1), a1 + hstep, voffA);
            PG8_WAIT_V(8); PG8_WAIT_L(0); PG8_BAR; PG8_MMA(0, 0, At, B0); PG8_MMA(0, 1, At, B1); PG8_BAR; PG8_SCHED;
            PG8_LDA(At, 0, 1); PG8_STAGE(PG8_SB(0, 0), b2, voffB); PG8_STAGE(PG8_SB(0, 1), b2 + hstep, voffB); PG8_STAGE(PG8_SA(0, 0), a2, voffA);
            PG8_WAIT_V(8); PG8_WAIT_L(0); PG8_BAR; PG8_MMA(1, 0, At, B0); PG8_MMA(1, 1, At, B1); PG8_BAR; PG8_SCHED;
            PG8_LDB(B0, 1, 0); PG8_LDB(B1, 1, 1); PG8_SCHED; PG8_LDA(At, 1, 0); PG8_STAGE(PG8_SA(0, 1), a2 + hstep, voffA);
            PG8_WAIT_V(8); PG8_WAIT_L(0); PG8_BAR; PG8_MMA(0, 0, At, B0); PG8_MMA(0, 1, At, B1); PG8_BAR; PG8_SCHED;
            PG8_LDA(At, 1, 1); PG8_STAGE(PG8_SB(1, 0), b3, voffB); PG8_STAGE(PG8_SB(1, 1), b3 + hstep, voffB); PG8_STAGE(PG8_SA(1, 0), a3, voffA);
            PG8_WAIT_V(8); PG8_WAIT_L(0); PG8_BAR; PG8_MMA(1, 0, At, B0); PG8_MMA(1, 1, At, B1); PG8_BAR; PG8_SCHED;
            } else {
            PG8_LDB(B0, 0, 0); PG8_SCHED; PG8_LDA(At, 0, 0); PG8_STAGE(PG8_SA(1, 1), a1 + hstep, voffA);
            PG8_WAIT_L(8); PG8_BAR; PG8_WAIT_L(0); PG8_MMA(0, 0, At, B0); PG8_BAR; PG8_SCHED;
            PG8_LDB(B1, 0, 1); PG8_STAGE(PG8_SB(0, 0), b2, voffB);
            PG8_BAR; PG8_WAIT_L(0); PG8_MMA(0, 1, At, B1); PG8_BAR;
            PG8_LDA(At, 0, 1); PG8_STAGE(PG8_SA(0, 0), a2, voffA);
            PG8_BAR; PG8_WAIT_L(0); PG8_MMA(1, 0, At, B0); PG8_BAR; PG8_SCHED;
            PG8_STAGE(PG8_SB(0, 1), b2 + hstep, voffB);
            PG8_WAIT_V(6); PG8_BAR; PG8_MMA(1, 1, At, B1); PG8_BAR;
            PG8_LDB(B0, 1, 0); PG8_SCHED; PG8_LDA(At, 1, 0); PG8_STAGE(PG8_SA(0, 1), a2 + hstep, voffA);
            PG8_WAIT_L(8); PG8_BAR; PG8_WAIT_L(0); PG8_MMA(0, 0, At, B0); PG8_BAR; PG8_SCHED;
            PG8_LDB(B1, 1, 1); PG8_STAGE(PG8_SB(1, 0), b3, voffB);
            PG8_BAR; PG8_WAIT_L(0); PG8_MMA(0, 1, At, B1); PG8_BAR;
            PG8_LDA(At, 1, 1); PG8_STAGE(PG8_SA(1, 0), a3, voffA);
            PG8_BAR; PG8_WAIT_L(0); PG8_MMA(1, 0, At, B0); PG8_BAR; PG8_SCHED;
            PG8_STAGE(PG8_SB(1, 1), b3 + hstep, voffB);
            PG8_WAIT_V(6); PG8_BAR; PG8_MMA(1, 1, At, B1); PG8_BAR;
            }
        }
        if constexpr (ALIGN_EPI) { if (wr == 0) PG8_BAR; }
        if constexpr (!Epi::AFTER_DRAIN) { E(acc, cur, wr, wc, fr, fq); S.done(cur); }
        if (!has_next) break;
#pragma unroll
        for (int a = 0; a < 2; ++a)
#pragma unroll
            for (int b = 0; b < 2; ++b)
#pragma unroll
                for (int m = 0; m < 4; ++m)
#pragma unroll
                    for (int n = 0; n < 2; ++n) acc[a][b][m][n] = (f32x4){0.f, 0.f, 0.f, 0.f};
        cur = nxt; cA = nA; cB = nB; ++ui;
        if constexpr (ALIGN_EPI) { if (wr == 1) PG8_BAR; }
    }
    PG8_WAIT_V(0);
    if constexpr (!ALIGN_EPI) { if (wr == 0) PG8_BAR; }
    PG8_BAR;
    if constexpr (Epi::AFTER_DRAIN) { E.fused(acc, cur, wr, wc, fr, fq, lds, wid, lane); S.done(cur); }
#undef PG8_SA
#undef PG8_SB
#undef PG8_STAGE
#undef PG8_LDA
#undef PG8_LDB
#undef PG8_MMA
#undef PG8_WAIT_V
#undef PG8_WAIT_L
#undef PG8_BAR
#undef PG8_SCHED
}
}
#define LAS __attribute__((address_space(3)))
typedef unsigned short bf16;
typedef short bf16x8 __attribute__((ext_vector_type(8)));
typedef float f32x4 __attribute__((ext_vector_type(4)));
typedef unsigned u32x4 __attribute__((ext_vector_type(4)));
typedef unsigned u32x2 __attribute__((ext_vector_type(2)));
constexpr int SEQ = 2048, DM = 1024, MROWS = 16384, FF = 4096, NINP = 3840, NINL = 3600, NTHR = 512, NWAVE = 8;
constexpr size_t MiB = 1u << 20;
constexpr size_t WS_SS = 0, WS_ROPE = 512 * 1024, WS_N = 1 * MiB, WS_MST = 2 * MiB, WS_G = 3 * MiB;
constexpr size_t WS_WIN = 4 * MiB, WS_WOUT = 19 * MiB, WS_WUP = 23 * MiB, WS_WDN = 39 * MiB;
constexpr size_t WS_XB = 56 * MiB;
constexpr size_t WS_SSP = 88 * MiB;
constexpr size_t WS_P1O = 93 * MiB, WS_P1ML = 109 * MiB;
constexpr size_t WS_U = 120 * MiB;
constexpr size_t WS_QKM = 120 * MiB, WS_KTM = 152 * MiB, WS_VTM = 168 * MiB, WS_AK = 184 * MiB, WS_VT16 = 200 * MiB, WS_Y = 216 * MiB, WS_END = 248 * MiB;
constexpr size_t WS_CTL = 2 * MiB + 256 * 1024, CTL_BYTES = 16384;
constexpr int LDS_BYTES = 147456, LDS_MISC = 131072 + 320;

struct Params {
    const float *x, *norm1_g, *w_in, *conv_w, *gate_i_b, *gate_f_b, *head_norm_g, *w_out, *norm2_g, *w_up, *w_down, *final_g;
    float* out; unsigned char* ws;
};

__device__ __forceinline__ unsigned pk2(float lo, float hi) { return pg8::cvt_pk_bf16(lo, hi); }
__device__ __forceinline__ float bflo(unsigned w) { return __uint_as_float(w << 16); }
__device__ __forceinline__ float bfhi(unsigned w) { return __uint_as_float(w & 0xffff0000u); }
__device__ __forceinline__ float wave_sum(float v) {
#pragma unroll
    for (int o = 1; o < 64; o <<= 1) v += __shfl_xor(v, o);
    return v;
}
__device__ __forceinline__ float wave_max(float v) {
#pragma unroll
    for (int o = 1; o < 64; o <<= 1) v = fmaxf(v, __shfl_xor(v, o));
    return v;
}
__device__ __forceinline__ float wave_incl_scan(float v, int lane) {
#pragma unroll
    for (int o = 1; o < 64; o <<= 1) { const float t = __shfl_up(v, o); if (lane >= o) v += t; }
    return v;
}

#define DPP_STEP_ADD(v, ctrl, rm) do { const int t_ = __builtin_amdgcn_update_dpp(0, __float_as_int(v), (ctrl), (rm), 0xf, false); v += __int_as_float(t_); } while (0)
#define DPP_STEP_MAX(v, ctrl, rm) do { const int t_ = __builtin_amdgcn_update_dpp((int)0xff800000, __float_as_int(v), (ctrl), (rm), 0xf, false); v = fmaxf(v, __int_as_float(t_)); } while (0)
__device__ __forceinline__ float wave_incl_scan_dpp(float v) {
    DPP_STEP_ADD(v, 0x111, 0xf); DPP_STEP_ADD(v, 0x112, 0xf); DPP_STEP_ADD(v, 0x114, 0xf); DPP_STEP_ADD(v, 0x118, 0xf); DPP_STEP_ADD(v, 0x142, 0xa); DPP_STEP_ADD(v, 0x143, 0xc);
    return v;
}
__device__ __forceinline__ float wave_incl_max_dpp(float v) {
    DPP_STEP_MAX(v, 0x111, 0xf); DPP_STEP_MAX(v, 0x112, 0xf); DPP_STEP_MAX(v, 0x114, 0xf); DPP_STEP_MAX(v, 0x118, 0xf); DPP_STEP_MAX(v, 0x142, 0xa); DPP_STEP_MAX(v, 0x143, 0xc);
    return v;
}
__device__ __forceinline__ float wave_max_dpp(float v) {
    DPP_STEP_MAX(v, 0x111, 0xf); DPP_STEP_MAX(v, 0x112, 0xf); DPP_STEP_MAX(v, 0x114, 0xf); DPP_STEP_MAX(v, 0x118, 0xf); DPP_STEP_MAX(v, 0x142, 0xa); DPP_STEP_MAX(v, 0x143, 0xc);
    return __int_as_float(__builtin_amdgcn_readlane(__float_as_int(v), 63));
}
#define MFMA16(a, b, c) __builtin_amdgcn_mfma_f32_16x16x32_bf16((a), (b), (c), 0, 0, 0)

__device__ __forceinline__ int win_src_col(int nb, int& nvalid) {
    nvalid = 32;
    if (nb < 2048) return nb;
    if (nb < 3072) { int xx = nb - 2048; const int isk = xx >> 9; xx &= 511; const int T = xx >> 8, bj = (xx >> 7) & 1, hl = (xx >> 5) & 3; return 2064 + isk * 512 + 64 * (4 * T + hl) + 32 * bj; }
    if (nb < 3584) return 3088 + (nb - 3072);
    if (nb == 3584) { nvalid = 16; return 2048; }
    nvalid = 0; return 0;
}
__device__ __forceinline__ void transpose_item(const float* W, int K, int Nsrc, int src_col, int nvalid, const float* g, bf16* WT, int dst_row, int k0, LAS float* scr, int lane) {
    const int c = lane & 31;
    float wv[32];
#pragma unroll
    for (int i = 0; i < 32; ++i) { const int kk = 2 * i + (lane >> 5); wv[i] = (c < nvalid) ? W[(size_t)(k0 + kk) * Nsrc + src_col + c] : 0.f; }
    if (g) {
#pragma unroll
        for (int i = 0; i < 32; ++i) wv[i] *= g[k0 + 2 * i + (lane >> 5)]; }
#pragma unroll
    for (int i = 0; i < 32; ++i) scr[(2 * i + (lane >> 5)) * 33 + c] = wv[i];
    asm volatile("s_waitcnt lgkmcnt(0)" ::: "memory");
    const int ch = lane & 7;
#pragma unroll
    for (int j = 0; j < 4; ++j) { const int n = (lane >> 3) + 8 * j; const LAS float* s = scr + (8 * ch) * 33 + n;
        u32x4 o; o.x = pk2(s[0 * 33], s[1 * 33]); o.y = pk2(s[2 * 33], s[3 * 33]); o.z = pk2(s[4 * 33], s[5 * 33]); o.w = pk2(s[6 * 33], s[7 * 33]);
        *(u32x4*)(WT + (size_t)(dst_row + n) * K + k0 + 8 * ch) = o; }
    asm volatile("s_waitcnt lgkmcnt(0)" ::: "memory");
}
constexpr int I_IN = 16 * (NINP / 32), I_OUT = 16 * 32, I_UP = 16 * 128, I_DN = 64 * 32, I_L = I_IN + I_OUT + I_UP + I_DN;
__device__ __forceinline__ void convert_item(const Params& p, int it, LAS float* scr, int lane) {
    const int l = it / I_L; int r = it % I_L;
    if (r < I_IN) { const int nblk = NINP / 32, kb = r / nblk, nb = (r % nblk) * 32; int nv; const int sc = win_src_col(nb, nv);
        transpose_item(p.w_in + (size_t)l * DM * NINL, DM, NINL, sc, nv, p.norm1_g + l * DM, (bf16*)(p.ws + WS_WIN) + (size_t)l * NINP * DM, nb, kb * 64, scr, lane); return; }
    r -= I_IN;
    if (r < I_OUT) { const int kb = r / 32, nb = (r % 32) * 32;
        transpose_item(p.w_out + (size_t)l * DM * DM, DM, DM, nb, 32, nullptr, (bf16*)(p.ws + WS_WOUT) + (size_t)l * DM * DM, nb, kb * 64, scr, lane); return; }
    r -= I_OUT;
    if (r < I_UP) { const int kb = r / 128, nb = (r % 128) * 32;
        transpose_item(p.w_up + (size_t)l * DM * FF, DM, FF, nb, 32, p.norm2_g + l * DM, (bf16*)(p.ws + WS_WUP) + (size_t)l * FF * DM, nb, kb * 64, scr, lane); return; }
    r -= I_UP;
    { const int kb = r / 32, nb = (r % 32) * 32;
        transpose_item(p.w_down + (size_t)l * FF * DM, FF, DM, nb, 32, nullptr, (bf16*)(p.ws + WS_WDN) + (size_t)l * DM * FF, nb, kb * 64, scr, lane); }
}
__device__ __forceinline__ void p0_prologue(const Params& p, LAS unsigned char* lds, int wave, int lane, int G, int n_items) {
    LAS float* scr = (LAS float*)(lds + wave * 16384);
    const int gw = blockIdx.x * NWAVE + wave, NGW = G * NWAVE;
    if (n_items < 0) { constexpr int I_A = I_IN + I_OUT;
        for (int j = gw; j < 2 * I_A; j += NGW) convert_item(p, (j / I_A) * I_L + (j % I_A), scr, lane); }
    else for (int it = gw; it < n_items; it += NGW) convert_item(p, it, scr, lane);
    float* ss = (float*)(p.ws + WS_SSP); bf16* xb = (bf16*)(p.ws + WS_XB);
    for (int m0 = gw; m0 < MROWS; m0 += 2 * NGW) {
        f32x4 v[2][4];
#pragma unroll
        for (int q = 0; q < 2; ++q) { const int m = (m0 + q * NGW < MROWS) ? m0 + q * NGW : m0; const f32x4* xr = (const f32x4*)(p.x + (size_t)m * DM) + lane;
#pragma unroll
            for (int j = 0; j < 4; ++j) v[q][j] = xr[64 * j]; }
#pragma unroll
        for (int q = 0; q < 2; ++q) { const int m = m0 + q * NGW; if (m < MROWS) { float s = 0.f; u32x2* o8 = (u32x2*)(xb + (size_t)m * DM) + lane;
#pragma unroll
            for (int j = 0; j < 4; ++j) { const f32x4 t = v[q][j]; s += (t[0] * t[0] + t[1] * t[1]) + (t[2] * t[2] + t[3] * t[3]); u32x2 w; w.x = pk2(t[0], t[1]); w.y = pk2(t[2], t[3]); o8[64 * j] = w; }
            s = wave_sum(s); if (lane < 16) ss[(size_t)m * 16 + lane] = (lane == 0) ? s : 0.f; } }
    }
    const int gt = blockIdx.x * NTHR + threadIdx.x, NGT = G * NTHR;
    float* rc = (float*)(p.ws + WS_ROPE); float* rsn = rc + SEQ * 32;
    for (int i = gt; i < SEQ * 32; i += NGT) { const int pos = i >> 5, fi = i & 31;
        const float inv = exp2f(-(float)fi * (13.287712379549449f / 32.0f)); const float ang = (float)pos * inv;
        const float n = rintf(ang * 0.15915494309189535f); float rr = fmaf(-n, 6.2831854820251465f, ang); rr = fmaf(-n, -1.7484555e-7f, rr);
        rc[i] = __cosf(rr); rsn[i] = __sinf(rr); }
}

struct ScanLd { u32x4 kc[2]; unsigned kb[2], ka[2]; float li, lf; };
__device__ __forceinline__ void scan_load(ScanLd& L, const bf16* Krow, const bf16* Vrow, const float* Gp, int tok0, int fq, int lane, int gcol) {
    L.li = Gp[(size_t)(tok0 + lane) * 16 + gcol]; L.lf = Gp[(size_t)(tok0 + lane) * 16 + 8 + gcol];
#pragma unroll
    for (int ks = 0; ks < 2; ++ks) { const int base = tok0 + 32 * ks + 8 * fq;
        L.kc[ks] = *(const u32x4*)(Krow + base);
        L.kb[ks] = (base >= 2) ? *(const unsigned*)(Krow + base - 2) : 0u;
        L.ka[ks] = (base + 8 < SEQ) ? *(const unsigned*)(Krow + base + 8) : 0u; }
}
__device__ __forceinline__ void scan_wave(const Params& p, int layer, int sw, LAS float* wl, int lane, bool bar_mid) {
    const int ksl = sw & 7, dir = (sw >> 3) & 1, hh = (sw >> 4) & 3, b = sw >> 6;
    const int fr = lane & 15, fq = lane >> 4, kdim = 16 * ksl + fr;
    const float* cw = p.conv_w + (size_t)layer * 5 * 1024 + 512 + hh * 128 + kdim;
    float cwt[5];
#pragma unroll
    for (int t = 0; t < 5; ++t) cwt[t] = cw[t * 1024];
    const bf16* Krow = (const bf16*)(p.ws + WS_KTM) + ((size_t)((b * 4 + hh) * 128 + kdim)) * SEQ;
    const bf16* Vrow = (const bf16*)(p.ws + WS_VTM) + ((size_t)((b * 4 + hh) * 128 + fr)) * SEQ;
    const float* Gp = (const float*)(p.ws + WS_G) + (size_t)b * SEQ * 16;
    const int gcol = dir * 4 + hh;
    bf16* Ct = (bf16*)p.out; float* Nst = (float*)(p.ws + WS_N); float* Mst = (float*)(p.ws + WS_MST);
    const f32x4 z4 = {0.f, 0.f, 0.f, 0.f};
    f32x4 C[8], CN = z4; float mrun = -1e30f;
#pragma unroll
    for (int nt = 0; nt < 8; ++nt) C[nt] = z4;
    const bf16x8 ones = {0x3F80, 0x3F80, 0x3F80, 0x3F80, 0x3F80, 0x3F80, 0x3F80, 0x3F80};
    ScanLd cur, nxt;
    scan_load(cur, Krow, Vrow, Gp, (dir ? 31 : 0) * 64, fq, lane, gcol);
    for (int cs = 0; cs < 32; ++cs) {
        if (bar_mid && cs == 14) __syncthreads();
        const int pc = dir ? 31 - cs : cs;
        bf16x8 vv[8][2];
#pragma unroll
        for (int ks = 0; ks < 2; ++ks)
#pragma unroll
            for (int nt = 0; nt < 8; ++nt) vv[nt][ks] = *(const bf16x8*)(Vrow + (size_t)nt * 16 * SEQ + pc * 64 + 32 * ks + 8 * fq);
        if (cs + 1 < 32) scan_load(nxt, Krow, Vrow, Gp, (dir ? 30 - cs : cs + 1) * 64, fq, lane, gcol); else nxt = cur;
        const float pre = wave_incl_scan_dpp(cur.lf); const float total = __int_as_float(__builtin_amdgcn_readlane(__float_as_int(pre), 63));
        const float g = dir ? (pre - cur.lf + cur.li) : (total - pre + cur.li);
        const float gmax = wave_max_dpp(g);
        const float mn = fmaxf(total + mrun, gmax); const float decay = __expf(total + mrun - mn); const float w = __expf(g - mn);
        const size_t sidx = (size_t)((b * 4 + hh) * 2 + dir) * 32 + pc;
        { bf16* Cd = Ct + sidx * 16384 + (size_t)fr * 128 + 16 * ksl + 4 * fq;
#pragma unroll
          for (int nt = 0; nt < 8; ++nt) { u32x2 w0; w0.x = pk2(C[nt][0], C[nt][1]); w0.y = pk2(C[nt][2], C[nt][3]); *(u32x2*)(Cd + nt * 16 * 128) = w0; }
          if (fr == 0) *(f32x4*)(Nst + sidx * 128 + 16 * ksl + 4 * fq) = CN;
          if (ksl == 0 && lane == 0) Mst[sidx] = mrun; }
        wl[lane] = w;
        asm volatile("s_waitcnt lgkmcnt(0)" ::: "memory");
        bf16x8 afr[2];
#pragma unroll
        for (int ks = 0; ks < 2; ++ks) {
            const f32x4 wa = *(const LAS f32x4*)(wl + 32 * ks + 8 * fq), wb = *(const LAS f32x4*)(wl + 32 * ks + 8 * fq + 4);
            float r[12]; r[0] = bflo(cur.kb[ks]); r[1] = bfhi(cur.kb[ks]);
#pragma unroll
            for (int q = 0; q < 4; ++q) { r[2 + 2 * q] = bflo(cur.kc[ks][q]); r[3 + 2 * q] = bfhi(cur.kc[ks][q]); }
            r[10] = bflo(cur.ka[ks]); r[11] = bfhi(cur.ka[ks]);
            float o[8];
#pragma unroll
            for (int j = 0; j < 8; ++j) { float a = 0.f;
#pragma unroll
                for (int t = 0; t < 5; ++t) a = fmaf(cwt[t], r[j + t], a);
                a = a * __builtin_amdgcn_rcpf(1.0f + __expf(-a)); o[j] = a * 0.08838834764831845f * (j < 4 ? wa[j] : wb[j - 4]); }
            u32x4 pw; pw.x = pk2(o[0], o[1]); pw.y = pk2(o[2], o[3]); pw.z = pk2(o[4], o[5]); pw.w = pk2(o[6], o[7]);
            afr[ks] = __builtin_bit_cast(bf16x8, pw);
        }
        asm volatile("" ::: "memory");
        CN = CN * decay;
#pragma unroll
        for (int nt = 0; nt < 8; ++nt) { C[nt] = C[nt] * decay; C[nt] = MFMA16(afr[0], vv[nt][0], C[nt]); C[nt] = MFMA16(afr[1], vv[nt][1], C[nt]); }
        CN = MFMA16(afr[0], ones, CN); CN = MFMA16(afr[1], ones, CN);
        mrun = mn; cur = nxt;
    }
}

__device__ __forceinline__ void tile_par(int T, int f, int r, int L0, int& R, int& Lb, int& dsh) {
    if (T < 10) { dsh = 4; R = r; Lb = L0 - 64 + 16 * T + 4 * f; }
    else if (T < 22) { dsh = 2; R = 4 * f + (r & 3); Lb = L0 - 16 + 4 * (T - 10); }
    else { const int xx = T - 22; dsh = 0; R = 4 * (xx & 3) + f; Lb = L0 - 4 + 4 * (xx >> 2); }
}
template <int LIM> __device__ __forceinline__ void attn_step(f32x4 (&O)[4], float& mrun, float& lsum, const bf16x8 (&qf)[2], const bf16x8 k00, const bf16x8 k01, const bf16x8 k10, const bf16x8 k11,
                                                             const u32x2 (&v0)[4], const u32x2 (&v1)[4], int D0, int D1, bool ok0, bool ok1) {
    const f32x4 z4 = {0.f, 0.f, 0.f, 0.f};
    f32x4 s0 = MFMA16(k00, qf[0], z4); s0 = MFMA16(k01, qf[1], s0);
    f32x4 s1 = MFMA16(k10, qf[0], z4); s1 = MFMA16(k11, qf[1], s1);
    bool va[4], vb[4];
#pragma unroll
    for (int j = 0; j < 4; ++j) { va[j] = ok0 && ((unsigned)(D0 + 16 * j) <= (unsigned)(2 * LIM)); vb[j] = ok1 && ((unsigned)(D1 + 16 * j) <= (unsigned)(2 * LIM));
        s0[j] = va[j] ? s0[j] : -1e30f; s1[j] = vb[j] ? s1[j] : -1e30f; }
    float tm = fmaxf(fmaxf(fmaxf(s0[0], s0[1]), fmaxf(s0[2], s0[3])), fmaxf(fmaxf(s1[0], s1[1]), fmaxf(s1[2], s1[3])));
    tm = fmaxf(tm, __shfl_xor(tm, 16)); tm = fmaxf(tm, __shfl_xor(tm, 32));
    const float mn = fmaxf(mrun, tm);
    if (__any(mn > mrun)) { const float sc = __builtin_amdgcn_exp2f(mrun - mn); lsum *= sc;
#pragma unroll
        for (int d = 0; d < 4; ++d) O[d] = O[d] * sc; }
    mrun = mn;
    float pv[8]; float ps = 0.f;
#pragma unroll
    for (int j = 0; j < 4; ++j) { pv[j] = va[j] ? __builtin_amdgcn_exp2f(s0[j] - mn) : 0.f; pv[4 + j] = vb[j] ? __builtin_amdgcn_exp2f(s1[j] - mn) : 0.f; ps += pv[j] + pv[4 + j]; }
    lsum += ps;
    u32x4 pw; pw.x = pk2(pv[0], pv[1]); pw.y = pk2(pv[2], pv[3]); pw.z = pk2(pv[4], pv[5]); pw.w = pk2(pv[6], pv[7]);
    const bf16x8 pb = __builtin_bit_cast(bf16x8, pw);
#pragma unroll
    for (int d = 0; d < 4; ++d) { u32x4 vw; vw.x = v0[d].x; vw.y = v0[d].y; vw.z = v1[d].x; vw.w = v1[d].y; O[d] = MFMA16(__builtin_bit_cast(bf16x8, vw), pb, O[d]); }
}
#define KLD(ptr, lo, hi) do { lo = *(const bf16x8*)(ptr); hi = *(const bf16x8*)((ptr) + 32); } while (0)
#define VLD(ptr, v) do { _Pragma("unroll") for (int d_ = 0; d_ < 4; ++d_) v[d_] = *(const u32x2*)((ptr) + d_ * 64); } while (0)
__device__ __forceinline__ void attn_pair(const Params& p, int b, int h, int p0, int r0, int lane) {
    const int fr = lane & 15, fq = lane >> 4, fK = fr >> 2, jK = fr & 3; const int L0 = p0 >> 4;
    const f32x4 z4 = {0.f, 0.f, 0.f, 0.f};
    bf16* Yrow[2]; bf16x8 qf[2][2]; f32x4 O[2][4]; float mrun[2], lsum[2];
    const bf16* Kb = (const bf16*)(p.ws + WS_AK) + (ptrdiff_t)b * SEQ * 512 + h * 64 + 8 * fq;
    const bf16* Vb = (const bf16*)(p.ws + WS_VT16) + (ptrdiff_t)(b * 8 + h) * 131072 + fr * 4;
#pragma unroll
    for (int u = 0; u < 2; ++u) { const int pq = p0 + 16 * fr + r0 + 4 * u; Yrow[u] = (bf16*)(p.ws + WS_Y) + ((size_t)(b * SEQ + pq)) * 1024 + 512 + h * 64;
        qf[u][0] = *(const bf16x8*)(Yrow[u] + 8 * fq); qf[u][1] = *(const bf16x8*)(Yrow[u] + 32 + 8 * fq); mrun[u] = -1e30f; lsum[u] = 0.f;
#pragma unroll
        for (int d = 0; d < 4; ++d) O[u][d] = z4; }
    {
        const bf16* kp = Kb + (ptrdiff_t)(16 * (L0 - 64 + 4 * fK + jK) + r0) * 512;
        const bf16* vp = Vb + (ptrdiff_t)(r0 * 32 + (L0 >> 2) - 16 + fq) * 256;
        for (int pp = 0; pp < 5; ++pp) { const int T0 = 2 * pp; const int lq = L0 - 64 + 16 * T0;
            if (lq + 31 < 0 || lq >= 128) continue;
            const int D0 = 16 * (-64 + 16 * T0 + 4 * fq - fr) + 1024; const bool ok0 = (unsigned)(lq + 4 * fq) < 128u, ok1 = (unsigned)(lq + 16 + 4 * fq) < 128u;
            const bf16* k0p = kp + (ptrdiff_t)T0 * 256 * 512; const bf16* v0p = vp + (ptrdiff_t)T0 * 4 * 256;
#pragma unroll
            for (int u = 0; u < 2; ++u) { bf16x8 k00, k01, k10, k11; u32x2 v0[4], v1[4];
                KLD(k0p + u * 4 * 512, k00, k01); VLD(v0p + u * 4 * 32 * 256, v0);
                if (pp < 4) { KLD(k0p + u * 4 * 512 + 256 * 512, k10, k11); VLD(v0p + u * 4 * 32 * 256 + 4 * 256, v1); }
                else { k10 = k00; k11 = k01;
#pragma unroll
                    for (int d_ = 0; d_ < 4; ++d_) v1[d_] = v0[d_]; }
                attn_step<1024>(O[u], mrun[u], lsum[u], qf[u], k00, k01, k10, k11, v0, v1, D0, D0 + 256, ok0, ok1 && (pp < 4)); }
        }
    }
    {
        const bf16* kp = Kb + (ptrdiff_t)(16 * (L0 - 16 + jK) + 4 * fK + (r0 & 3)) * 512;
        const bf16* vp = Vb + (ptrdiff_t)((4 * fq + (r0 & 3)) * 32 + (L0 >> 2) - 4) * 256;
        for (int pp = 0; pp < 6; ++pp) { const int T0 = 2 * pp; const int lb = L0 - 16 + 4 * T0;
            const bool ok0 = (unsigned)lb < 128u, ok1 = (unsigned)(lb + 4) < 128u; if (!ok0 && !ok1) continue;
            const int D0 = 16 * (-16 + 4 * T0 - fr) + 4 * fq - (r0 & ~3) + 256;
            const bf16* k0p = kp + (ptrdiff_t)T0 * 64 * 512; const bf16* v0p = vp + (ptrdiff_t)T0 * 256;
            { bf16x8 k00, k01, k10, k11; u32x2 v0[4], v1[4];
                KLD(k0p, k00, k01); KLD(k0p + 64 * 512, k10, k11); VLD(v0p, v0); VLD(v0p + 256, v1);
                attn_step<256>(O[0], mrun[0], lsum[0], qf[0], k00, k01, k10, k11, v0, v1, D0, D0 + 64, ok0, ok1);
                attn_step<256>(O[1], mrun[1], lsum[1], qf[1], k00, k01, k10, k11, v0, v1, D0 - 4, D0 + 60, ok0, ok1); }
        }
    }
#pragma unroll
    for (int u = 0; u < 2; ++u) { float l2 = lsum[u]; l2 += __shfl_xor(l2, 16); l2 += __shfl_xor(l2, 32); const int pq = p0 + 16 * fr + r0 + 4 * u; const size_t qrow = (size_t)(b * SEQ + pq);
        const float* ml = (const float*)(p.ws + WS_P1ML) + (qrow * 8 + h) * 2; const float m1 = ml[0], l1 = ml[1];
        const float m = fmaxf(mrun[u], m1); const float a2 = __builtin_amdgcn_exp2f(mrun[u] - m), a1 = __builtin_amdgcn_exp2f(m1 - m) * l1; const float rden = 1.0f / (l2 * a2 + a1);
        const bf16* o1p = (const bf16*)(p.ws + WS_P1O) + qrow * 512 + h * 64 + 4 * fq;
#pragma unroll
        for (int d = 0; d < 4; ++d) { const u32x2 ow = *(const u32x2*)(o1p + 16 * d); u32x2 w;
            w.x = pk2((O[u][d][0] * a2 + bflo(ow.x) * a1) * rden, (O[u][d][1] * a2 + bfhi(ow.x) * a1) * rden); w.y = pk2((O[u][d][2] * a2 + bflo(ow.y) * a1) * rden, (O[u][d][3] * a2 + bfhi(ow.y) * a1) * rden);
            *(u32x2*)(Yrow[u] + 16 * d + 4 * fq) = w; } }
}
__device__ __forceinline__ void attn_quad_d1(const Params& p, int b, int h, int L, int lane) {
    const int fr = lane & 15, fq = lane >> 4, fK = fr >> 2, jK = fr & 3;
    const f32x4 z4 = {0.f, 0.f, 0.f, 0.f};
    bf16x8 qf[4][2]; f32x4 O[4][4]; float mrun[4], lsum[4];
    const bf16* Kb = (const bf16*)(p.ws + WS_AK) + (ptrdiff_t)b * SEQ * 512 + h * 64 + 8 * fq;
    const bf16* Vb = (const bf16*)(p.ws + WS_VT16) + (ptrdiff_t)(b * 8 + h) * 131072 + fr * 4;
#pragma unroll
    for (int i = 0; i < 4; ++i) { const bf16* qrow = (const bf16*)(p.ws + WS_Y) + ((size_t)(b * SEQ + 16 * (L + i) + fr)) * 1024 + 512 + h * 64;
        qf[i][0] = *(const bf16x8*)(qrow + 8 * fq); qf[i][1] = *(const bf16x8*)(qrow + 32 + 8 * fq); mrun[i] = -1e30f; lsum[i] = 0.f;
#pragma unroll
        for (int d = 0; d < 4; ++d) O[i][d] = z4; }
    const bf16* kp = Kb + (ptrdiff_t)(16 * (L - 4 + jK) + fK) * 512;
    const bf16* vp = Vb + (ptrdiff_t)(fq * 32 + (L >> 2) - 1) * 256;
    for (int kb = 0; kb < 3; ++kb) { const int lb = L - 4 + 4 * kb; if ((unsigned)lb >= 128u) continue;
#pragma unroll
        for (int th = 0; th < 2; ++th) { const int t0 = 2 * th;
            const int D0 = 16 * (-4 + 4 * kb) + 4 * t0 + fq - fr + 64;
            const bf16* k0p = kp + (ptrdiff_t)(64 * kb + 4 * t0) * 512; const bf16* v0p = vp + (ptrdiff_t)(128 * t0 + kb) * 256;
            bf16x8 k00, k01, k10, k11; u32x2 v0[4], v1[4];
            KLD(k0p, k00, k01); KLD(k0p + 4 * 512, k10, k11); VLD(v0p, v0); VLD(v0p + 128 * 256, v1);
#pragma unroll
            for (int i = 0; i < 4; ++i) { attn_step<64>(O[i], mrun[i], lsum[i], qf[i], k00, k01, k10, k11, v0, v1, D0 - 16 * i, D0 - 16 * i + 4, true, true); if (i & 1) __builtin_amdgcn_sched_barrier(0); } }
    }
#pragma unroll
    for (int i = 0; i < 4; ++i) { float l = lsum[i]; l += __shfl_xor(l, 16); l += __shfl_xor(l, 32); const float rl = 1.0f / l; const size_t qrow = (size_t)(b * SEQ + 16 * (L + i) + fr);
        bf16* o1p = (bf16*)(p.ws + WS_P1O) + qrow * 512 + h * 64 + 4 * fq;
#pragma unroll
        for (int d = 0; d < 4; ++d) { u32x2 w; w.x = pk2(O[i][d][0] * rl, O[i][d][1] * rl); w.y = pk2(O[i][d][2] * rl, O[i][d][3] * rl); *(u32x2*)(o1p + 16 * d) = w; }
        if (fq == 0) { float* ml = (float*)(p.ws + WS_P1ML) + (qrow * 8 + h) * 2; ml[0] = mrun[i]; ml[1] = l; } }
}
constexpr int QS_OFF = 0, KS_OFF = 17408, PF_OFF = 34816, PB_OFF = 44032, FL_OFF = 53248, QPITCH = 272, PPITCH = 144;
__device__ __forceinline__ void mout_unit(const Params& p, int layer, int u, LAS unsigned char* lds, int tid, int wave, int lane) {
    const int b = u >> 7, hh = (u >> 5) & 3, pc = u & 31, tok0 = pc * 64;
    const int fr = lane & 15, fq = lane >> 4;
    LAS float* FL = (LAS float*)(lds + FL_OFF);
    const float* Gp = (const float*)(p.ws + WS_G) + (size_t)(b * SEQ + tok0) * 16;
    const float* Mst = (const float*)(p.ws + WS_MST); const float* Nst = (const float*)(p.ws + WS_N);
    const bf16* Ct = (const bf16*)p.out;
    const size_t sid0 = (size_t)((b * 4 + hh) * 2 + 0) * 32 + pc, sid1 = (size_t)((b * 4 + hh) * 2 + 1) * 32 + pc;
    bf16x8 vaf[2], caf[2][4];
    { const bf16* Vr = (const bf16*)(p.ws + WS_VTM) + ((size_t)((b * 4 + hh) * 128 + 16 * wave + fr)) * SEQ + tok0;
#pragma unroll
      for (int ks = 0; ks < 2; ++ks) vaf[ks] = *(const bf16x8*)(Vr + 32 * ks + 8 * fq);
#pragma unroll
      for (int d = 0; d < 2; ++d) { const bf16* Cr = Ct + (d ? sid1 : sid0) * 16384 + (size_t)(16 * wave + fr) * 128;
#pragma unroll
          for (int kk = 0; kk < 4; ++kk) caf[d][kk] = *(const bf16x8*)(Cr + 32 * kk + 8 * fq); } }
    if (wave < 2) {
        const int dir = wave; const float li = Gp[lane * 16 + dir * 4 + hh], lf = Gp[lane * 16 + 8 + dir * 4 + hh];
        const float pre = wave_incl_scan_dpp(lf); const float total = __int_as_float(__builtin_amdgcn_readlane(__float_as_int(pre), 63));
        const float bt = dir ? (total - pre + lf) : pre; const float uu = li - bt;
        float pm;
        if (dir == 0) pm = wave_incl_max_dpp(uu); else pm = __shfl(wave_incl_max_dpp(__shfl(uu, 63 - lane)), 63 - lane);
        const float mprev = Mst[dir ? sid1 : sid0]; const float a = bt + mprev; const float mt = fmaxf(a, bt + pm);
        FL[(0 + 2 * dir) * 64 + lane] = bt - mt; FL[(1 + 2 * dir) * 64 + lane] = uu; FL[(4 + dir) * 64 + lane] = __expf(a - mt); FL[(6 + dir) * 64 + lane] = __expf(-mt);
    }
    {
        const bf16* QKm = (const bf16*)(p.ws + WS_QKM); const float* cwl = p.conv_w + (size_t)layer * 5 * 1024;
#pragma unroll
        for (int it4 = 0; it4 < 4; ++it4) { const int it = tid + it4 * NTHR; const int mat = it >> 10, rem = it & 1023, tok = rem >> 4, dg = rem & 15; const int col = mat * 512 + hh * 128 + 8 * dg;
            float a8[8];
#pragma unroll
            for (int j = 0; j < 8; ++j) a8[j] = 0.f;
#pragma unroll
            for (int t = 0; t < 5; ++t) { const int tt = tok0 + tok + t - 2;
                if (tt >= 0 && tt < SEQ) { const u32x4 xx = *(const u32x4*)(QKm + (size_t)(b * SEQ + tt) * 1024 + col);
                    const f32x4 w0 = *(const f32x4*)(cwl + t * 1024 + col), w1 = *(const f32x4*)(cwl + t * 1024 + col + 4);
                    a8[0] = fmaf(w0[0], bflo(xx.x), a8[0]); a8[1] = fmaf(w0[1], bfhi(xx.x), a8[1]); a8[2] = fmaf(w0[2], bflo(xx.y), a8[2]); a8[3] = fmaf(w0[3], bfhi(xx.y), a8[3]);
                    a8[4] = fmaf(w1[0], bflo(xx.z), a8[4]); a8[5] = fmaf(w1[1], bfhi(xx.z), a8[5]); a8[6] = fmaf(w1[2], bflo(xx.w), a8[6]); a8[7] = fmaf(w1[3], bfhi(xx.w), a8[7]); } }
            const float sc = mat ? 0.08838834764831845f : 1.0f;
#pragma unroll
            for (int j = 0; j < 8; ++j) a8[j] = a8[j] * __builtin_amdgcn_rcpf(1.0f + __expf(-a8[j])) * sc;
            u32x4 w; w.x = pk2(a8[0], a8[1]); w.y = pk2(a8[2], a8[3]); w.z = pk2(a8[4], a8[5]); w.w = pk2(a8[6], a8[7]);
            *(LAS u32x4*)(lds + (mat ? KS_OFF : QS_OFF) + tok * QPITCH + dg * 16) = w; }
    }
    __syncthreads();
    if (wave < 2) {
        const float* np = Nst + (wave ? sid1 : sid0) * 128; float acc = 0.f;
#pragma unroll
        for (int dg = 0; dg < 16; ++dg) { const u32x4 xx = *(const LAS u32x4*)(lds + QS_OFF + lane * QPITCH + dg * 16); const f32x4 n0 = *(const f32x4*)(np + 8 * dg), n1 = *(const f32x4*)(np + 8 * dg + 4);
            acc += bflo(xx.x) * n0[0] + bfhi(xx.x) * n0[1] + bflo(xx.y) * n0[2] + bfhi(xx.y) * n0[3] + bflo(xx.z) * n1[0] + bfhi(xx.z) * n1[1] + bflo(xx.w) * n1[2] + bfhi(xx.w) * n1[3]; }
        FL[(16 + wave) * 64 + lane] = acc;
    }
    {
        const int st = wave >> 1, tt0 = 2 * (wave & 1); const f32x4 z4 = {0.f, 0.f, 0.f, 0.f};
        bf16x8 ka[4];
#pragma unroll
        for (int ks = 0; ks < 4; ++ks) ka[ks] = *(const LAS bf16x8*)(lds + KS_OFF + (16 * st + fr) * QPITCH + (32 * ks + 8 * fq) * 2);
#pragma unroll
        for (int q = 0; q < 2; ++q) { const int t = 16 * (tt0 + q) + fr; f32x4 s = z4;
#pragma unroll
            for (int ks = 0; ks < 4; ++ks) { const bf16x8 qb = *(const LAS bf16x8*)(lds + QS_OFF + t * QPITCH + (32 * ks + 8 * fq) * 2); s = MFMA16(ka[ks], qb, s); }
            const float cf = FL[0 * 64 + t], cb = FL[2 * 64 + t]; float pf[4], pb[4]; float rf = 0.f, rb = 0.f;
#pragma unroll
            for (int j = 0; j < 4; ++j) { const int si = 16 * st + 4 * fq + j; const float uf = FL[1 * 64 + si], ub = FL[3 * 64 + si];
                pf[j] = (si <= t) ? s[j] * __expf(cf + uf) : 0.f; pb[j] = (si >= t) ? s[j] * __expf(cb + ub) : 0.f; rf += pf[j]; rb += pb[j]; }
            u32x2 w; w.x = pk2(pf[0], pf[1]); w.y = pk2(pf[2], pf[3]); *(LAS u32x2*)(lds + PF_OFF + t * PPITCH + (16 * st + 4 * fq) * 2) = w;
            w.x = pk2(pb[0], pb[1]); w.y = pk2(pb[2], pb[3]); *(LAS u32x2*)(lds + PB_OFF + t * PPITCH + (16 * st + 4 * fq) * 2) = w;
            rf += __shfl_xor(rf, 16); rf += __shfl_xor(rf, 32); rb += __shfl_xor(rb, 16); rb += __shfl_xor(rb, 32);
            if (fq == 0) { FL[(8 + st) * 64 + t] = rf; FL[(12 + st) * 64 + t] = rb; } }
    }
    __syncthreads();
    f32x4 aI[2][4], aX[2][4];
    {
        const f32x4 z4 = {0.f, 0.f, 0.f, 0.f};
#pragma unroll
        for (int d = 0; d < 2; ++d)
#pragma unroll
            for (int tt = 0; tt < 4; ++tt) { aI[d][tt] = z4; aX[d][tt] = z4; }
#pragma unroll
        for (int ks = 0; ks < 2; ++ks) { const bf16x8 va = vaf[ks];
#pragma unroll
            for (int tt = 0; tt < 4; ++tt) { const bf16x8 pfb = *(const LAS bf16x8*)(lds + PF_OFF + (16 * tt + fr) * PPITCH + (32 * ks + 8 * fq) * 2);
                const bf16x8 pbb = *(const LAS bf16x8*)(lds + PB_OFF + (16 * tt + fr) * PPITCH + (32 * ks + 8 * fq) * 2);
                aI[0][tt] = MFMA16(va, pfb, aI[0][tt]); aI[1][tt] = MFMA16(va, pbb, aI[1][tt]); } }
#pragma unroll
        for (int d = 0; d < 2; ++d) {
#pragma unroll
            for (int kk = 0; kk < 4; ++kk) { const bf16x8 ca = caf[d][kk];
#pragma unroll
                for (int tt = 0; tt < 4; ++tt) { const bf16x8 qb = *(const LAS bf16x8*)(lds + QS_OFF + (16 * tt + fr) * QPITCH + (32 * kk + 8 * fq) * 2); aX[d][tt] = MFMA16(ca, qb, aX[d][tt]); } } }
    }
    f32x4 hs[4];
#pragma unroll
    for (int tt = 0; tt < 4; ++tt) { const int t = 16 * tt + fr; const f32x4 z4 = {0.f, 0.f, 0.f, 0.f}; hs[tt] = z4;
#pragma unroll
        for (int d = 0; d < 2; ++d) { const float in = FL[(4 + d) * 64 + t]; const float den = ((FL[(8 + 4 * d) * 64 + t] + FL[(9 + 4 * d) * 64 + t]) + (FL[(10 + 4 * d) * 64 + t] + FL[(11 + 4 * d) * 64 + t])) + in * FL[(16 + d) * 64 + t];
            const float rd = 1.0f / fmaxf(fabsf(den), FL[(6 + d) * 64 + t]); hs[tt] += (aI[d][tt] + aX[d][tt] * in) * rd; }
        float sq = (hs[tt][0] * hs[tt][0] + hs[tt][1] * hs[tt][1]) + (hs[tt][2] * hs[tt][2] + hs[tt][3] * hs[tt][3]);
        sq += __shfl_xor(sq, 16); sq += __shfl_xor(sq, 32);
        if (fq == 0) FL[(18 + wave) * 64 + t] = sq; }
    __syncthreads();
    {
        const f32x4 hg = *(const f32x4*)(p.head_norm_g + layer * 512 + hh * 128 + 16 * wave + 4 * fq);
#pragma unroll
        for (int tt = 0; tt < 4; ++tt) { const int t = 16 * tt + fr; const float ssq = ((FL[18 * 64 + t] + FL[19 * 64 + t]) + (FL[20 * 64 + t] + FL[21 * 64 + t])) + ((FL[22 * 64 + t] + FL[23 * 64 + t]) + (FL[24 * 64 + t] + FL[25 * 64 + t])); const float rsd = rsqrtf(ssq * (1.0f / 128.0f) + 1e-6f);
            bf16* yp = (bf16*)(p.ws + WS_Y) + (size_t)(b * SEQ + tok0 + t) * 1024 + hh * 128 + 16 * wave + 4 * fq;
            const u32x2 gt = *(const u32x2*)yp;
            u32x2 w; w.x = pk2(hs[tt][0] * rsd * hg[0] * bflo(gt.x), hs[tt][1] * rsd * hg[1] * bfhi(gt.x)); w.y = pk2(hs[tt][2] * rsd * hg[2] * bflo(gt.y), hs[tt][3] * rsd * hg[3] * bfhi(gt.y));
            *(u32x2*)yp = w; }
    }
    __syncthreads();
}

#define XB_TMO      128
#define XB_XCNT(j)  (256  + 64 * (j))
#define XB_XSUB(j)  (1280 + 64 * (j))
#define XB_XGEN(j)  (2304 + 64 * (j))
#define XB_TOP      3328
#define XB_TOPGEN   3392
#define XCD_BAR_WORDS 3456
#define XB_SPIN_CAP (1u << 18)

__device__ __forceinline__ unsigned xb_ld(unsigned* p)              { return __hip_atomic_load(p, __ATOMIC_RELAXED, __HIP_MEMORY_SCOPE_AGENT); }
__device__ __forceinline__ unsigned xb_add(unsigned* p, unsigned v) { return __hip_atomic_fetch_add(p, v, __ATOMIC_RELAXED, __HIP_MEMORY_SCOPE_AGENT); }
__device__ __forceinline__ unsigned xb_xcc_id() { return (unsigned)__builtin_amdgcn_s_getreg((3 << 11) | 20) & 0xFu; }
#define XB_SPIN(cond, bar) do { unsigned _sp = 0; while (cond) { __builtin_amdgcn_s_sleep(1); \
    if ((++_sp & 255u) == 0u) { if (xb_ld(&(bar)[XB_TMO])) break; if (_sp > XB_SPIN_CAP) { atomicAdd(&(bar)[XB_TMO], 1u); break; } } } } while (0)

struct XcdBarrier {
    unsigned* bar; unsigned x;
    volatile LAS unsigned* st;
};

__device__ __forceinline__ XcdBarrier xcd_barrier_post(unsigned* bar, volatile LAS unsigned* st) {
    XcdBarrier b; b.bar = bar; b.x = xb_xcc_id(); b.st = st;
    if (threadIdx.x == 0) (void)xb_add(&bar[XB_XCNT(b.x)], 1u);
    return b;
}
__device__ __forceinline__ void xcd_barrier_complete(unsigned* bar, unsigned x, unsigned& nloc, unsigned& nx) {
    const unsigned G = gridDim.x * gridDim.y * gridDim.z;
    unsigned sum, cnt, mine, sp = 0u;
    for (;;) {
        sum = 0u; cnt = 0u; mine = 0u;
#pragma unroll
        for (unsigned j = 0; j < 16; ++j) { const unsigned c = xb_ld(&bar[XB_XCNT(j)]); sum += c; cnt += (c > 0u) ? 1u : 0u; mine = (j == x) ? c : mine; }
        if (sum == G) break;
        __builtin_amdgcn_s_sleep(1);
        if ((++sp & 255u) == 0u) { if (xb_ld(&bar[XB_TMO])) break; if (sp > XB_SPIN_CAP) { atomicAdd(&bar[XB_TMO], 1u); break; } }
    }
    nloc = mine > 0u ? mine : 1u; nx = cnt > 0u ? cnt : 1u;
}

__device__ __forceinline__ void xcd_barrier(const XcdBarrier& b) {
    asm volatile("s_waitcnt vmcnt(0)" ::: "memory");
    __syncthreads();
    if (threadIdx.x == 0) {
        unsigned* bar = b.bar;
        __builtin_amdgcn_s_waitcnt(0);
        unsigned nloc = b.st[0], nx = b.st[1];
        if (nloc == 0u) { xcd_barrier_complete(bar, b.x, nloc, nx); b.st[0] = nloc; b.st[1] = nx; }
        const unsigned old = xb_add(&bar[XB_XSUB(b.x)], 1u);
        const unsigned gen = old / nloc;
        if (old + 1u == (gen + 1u) * nloc) {
            __builtin_amdgcn_fence(__ATOMIC_RELEASE, "agent");
            asm volatile("s_waitcnt vmcnt(0)" ::: "memory");
            const unsigned og = xb_add(&bar[XB_TOP], 1u);
            const unsigned tg = og / nx;
            if (og + 1u == (tg + 1u) * nx) xb_add(&bar[XB_TOPGEN], 1u);
            else XB_SPIN(xb_ld(&bar[XB_TOPGEN]) == tg, bar);
            __builtin_amdgcn_fence(__ATOMIC_ACQUIRE, "agent");
            xb_add(&bar[XB_XGEN(b.x)], 1u);
            asm volatile("s_waitcnt vmcnt(0)" ::: "memory");
        } else {
            XB_SPIN(xb_ld(&bar[XB_XGEN(b.x)]) == gen, bar);
            __builtin_amdgcn_fence(__ATOMIC_ACQUIRE, "agent");
            asm volatile("s_waitcnt vmcnt(0)" ::: "memory");
        }
    }
    __syncthreads();
}

__global__ void __launch_bounds__(NTHR, 2) fwd_megakernel(Params p) {
    extern __shared__ __attribute__((aligned(16))) unsigned char lds_raw[];
    LAS unsigned char* lds = (LAS unsigned char*)lds_raw;
    cg::grid_group grid = cg::this_grid();
#define GRID_SYNC_CG() do { asm volatile("s_waitcnt vmcnt(0) lgkmcnt(0)" ::: "memory"); grid.sync(); \
        __builtin_amdgcn_fence(__ATOMIC_ACQUIRE, "agent"); asm volatile("s_waitcnt vmcnt(0)" ::: "memory"); __syncthreads(); } while (0)
#define GRID_SYNC() do { XcdBarrier xb_; xb_.bar = (unsigned*)(p.ws + WS_CTL); xb_.x = xb_xcc_id(); xb_.st = (volatile LAS unsigned*)(lds + LDS_MISC); xcd_barrier(xb_); } while (0)
    const int tid = threadIdx.x, lane = tid & 63, wave = __builtin_amdgcn_readfirstlane(tid >> 6), G = gridDim.x, bid = blockIdx.x;
    float* ss = (float*)(p.ws + WS_SSP);
    { volatile LAS unsigned* st0 = (volatile LAS unsigned*)(lds + LDS_MISC); if (threadIdx.x < 2) st0[threadIdx.x] = 0u; __syncthreads(); }
    (void)xcd_barrier_post((unsigned*)(p.ws + WS_CTL), (volatile LAS unsigned*)(lds + LDS_MISC));
    bf16* xb = (bf16*)(p.ws + WS_XB);

    const bool defer = (G == 256);
    p0_prologue(p, lds, wave, lane, G, defer ? -1 : 2 * I_L);
    if (G == 0x7fffffff) GRID_SYNC_CG();
    GRID_SYNC();

    for (int layer = 0; layer < 2; ++layer) {
#define RELANE() int tid = threadIdx.x; asm volatile("" : "+v"(tid)); const int lane = tid & 63, wave = __builtin_amdgcn_readfirstlane(tid >> 6)
        {
            pg8::Gemm g{xb, (const bf16*)(p.ws + WS_WIN) + (size_t)layer * NINP * DM, MROWS, NINP, DM};
            pg8::StaticOrder S; S.init(MROWS, NINP, G, bid);
            pg8::EpiIn E{ss + (size_t)(2 * layer) * MROWS * 16, p.ws, p.gate_i_b + layer * 8, p.gate_f_b + layer * 8};
            static_assert(pg8::EpiIn::O_ROPE == WS_ROPE && pg8::EpiIn::O_G == WS_G && pg8::EpiIn::O_QKM == WS_QKM && pg8::EpiIn::O_KTM == WS_KTM && pg8::EpiIn::O_VTM == WS_VTM && pg8::EpiIn::O_AK == WS_AK && pg8::EpiIn::O_VT16 == WS_VT16 && pg8::EpiIn::O_Y == WS_Y, "ws map");
            pg8::gemm_phase<pg8::EpiIn, pg8::StaticOrder, true, true>(lds, g, S, E);
            if (defer && bid >= 192) { RELANE(); LAS float* scr = (LAS float*)(lds + wave * 16384);
                for (int it = layer * I_L + I_IN + I_OUT + (bid - 192) * NWAVE + wave; it < (layer + 1) * I_L; it += 64 * NWAVE) convert_item(p, it, scr, lane); }
        }
        GRID_SYNC();
        {
            RELANE();
            volatile LAS unsigned* ctr = (volatile LAS unsigned*)(lds + LDS_MISC + 16);
            if (tid == 0) *ctr = 0u;
            const int nU = (512 - bid + G - 1) / G;
            const bool fast = (G * 2 == 512);
            if (fast && wave < 2) {
                __builtin_amdgcn_s_setprio(3);
                scan_wave(p, layer, bid * 2 + wave, (LAS float*)(lds + wave * 256), lane, true);
                __builtin_amdgcn_s_setprio(0);
            } else {
                const int w0 = fast ? 2 : 0, nw = fast ? 6 : NWAVE;
                for (int I = wave - w0; I < 4 * nU; I += nw) { const int au = bid + G * (I >> 2); const int b = au >> 6, h = (au >> 3) & 7, p0 = (au & 7) * 256;
                    attn_quad_d1(p, b, h, (p0 >> 4) + 4 * (I & 3), lane); }
                asm volatile("s_waitcnt vmcnt(0)" ::: "memory");
                __syncthreads();
                if (!fast && wave < 2) for (int sw = bid * 2 + wave; sw < 512; sw += G * 2) scan_wave(p, layer, sw, (LAS float*)(lds + wave * 256), lane, false);
            }
            {
                const int nQ = 8 * nU;
                for (;;) { unsigned Q = 0; if (lane == 0) Q = atomicAdd((unsigned*)(lds_raw + LDS_MISC + 16), 1u); Q = (unsigned)__builtin_amdgcn_readfirstlane((int)Q);
                    if ((int)Q >= nQ) break;
                    const int au = bid + G * (int)(Q >> 3); const int b = au >> 6, h = (au >> 3) & 7, p0 = (au & 7) * 256; attn_pair(p, b, h, p0, (int)((Q & 3) + 8 * ((Q >> 2) & 1)), lane); }
            }
        }
        GRID_SYNC();
        { RELANE(); for (int u = bid; u < 1024; u += G) mout_unit(p, layer, u, lds, tid, wave, lane); }
        GRID_SYNC();
        {
            pg8::Gemm g{(const bf16*)(p.ws + WS_Y), (const bf16*)(p.ws + WS_WOUT) + (size_t)layer * DM * DM, MROWS, DM, DM};
            pg8::StaticOrder S; S.init(MROWS, DM, G, bid);
            pg8::EpiRes E{xb, ss + (size_t)(2 * layer + 1) * MROWS * 16};
            pg8::gemm_phase<pg8::EpiRes, pg8::StaticOrder, true, true>(lds, g, S, E);
        }
        GRID_SYNC();
        {
            pg8::Gemm g{xb, (const bf16*)(p.ws + WS_WUP) + (size_t)layer * FF * DM, MROWS, FF, DM};
            pg8::StaticOrder S; S.init(MROWS, FF, G, bid);
            pg8::EpiUp E{ss + (size_t)(2 * layer + 1) * MROWS * 16, (bf16*)(p.ws + WS_U)};
            pg8::gemm_phase<pg8::EpiUp, pg8::StaticOrder, true, true>(lds, g, S, E);
        }
        GRID_SYNC();
        {
            pg8::Gemm g{(const bf16*)(p.ws + WS_U), (const bf16*)(p.ws + WS_WDN) + (size_t)layer * DM * FF, MROWS, DM, FF};
            pg8::StaticOrder S; S.init(MROWS, DM, G, bid);
            pg8::EpiRes E{xb, ss + (size_t)(2 * layer + 2) * MROWS * 16};
            pg8::gemm_phase<pg8::EpiRes, pg8::StaticOrder, true, true>(lds, g, S, E);
        }
        GRID_SYNC();
    }
    {
        RELANE();
        const int gw = bid * NWAVE + wave, NGW = G * NWAVE;
        for (int m = gw; m < MROWS; m += NGW) { const float rsd = rsqrtf(pg8::row_ss(ss + (size_t)4 * MROWS * 16, m) * (1.0f / 1024.0f) + 1e-6f);
            const u32x2* xr = (const u32x2*)(xb + (size_t)m * DM) + lane; f32x4* orow = (f32x4*)(p.out + (size_t)m * DM) + lane; const f32x4* gr = (const f32x4*)p.final_g + lane;
#pragma unroll
            for (int j = 0; j < 4; ++j) { const u32x2 w = xr[64 * j]; const f32x4 g4 = gr[64 * j]; f32x4 o; o[0] = bflo(w.x) * rsd * g4[0]; o[1] = bfhi(w.x) * rsd * g4[1]; o[2] = bflo(w.y) * rsd * g4[2]; o[3] = bfhi(w.y) * rsd * g4[3]; orow[64 * j] = o; } }
    }
}

extern "C" void kernel_launch(void* const* d_in, const int* in_sizes, int n_in, void* d_out, int out_size, void* d_ws, size_t ws_size, hipStream_t stream) {
    static int grid = 0;
    if (grid == 0) {
        int dev = 0, cus = 0, per_cu = 0;
        (void)hipGetDevice(&dev);
        (void)hipDeviceGetAttribute(&cus, hipDeviceAttributeMultiprocessorCount, dev);
        (void)hipFuncSetAttribute((const void*)fwd_megakernel, hipFuncAttributeMaxDynamicSharedMemorySize, LDS_BYTES);
        (void)hipOccupancyMaxActiveBlocksPerMultiprocessor(&per_cu, (const void*)fwd_megakernel, NTHR, LDS_BYTES);
        if (per_cu < 1) per_cu = 1;
        grid = cus * per_cu;
        if (ws_size < WS_END) { fprintf(stderr, "kernel_launch: workspace too small (%zu)\n", ws_size); grid = -1; }
    }
    if (grid < 0) return;
    Params p{};
    p.x = (const float*)d_in[0]; p.norm1_g = (const float*)d_in[1]; p.w_in = (const float*)d_in[2]; p.conv_w = (const float*)d_in[3];
    p.gate_i_b = (const float*)d_in[4]; p.gate_f_b = (const float*)d_in[5]; p.head_norm_g = (const float*)d_in[6]; p.w_out = (const float*)d_in[7];
    p.norm2_g = (const float*)d_in[8]; p.w_up = (const float*)d_in[9]; p.w_down = (const float*)d_in[10]; p.final_g = (const float*)d_in[11];
    p.out = (float*)d_out; p.ws = (unsigned char*)d_ws;
    (void)hipMemsetAsync((char*)d_ws + WS_CTL, 0, CTL_BYTES, stream);
    void* args[] = {&p};
    hipError_t e = hipLaunchCooperativeKernel((void*)fwd_megakernel, dim3(grid), dim3(NTHR), args, LDS_BYTES, stream);
    if (e != hipSuccess) fprintf(stderr, "cooperative launch failed: %s (grid %d)\n", hipGetErrorString(e), grid);
}
```

```cpp
#include <hip/hip_runtime.h>
#include <hip/hip_cooperative_groups.h>
#include <cstdio>
#include <cstdint>
#include <cmath>
namespace cg = cooperative_groups;
namespace pg8 {
#define PG8_LAS __attribute__((address_space(3)))
typedef unsigned short bf16_t;
typedef short bf16x8 __attribute__((ext_vector_type(8)));
typedef float f32x4 __attribute__((ext_vector_type(4)));
typedef unsigned u32x4 __attribute__((ext_vector_type(4)));
constexpr int BM = 256, BK = 64, HALF = 128, HTB = HALF * BK * 2  , STAGE_BYTES = 8 * HTB, NXCD = 8, WGM = 8;

__host__ __device__ __forceinline__ int lds_byte(int r, int c) { const int st = (r >> 4) * 2 + (c >> 5), rr = r & 15, cc = c & 31, ob = rr * 64 + cc * 2; return st * 1024 + (ob ^ (((ob >> 9) & 1) << 5)); }
__host__ __device__ __forceinline__ void stage_rc(int b, int& R, int& C) { const int st = b / 1024, sb = b % 1024, swz = sb ^ (((sb >> 9) & 1) << 5); R = (st >> 1) * 16 + swz / 64; C = (st & 1) * 32 + (swz % 64) / 2; }
__host__ __device__ __forceinline__ int perm32(int rho) { const int n = rho >> 4, i = rho & 15; return 8 * (i >> 2) + 4 * n + (i & 3); }

struct Unit { int pm, pn; };
struct Gemm { const bf16_t* A; const bf16_t* Bt; int M, N, K; };

struct StaticOrder {
    int nM, nN, nwg, G, c;
    __host__ __device__ void init(int M, int N, int G_, int c_) { nM = M / BM; nN = N / BM; nwg = nM * nN; G = G_; c = c_; }
    __host__ __device__ bool next(int i, Unit& u) const {
        const long L = (long)i * G + c; if (L >= nwg) return false;
        int wgid = (int)L; { const int q = nwg / NXCD, r = nwg % NXCD, xcd = wgid % NXCD, off = wgid / NXCD; wgid = (xcd < r ? xcd * (q + 1) : r * (q + 1) + (xcd - r) * q) + off; }
        const int nig = WGM * nN, gid = wgid / nig, fm = gid * WGM, gsz = (nM - fm) < WGM ? (nM - fm) : WGM;
        u.pm = fm + ((wgid % nig) % gsz); u.pn = (wgid % nig) / gsz; return true;
    }
    __device__ __forceinline__ void a_ready(const Unit&) const {}
    __device__ __forceinline__ void done(const Unit&) const {}
};

typedef float f32x2c_t __attribute__((ext_vector_type(2))); typedef __bf16 bf16x2c_t __attribute__((ext_vector_type(2)));
__device__ __forceinline__ unsigned cvt_pk_bf16(float lo, float hi) { f32x2c_t v = {lo, hi}; bf16x2c_t b = __builtin_convertvector(v, bf16x2c_t); return __builtin_bit_cast(unsigned, b); }
typedef float f32x2 __attribute__((ext_vector_type(2)));
__device__ __forceinline__ unsigned short bf16_1(float v) { return (unsigned short)(cvt_pk_bf16(v, v) & 0xffffu); }
__device__ __forceinline__ float row_ss(const float* ssp, int row) { const f32x4* q = (const f32x4*)(ssp + (size_t)row * 16); const f32x4 a = q[0], b = q[1], c = q[2], d = q[3];
    return (((a[0] + a[1]) + (a[2] + a[3])) + ((b[0] + b[1]) + (b[2] + b[3]))) + (((c[0] + c[1]) + (c[2] + c[3])) + ((d[0] + d[1]) + (d[2] + d[3]))); }
__device__ __forceinline__ float row_ss_q(const float* ssp, int row, int fq) { const f32x4 a = *(const f32x4*)(ssp + (size_t)row * 16 + 4 * fq); float t = (a[0] + a[1]) + (a[2] + a[3]);
    t += __shfl_xor(t, 16); t += __shfl_xor(t, 32); return t; }
struct EpiIn {
    static constexpr bool PERM = true, AFTER_DRAIN = false;
    const float* ss; unsigned char* ws; const float* gib; const float* gfb;
    static constexpr size_t O_ROPE = 512 * 1024, O_G = 3u << 20, O_QKM = 120u << 20, O_KTM = 152u << 20, O_VTM = 168u << 20, O_AK = 184u << 20, O_VT16 = 200u << 20, O_Y = 216u << 20;
    __device__ __forceinline__ void operator()(const f32x4 (&acc)[2][2][4][2], const Unit& u, int wr, int wc, int fr_, int fq_) const {
        int fr = fr_, fq = fq_; asm volatile("" : "+v"(fr), "+v"(fq));
        const int pn = u.pn;
        const int rbase = u.pm * BM + wr * 64 + fr;
        float rsv[2][4];
#pragma unroll
        for (int ai = 0; ai < 2; ++ai)
#pragma unroll
            for (int m = 0; m < 4; ++m) rsv[ai][m] = row_ss_q(ss, rbase + ai * HALF + m * 16, fq);
#pragma unroll
        for (int ai = 0; ai < 2; ++ai)
#pragma unroll
            for (int m = 0; m < 4; ++m) rsv[ai][m] = rsqrtf(rsv[ai][m] * (1.0f / 1024.0f) + 1e-6f);
        if (pn < 4) {
            bf16_t* QKm = (bf16_t*)(ws + O_QKM);
#pragma unroll
            for (int ai = 0; ai < 2; ++ai)
#pragma unroll
                for (int m = 0; m < 4; ++m) { const int row = rbase + ai * HALF + m * 16; const float r = rsv[ai][m]; bf16_t* rowp = QKm + (size_t)row * 1024 + pn * 256 + wc * 32 + 8 * fq;
#pragma unroll
                    for (int bj = 0; bj < 2; ++bj) { const f32x4 v0 = acc[ai][bj][m][0] * r, v1 = acc[ai][bj][m][1] * r; u32x4 w;
                        w.x = cvt_pk_bf16(v0[0], v0[1]); w.y = cvt_pk_bf16(v0[2], v0[3]); w.z = cvt_pk_bf16(v1[0], v1[1]); w.w = cvt_pk_bf16(v1[2], v1[3]);
                        *(u32x4*)(rowp + bj * HALF) = w; }
                    asm volatile("" ::: "memory"); }
        }
        if ((pn >= 2 && pn < 6)) {
            const int row0 = u.pm * BM; const int b = row0 >> 11;
            unsigned char* ub = ws + ((pn < 4) ? O_KTM : O_VTM) + ((size_t)(((b * 4 + 2 * (pn & 1)) * 128 + wc * 32) * 2048 + (row0 & 2047) + wr * 64)) * 2;
            const unsigned voff = (unsigned)((8 * fq) * 2048 + fr) * 2u;
#pragma unroll
            for (int ai = 0; ai < 2; ++ai)
#pragma unroll
                for (int m = 0; m < 4; m += 2) { const float r0 = rsv[ai][m], r1 = rsv[ai][m + 1];
#pragma unroll
                    for (int bj = 0; bj < 2; ++bj)
#pragma unroll
                        for (int n = 0; n < 2; ++n)
#pragma unroll
                            for (int j = 0; j < 4; ++j) { const unsigned w = cvt_pk_bf16(acc[ai][bj][m][n][j] * r0, acc[ai][bj][m + 1][n][j] * r1);
                                unsigned char* q = ub + (size_t)(((bj * 128 + 4 * n + j) * 2048 + ai * HALF + m * 16) * 2) + voff;
                                *(bf16_t*)q = (bf16_t)(w & 0xffffu); *(bf16_t*)(q + 32) = (bf16_t)(w >> 16); }
                    asm volatile("" ::: "memory"); }
        } else if (pn == 6 || pn == 7) {
            bf16_t* Y = (bf16_t*)(ws + O_Y);
#pragma unroll
            for (int ai = 0; ai < 2; ++ai)
#pragma unroll
                for (int m = 0; m < 4; ++m) { const int row = rbase + ai * HALF + m * 16; const float r = rsv[ai][m]; bf16_t* rowp = Y + (size_t)row * 1024 + (pn - 6) * 256 + wc * 32 + 8 * fq;
#pragma unroll
                    for (int bj = 0; bj < 2; ++bj) { f32x4 v0 = acc[ai][bj][m][0] * r, v1 = acc[ai][bj][m][1] * r;
#pragma unroll
                        for (int j = 0; j < 4; ++j) { v0[j] = __builtin_amdgcn_rcpf(1.0f + __expf(-v0[j])); v1[j] = __builtin_amdgcn_rcpf(1.0f + __expf(-v1[j])); }
                        u32x4 w; w.x = cvt_pk_bf16(v0[0], v0[1]); w.y = cvt_pk_bf16(v0[2], v0[3]); w.z = cvt_pk_bf16(v1[0], v1[1]); w.w = cvt_pk_bf16(v1[2], v1[3]);
                        *(u32x4*)(rowp + bj * HALF) = w; }
                    asm volatile("" ::: "memory"); }
        } else if (pn >= 8 && pn < 12) {
            const bool isk = pn >= 10; const int head = 4 * (pn & 1) + wc; const float qs = isk ? 1.0f : 0.125f * 1.4426950408889634f;
            const float* ropeC = (const float*)(ws + O_ROPE) + 8 * fq; const float* ropeS = ropeC + 2048 * 32;
            f32x4 tb[2][4];
            { const int pos = rbase & 2047; tb[0][0] = *(const f32x4*)(ropeC + pos * 32); tb[0][1] = *(const f32x4*)(ropeC + pos * 32 + 4); tb[0][2] = *(const f32x4*)(ropeS + pos * 32); tb[0][3] = *(const f32x4*)(ropeS + pos * 32 + 4); }
#pragma unroll
            for (int it = 0; it < 8; ++it) { const int ai = it >> 2, m = it & 3; const int row = rbase + ai * HALF + m * 16; const float r = rsv[ai][m] * qs;
                if (it < 7) { const int pos2 = (rbase + ((it + 1) >> 2) * HALF + ((it + 1) & 3) * 16) & 2047;
                    tb[(it + 1) & 1][0] = *(const f32x4*)(ropeC + pos2 * 32); tb[(it + 1) & 1][1] = *(const f32x4*)(ropeC + pos2 * 32 + 4); tb[(it + 1) & 1][2] = *(const f32x4*)(ropeS + pos2 * 32); tb[(it + 1) & 1][3] = *(const f32x4*)(ropeS + pos2 * 32 + 4); }
                const f32x4 c0 = tb[it & 1][0], c1 = tb[it & 1][1], s0 = tb[it & 1][2], s1 = tb[it & 1][3];
                const f32x4 a0 = acc[ai][0][m][0] * r, a1 = acc[ai][0][m][1] * r, b0 = acc[ai][1][m][0] * r, b1 = acc[ai][1][m][1] * r;
                const f32x4 o10 = a0 * c0 - b0 * s0, o11 = a1 * c1 - b1 * s1, o20 = a0 * s0 + b0 * c0, o21 = a1 * s1 + b1 * c1;
                bf16_t* dst = isk ? ((bf16_t*)(ws + O_AK) + (size_t)row * 512 + head * 64 + 8 * fq) : ((bf16_t*)(ws + O_Y) + (size_t)row * 1024 + 512 + head * 64 + 8 * fq);
                u32x4 w; w.x = cvt_pk_bf16(o10[0], o10[1]); w.y = cvt_pk_bf16(o10[2], o10[3]); w.z = cvt_pk_bf16(o11[0], o11[1]); w.w = cvt_pk_bf16(o11[2], o11[3]);
                *(u32x4*)(dst) = w;
                w.x = cvt_pk_bf16(o20[0], o20[1]); w.y = cvt_pk_bf16(o20[2], o20[3]); w.z = cvt_pk_bf16(o21[0], o21[1]); w.w = cvt_pk_bf16(o21[2], o21[3]);
                *(u32x4*)(dst + 32) = w;
                asm volatile("" ::: "memory"); }
        } else if (pn == 12 || pn == 13) {
            const int row0 = u.pm * BM; const int b = row0 >> 11;
            typedef unsigned u32x2v __attribute__((ext_vector_type(2)));
            unsigned char* ub = ws + O_VT16 + ((size_t)((((b * 8 + 4 * (pn - 12) + (wc >> 1)) * 16 * 32 + ((row0 & 2047) >> 6) + wr) * 256) + (wc & 1) * 128)) * 2;
            const unsigned voff = (unsigned)(fr * 32 * 256 + 8 * fq * 4) * 2u;
#pragma unroll
            for (int ai = 0; ai < 2; ++ai) { const float r0 = rsv[ai][0], r1 = rsv[ai][1], r2 = rsv[ai][2], r3 = rsv[ai][3];
#pragma unroll
                for (int bj = 0; bj < 2; ++bj)
#pragma unroll
                    for (int n = 0; n < 2; ++n)
#pragma unroll
                        for (int j = 0; j < 4; ++j) { u32x2v w; w.x = cvt_pk_bf16(acc[ai][bj][0][n][j] * r0, acc[ai][bj][1][n][j] * r1); w.y = cvt_pk_bf16(acc[ai][bj][2][n][j] * r2, acc[ai][bj][3][n][j] * r3);
                            *(u32x2v*)(ub + (size_t)((bj * 262144 + 2 * ai * 256 + (4 * n + j) * 4) * 2) + voff) = w; }
                asm volatile("" ::: "memory"); }
        } else if (pn == 14) {
            if (wc == 0 && fq < 2) {
                float* G = (float*)(ws + O_G);
#pragma unroll
                for (int ai = 0; ai < 2; ++ai)
#pragma unroll
                    for (int m = 0; m < 4; ++m) { const int row = rbase + ai * HALF + m * 16; const float r = rsv[ai][m];
#pragma unroll
                        for (int n = 0; n < 2; ++n) { f32x4 v = acc[ai][0][m][n] * r; f32x4 o;
#pragma unroll
                            for (int j = 0; j < 4; ++j) { const int c8 = 4 * n + j;
                                if (fq == 0) o[j] = v[j] + gib[c8];
                                else { const float x = v[j] + gfb[c8]; o[j] = fminf(x, 0.0f) - __logf(1.0f + __expf(-fabsf(x))); } }
                            *(f32x4*)(G + (size_t)row * 16 + 8 * fq + 4 * n) = o; }
                        asm volatile("" ::: "memory"); }
            }
        }
    }
};
struct EpiRes {
    static constexpr bool PERM = true, AFTER_DRAIN = false;
    bf16_t* xb; float* ssn;
    __device__ __forceinline__ void operator()(const f32x4 (&acc)[2][2][4][2], const Unit& u, int wr, int wc, int fr, int fq) const {
        const int col0 = u.pn * BM + wc * 32 + 8 * fq;
#pragma unroll
        for (int ai = 0; ai < 2; ++ai)
#pragma unroll
            for (int m = 0; m < 4; ++m) { const int row = u.pm * BM + ai * HALF + wr * 64 + m * 16 + fr; bf16_t* rp = xb + (size_t)row * 1024 + col0; float sq = 0.f;
#pragma unroll
                for (int bj = 0; bj < 2; ++bj) { const u32x4 b = *(const u32x4*)(rp + bj * HALF);
                    const f32x4 v0 = acc[ai][bj][m][0], v1 = acc[ai][bj][m][1];
                    const float o0 = __uint_as_float(b.x << 16) + v0[0], o1 = __uint_as_float(b.x & 0xffff0000u) + v0[1], o2 = __uint_as_float(b.y << 16) + v0[2], o3 = __uint_as_float(b.y & 0xffff0000u) + v0[3];
                    const float o4 = __uint_as_float(b.z << 16) + v1[0], o5 = __uint_as_float(b.z & 0xffff0000u) + v1[1], o6 = __uint_as_float(b.w << 16) + v1[2], o7 = __uint_as_float(b.w & 0xffff0000u) + v1[3];
                    u32x4 w; w.x = cvt_pk_bf16(o0, o1); w.y = cvt_pk_bf16(o2, o3); w.z = cvt_pk_bf16(o4, o5); w.w = cvt_pk_bf16(o6, o7);
                    *(u32x4*)(rp + bj * HALF) = w;
                    sq += ((o0 * o0 + o1 * o1) + (o2 * o2 + o3 * o3)) + ((o4 * o4 + o5 * o5) + (o6 * o6 + o7 * o7)); }
                sq += __shfl_xor(sq, 16); sq += __shfl_xor(sq, 32);
                if (fq == 0) ssn[(size_t)row * 16 + u.pn * 4 + wc] = sq; }
    }
};
struct EpiUp {
    static constexpr bool PERM = true, AFTER_DRAIN = false;
    const float* ss; bf16_t* U;
    __device__ __forceinline__ void operator()(const f32x4 (&acc)[2][2][4][2], const Unit& u, int wr, int wc, int fr, int fq) const {
        const int rbase = u.pm * BM + wr * 64 + fr;
        float rsv[2][4];
#pragma unroll
        for (int ai = 0; ai < 2; ++ai)
#pragma unroll
            for (int m = 0; m < 4; ++m) rsv[ai][m] = row_ss_q(ss, rbase + ai * HALF + m * 16, fq);
#pragma unroll
        for (int ai = 0; ai < 2; ++ai)
#pragma unroll
            for (int m = 0; m < 4; ++m) { const int row = rbase + ai * HALF + m * 16; const float r = rsqrtf(rsv[ai][m] * (1.0f / 1024.0f) + 1e-6f);
                bf16_t* rowp = U + (size_t)row * 4096 + u.pn * BM + wc * 32 + 8 * fq;
#pragma unroll
                for (int bj = 0; bj < 2; ++bj) { f32x4 v0 = acc[ai][bj][m][0] * r, v1 = acc[ai][bj][m][1] * r;
#pragma unroll
                    for (int j = 0; j < 4; ++j) { v0[j] = fmaxf(v0[j], 0.f); v0[j] *= v0[j]; v1[j] = fmaxf(v1[j], 0.f); v1[j] *= v1[j]; }
                    u32x4 w; w.x = cvt_pk_bf16(v0[0], v0[1]); w.y = cvt_pk_bf16(v0[2], v0[3]); w.z = cvt_pk_bf16(v1[0], v1[1]); w.w = cvt_pk_bf16(v1[2], v1[3]);
                    *(u32x4*)(rowp + bj * HALF) = w; } }
    }
};
template <class Epi, class Sched, bool ALIGN_EPI = false, bool SP2 = false>
__device__ __forceinline__ void gemm_phase(PG8_LAS unsigned char* lds, const Gemm g, const Sched& S, const Epi& E) {
    int tid_ = threadIdx.x; asm volatile("" : "+v"(tid_));
    const int tid = tid_, wid = __builtin_amdgcn_readfirstlane(tid >> 6), lane = tid & 63, wr = wid >> 2, wc = wid & 3, fr = lane & 15, fq = lane >> 4;
    const int K = g.K, nt = K / BK;
    unsigned voffA[2], voffB[2];
#pragma unroll
    for (int i = 0; i < 2; ++i) { int R, C; stage_rc(tid * 16 + i * 8192, R, C); const int Rb = Epi::PERM ? ((R & ~31) + perm32(R & 31)) : R;
        voffA[i] = (unsigned)(R * K + C) * 2u; voffB[i] = (unsigned)(Rb * K + C) * 2u; }
    const size_t kstep = (size_t)(BK * 2);
    const size_t hstep = (size_t)HALF * K * 2;
    const size_t tstep = 2 * hstep;
    const unsigned ldsw = (unsigned)wid * 1024u;
    const int aoff = lds_byte(wr * 64 + fr, fq * 8), boff = lds_byte(wc * 32 + fr, fq * 8);
#define PG8_SA(b, h) (((b) * 2 + (h)) * HTB)
#define PG8_SB(b, h) ((4 + (b) * 2 + (h)) * HTB)
#define PG8_STAGE(bufoff, gbase, voff) do { _Pragma("unroll") for (int _i = 0; _i < 2; ++_i) \
        __builtin_amdgcn_global_load_lds((const unsigned*)((const char*)(gbase) + (voff)[_i]), (PG8_LAS unsigned*)(lds + (bufoff) + ldsw + _i * 8192), 16, 0, 0); } while (0)
#define PG8_LDA(dst, b, h) do { _Pragma("unroll") for (int m = 0; m < 4; ++m) _Pragma("unroll") for (int k = 0; k < 2; ++k) dst[m][k] = *(const PG8_LAS bf16x8*)(lds + PG8_SA(b, h) + aoff + m * 2048 + k * 1024); } while (0)
#define PG8_LDB(dst, b, h) do { _Pragma("unroll") for (int n = 0; n < 2; ++n) _Pragma("unroll") for (int k = 0; k < 2; ++k) dst[n][k] = *(const PG8_LAS bf16x8*)(lds + PG8_SB(b, h) + boff + n * 2048 + k * 1024); } while (0)
#define PG8_MMA(ai, bj, At, Bt) do { __builtin_amdgcn_s_setprio(1); _Pragma("unroll") for (int m = 0; m < 4; ++m) _Pragma("unroll") for (int n = 0; n < 2; ++n) _Pragma("unroll") for (int k = 0; k < 2; ++k) \
        acc[ai][bj][m][n] = __builtin_amdgcn_mfma_f32_16x16x32_bf16(Bt[n][k], At[m][k], acc[ai][bj][m][n], 0, 0, 0); __builtin_amdgcn_s_setprio(0); } while (0)
#define PG8_WAIT_V(n) asm volatile("s_waitcnt vmcnt(" #n ")" ::: "memory")
#define PG8_WAIT_L(n) asm volatile("s_waitcnt lgkmcnt(" #n ")" ::: "memory")
#define PG8_BAR __builtin_amdgcn_s_barrier()
#define PG8_SCHED __builtin_amdgcn_sched_barrier(0)
    Unit cur, nxt; int ui = 0;
    if (!S.next(0, cur)) return;
    f32x4 acc[2][2][4][2];
#pragma unroll
    for (int a = 0; a < 2; ++a)
#pragma unroll
        for (int b = 0; b < 2; ++b)
#pragma unroll
            for (int m = 0; m < 4; ++m)
#pragma unroll
                for (int n = 0; n < 2; ++n) acc[a][b][m][n] = (f32x4){0.f, 0.f, 0.f, 0.f};
    bf16x8 At[4][2], B0[2][2], B1[2][2];
    const char* cA = (const char*)g.A + (size_t)cur.pm * tstep; const char* cB = (const char*)g.Bt + (size_t)cur.pn * tstep;
    S.a_ready(cur);
    if constexpr (SP2) {
        PG8_STAGE(PG8_SB(0, 0), cB, voffB); PG8_STAGE(PG8_SB(0, 1), cB + hstep, voffB); PG8_STAGE(PG8_SA(0, 0), cA, voffA); PG8_STAGE(PG8_SA(0, 1), cA + hstep, voffA);
        if (wr == 1) PG8_BAR;
        PG8_WAIT_V(2); PG8_BAR;
        PG8_STAGE(PG8_SB(1, 0), cB + kstep, voffB); PG8_STAGE(PG8_SA(1, 0), cA + kstep, voffA); PG8_STAGE(PG8_SB(1, 1), cB + hstep + kstep, voffB);
        PG8_WAIT_V(6); PG8_BAR;
    } else {
        PG8_STAGE(PG8_SB(0, 0), cB, voffB); PG8_STAGE(PG8_SA(0, 0), cA, voffA); PG8_STAGE(PG8_SB(0, 1), cB + hstep, voffB); PG8_STAGE(PG8_SA(0, 1), cA + hstep, voffA);
        if (wr == 1) PG8_BAR;
        PG8_WAIT_V(4); PG8_BAR;
        PG8_STAGE(PG8_SB(1, 0), cB + kstep, voffB); PG8_STAGE(PG8_SA(1, 0), cA + kstep, voffA); PG8_STAGE(PG8_SB(1, 1), cB + hstep + kstep, voffB);
        PG8_WAIT_V(6); PG8_BAR;
    }
    for (;;) {
        const bool has_next = S.next(ui + 1, nxt);
        const char* nA = has_next ? (const char*)g.A + (size_t)nxt.pm * tstep : cA; const char* nB = has_next ? (const char*)g.Bt + (size_t)nxt.pn * tstep : cB;
        for (int t = 0; t < nt; t += 2) {
            const bool last = (t == nt - 2);
            const char* a1 = cA + (size_t)(t + 1) * kstep;
            const char* a2 = last ? nA : cA + (size_t)(t + 2) * kstep; const char* b2 = last ? nB : cB + (size_t)(t + 2) * kstep;
            const char* a3 = a2 + kstep; const char* b3 = b2 + kstep;
            if (last && has_next) S.a_ready(nxt);
            if constexpr (SP2) {
            PG8_LDB(B0, 0, 0); PG8_LDB(B1, 0, 1); PG8_SCHED; PG8_LDA(At, 0, 0); PG8_STAGE(PG8_SA(1, 1), a1 + hstep, voffA);
            PG8_WAIT_V(8); PG8_WAIT_L(0); PG8_BAR; PG8_MMA(0, 0, At, B0); PG8_MMA(0, 1, At, B1); PG8_BAR; PG8_SCHED;
            PG8_LDA(At, 0, 1); PG8_STAGE(PG8_SB(0, 0), b2, voffB); PG8_STAGE(PG8_SB(0, 1), b2 + hstep, voffB); PG8_STAGE(PG8_SA(0, 0), a2, voffA);
            PG8_WAIT_V(8); PG8_WAIT_L(0); PG8_BAR; PG8_MMA(1, 0, At, B0); PG8_MMA(1, 1, At, B1); PG8_BAR; PG8_SCHED;
            PG8_LDB(B0, 1, 0); PG8_LDB(B1, 1, 1); PG8_SCHED; PG8_LDA(At, 1, 0); PG8_STAGE(PG8_SA(0, 1), a2 + hstep, voffA);
            PG8_WAIT_V(8); PG8_WAIT_L(0); PG8_BAR; PG8_MMA(0, 0, At, B0); PG8_MMA(0, 1, At, B1); PG8_BAR; PG8_SCHED;
            PG8_LDA(At, 1, 1); PG8_STAGE(PG8_SB(1, 0), b3, voffB); PG8_STAGE(PG8_SB(1, 1), b3 + hstep, voffB); PG8_STAGE(PG8_SA(1, 0), a3, voffA);
            PG8_WAIT_V(8); PG8_WAIT_L(0); PG8_BAR; PG8_MMA(1, 0, At, B0); PG8_MMA(1, 1, At, B1); PG8_BAR; PG8_SCHED;
            } else {
            PG8_LDB(B0, 0, 0); PG8_SCHED; PG8_LDA(At, 0, 0); PG8_STAGE(PG8_SA(1, 1), a1 + hstep, voffA);
            PG8_WAIT_L(8); PG8_BAR; PG8_WAIT_L(0); PG8_MMA(0, 0, At, B0); PG8_BAR; PG8_SCHED;
            PG8_LDB(B1, 0, 1); PG8_STAGE(PG8_SB(0, 0), b2, voffB);
            PG8_BAR; PG8_WAIT_L(0); PG8_MMA(0, 1, At, B1); PG8_BAR;
            PG8_LDA(At, 0, 1); PG8_STAGE(PG8_SA(0, 0), a2, voffA);
            PG8_BAR; PG8_WAIT_L(0); PG8_MMA(1, 0, At, B0); PG8_BAR; PG8_SCHED;
            PG8_STAGE(PG8_SB(0, 1), b2 + hstep, voffB);
            PG8_WAIT_V(6); PG8_BAR; PG8_MMA(1, 1, At, B1); PG8_BAR;
            PG8_LDB(B0, 1, 0); PG8_SCHED; PG8_LDA(At, 1, 0); PG8_STAGE(PG8_SA(0, 1), a2 + hstep, voffA);
            PG8_WAIT_L(8); PG8_BAR; PG8_WAIT_L(0); PG8_MMA(0, 0, At, B0); PG8_BAR; PG8_SCHED;
            PG8_LDB(B1, 1, 1); PG8_STAGE(PG8_SB(1, 0), b3, voffB);
            PG8_BAR; PG8_WAIT_L(0); PG8_MMA(0, 1, At, B1); PG8_BAR;
            PG8_LDA(At, 1, 1); PG8_STAGE(PG8_SA(1, 0), a3, voffA);
            PG8_BAR; PG8_WAIT_L(0); PG8_MMA(1, 0, At, B0); PG8_BAR; PG8_SCHED;
            PG8_STAGE(PG8_SB(1, 1), b3 + hstep, voffB);
            PG8_WAIT_V(6); PG8_BAR; PG8_MMA(1, 1, At, B1); PG8_BAR;
            }
        }
        if constexpr (ALIGN_EPI) { if (wr == 0) PG8_BAR; }
        if constexpr (!Epi::AFTER_DRAIN) { E(acc, cur, wr, wc, fr, fq); S.done(cur); }
        if (!has_next) break;
#pragma unroll
        for (int a = 0; a < 2; ++a)
#pragma unroll
            for (int b = 0; b < 2; ++b)
#pragma unroll
                for (int m = 0; m < 4; ++m)
#pragma unroll
                    for (int n = 0; n < 2; ++n) acc[a][b][m][n] = (f32x4){0.f, 0.f, 0.f, 0.f};
        cur = nxt; cA = nA; cB = nB; ++ui;
        if constexpr (ALIGN_EPI) { if (wr == 1) PG8_BAR; }
    }
    PG8_WAIT_V(0);
    if constexpr (!ALIGN_EPI) { if (wr == 0) PG8_BAR; }
    PG8_BAR;
    if constexpr (Epi::AFTER_DRAIN) { E.fused(acc, cur, wr, wc, fr, fq, lds, wid, lane); S.done(cur); }
#undef PG8_SA
#undef PG8_SB
#undef PG8_STAGE
#undef PG8_LDA
#undef PG8_LDB
#undef PG8_MMA
#undef PG8_WAIT_V
#undef PG8_WAIT_L
#undef PG8_BAR
#undef PG8_SCHED
}
}
#define LAS __attribute__((address_space(3)))
typedef unsigned short bf16;
typedef short bf16x8 __attribute__((ext_vector_type(8)));
typedef float f32x4 __attribute__((ext_vector_type(4)));
typedef unsigned u32x4 __attribute__((ext_vector_type(4)));
typedef unsigned u32x2 __attribute__((ext_vector_type(2)));
constexpr int SEQ = 2048, DM = 1024, MROWS = 16384, FF = 4096, NINP = 3840, NINL = 3600, NTHR = 512, NWAVE = 8;
constexpr size_t MiB = 1u << 20;
constexpr size_t WS_SS = 0, WS_ROPE = 512 * 1024, WS_N = 1 * MiB, WS_MST = 2 * MiB, WS_G = 3 * MiB;
constexpr size_t WS_WIN = 4 * MiB, WS_WOUT = 19 * MiB, WS_WUP = 23 * MiB, WS_WDN = 39 * MiB;
constexpr size_t WS_XB = 56 * MiB;
constexpr size_t WS_SSP = 88 * MiB;
constexpr size_t WS_P1O = 93 * MiB, WS_P1ML = 109 * MiB;
constexpr size_t WS_U = 120 * MiB;
constexpr size_t WS_QKM = 120 * MiB, WS_KTM = 152 * MiB, WS_VTM = 168 * MiB, WS_AK = 184 * MiB, WS_VT16 = 200 * MiB, WS_Y = 216 * MiB, WS_END = 248 * MiB;
constexpr size_t WS_CTL = 2 * MiB + 256 * 1024, CTL_BYTES = 16384;
constexpr int LDS_BYTES = 147456, LDS_MISC = 131072 + 320;

struct Params {
    const float *x, *norm1_g, *w_in, *conv_w, *gate_i_b, *gate_f_b, *head_norm_g, *w_out, *norm2_g, *w_up, *w_down, *final_g;
    float* out; unsigned char* ws;
};

__device__ __forceinline__ unsigned pk2(float lo, float hi) { return pg8::cvt_pk_bf16(lo, hi); }
__device__ __forceinline__ float bflo(unsigned w) { return __uint_as_float(w << 16); }
__device__ __forceinline__ float bfhi(unsigned w) { return __uint_as_float(w & 0xffff0000u); }
__device__ __forceinline__ float wave_sum(float v) {
#pragma unroll
    for (int o = 1; o < 64; o <<= 1) v += __shfl_xor(v, o);
    return v;
}
__device__ __forceinline__ float wave_max(float v) {
#pragma unroll
    for (int o = 1; o < 64; o <<= 1) v = fmaxf(v, __shfl_xor(v, o));
    return v;
}
__device__ __forceinline__ float wave_incl_scan(float v, int lane) {
#pragma unroll
    for (int o = 1; o < 64; o <<= 1) { const float t = __shfl_up(v, o); if (lane >= o) v += t; }
    return v;
}

#define DPP_STEP_ADD(v, ctrl, rm) do { const int t_ = __builtin_amdgcn_update_dpp(0, __float_as_int(v), (ctrl), (rm), 0xf, false); v += __int_as_float(t_); } while (0)
#define DPP_STEP_MAX(v, ctrl, rm) do { const int t_ = __builtin_amdgcn_update_dpp((int)0xff800000, __float_as_int(v), (ctrl), (rm), 0xf, false); v = fmaxf(v, __int_as_float(t_)); } while (0)
__device__ __forceinline__ float wave_incl_scan_dpp(float v) {
    DPP_STEP_ADD(v, 0x111, 0xf); DPP_STEP_ADD(v, 0x112, 0xf); DPP_STEP_ADD(v, 0x114, 0xf); DPP_STEP_ADD(v, 0x118, 0xf); DPP_STEP_ADD(v, 0x142, 0xa); DPP_STEP_ADD(v, 0x143, 0xc);
    return v;
}
__device__ __forceinline__ float wave_incl_max_dpp(float v) {
    DPP_STEP_MAX(v, 0x111, 0xf); DPP_STEP_MAX(v, 0x112, 0xf); DPP_STEP_MAX(v, 0x114, 0xf); DPP_STEP_MAX(v, 0x118, 0xf); DPP_STEP_MAX(v, 0x142, 0xa); DPP_STEP_MAX(v, 0x143, 0xc);
    return v;
}
__device__ __forceinline__ float wave_max_dpp(float v) {
    DPP_STEP_MAX(v, 0x111, 0xf); DPP_STEP_MAX(v, 0x112, 0xf); DPP_STEP_MAX(v, 0x114, 0xf); DPP_STEP_MAX(v, 0x118, 0xf); DPP_STEP_MAX(v, 0x142, 0xa); DPP_STEP_MAX(v, 0x143, 0xc);
    return __int_as_float(__builtin_amdgcn_readlane(__float_as_int(v), 63));
}
#define MFMA16(a, b, c) __builtin_amdgcn_mfma_f32_16x16x32_bf16((a), (b), (c), 0, 0, 0)

__device__ __forceinline__ int win_src_col(int nb, int& nvalid) {
    nvalid = 32;
    if (nb < 2048) return nb;
    if (nb < 3072) { int xx = nb - 2048; const int isk = xx >> 9; xx &= 511; const int T = xx >> 8, bj = (xx >> 7) & 1, hl = (xx >> 5) & 3; return 2064 + isk * 512 + 64 * (4 * T + hl) + 32 * bj; }
    if (nb < 3584) return 3088 + (nb - 3072);
    if (nb == 3584) { nvalid = 16; return 2048; }
    nvalid = 0; return 0;
}
__device__ __forceinline__ void transpose_item(const float* W, int K, int Nsrc, int src_col, int nvalid, const float* g, bf16* WT, int dst_row, int k0, LAS float* scr, int lane) {
    const int c = lane & 31;
    float wv[32];
#pragma unroll
    for (int i = 0; i < 32; ++i) { const int kk = 2 * i + (lane >> 5); wv[i] = (c < nvalid) ? W[(size_t)(k0 + kk) * Nsrc + src_col + c] : 0.f; }
    if (g) {
#pragma unroll
        for (int i = 0; i < 32; ++i) wv[i] *= g[k0 + 2 * i + (lane >> 5)]; }
#pragma unroll
    for (int i = 0; i < 32; ++i) scr[(2 * i + (lane >> 5)) * 33 + c] = wv[i];
    asm volatile("s_waitcnt lgkmcnt(0)" ::: "memory");
    const int ch = lane & 7;
#pragma unroll
    for (int j = 0; j < 4; ++j) { const int n = (lane >> 3) + 8 * j; const LAS float* s = scr + (8 * ch) * 33 + n;
        u32x4 o; o.x = pk2(s[0 * 33], s[1 * 33]); o.y = pk2(s[2 * 33], s[3 * 33]); o.z = pk2(s[4 * 33], s[5 * 33]); o.w = pk2(s[6 * 33], s[7 * 33]);
        *(u32x4*)(WT + (size_t)(dst_row + n) * K + k0 + 8 * ch) = o; }
    asm volatile("s_waitcnt lgkmcnt(0)" ::: "memory");
}
constexpr int I_IN = 16 * (NINP / 32), I_OUT = 16 * 32, I_UP = 16 * 128, I_DN = 64 * 32, I_L = I_IN + I_OUT + I_UP + I_DN;
__device__ __forceinline__ void convert_item(const Params& p, int it, LAS float* scr, int lane) {
    const int l = it / I_L; int r = it % I_L;
    if (r < I_IN) { const int nblk = NINP / 32, kb = r / nblk, nb = (r % nblk) * 32; int nv; const int sc = win_src_col(nb, nv);
        transpose_item(p.w_in + (size_t)l * DM * NINL, DM, NINL, sc, nv, p.norm1_g + l * DM, (bf16*)(p.ws + WS_WIN) + (size_t)l * NINP * DM, nb, kb * 64, scr, lane); return; }
    r -= I_IN;
    if (r < I_OUT) { const int kb = r / 32, nb = (r % 32) * 32;
        transpose_item(p.w_out + (size_t)l * DM * DM, DM, DM, nb, 32, nullptr, (bf16*)(p.ws + WS_WOUT) + (size_t)l * DM * DM, nb, kb * 64, scr, lane); return; }
    r -= I_OUT;
    if (r < I_UP) { const int kb = r / 128, nb = (r % 128) * 32;
        transpose_item(p.w_up + (size_t)l * DM * FF, DM, FF, nb, 32, p.norm2_g + l * DM, (bf16*)(p.ws + WS_WUP) + (size_t)l * FF * DM, nb, kb * 64, scr, lane); return; }
    r -= I_UP;
    { const int kb = r / 32, nb = (r % 32) * 32;
        transpose_item(p.w_down + (size_t)l * FF * DM, FF, DM, nb, 32, nullptr, (bf16*)(p.ws + WS_WDN) + (size_t)l * DM * FF, nb, kb * 64, scr, lane); }
}
__device__ __forceinline__ void p0_prologue(const Params& p, LAS unsigned char* lds, int wave, int lane, int G, int n_items) {
    LAS float* scr = (LAS float*)(lds + wave * 16384);
    const int gw = blockIdx.x * NWAVE + wave, NGW = G * NWAVE;
    if (n_items < 0) { constexpr int I_A = I_IN + I_OUT;
        for (int j = gw; j < 2 * I_A; j += NGW) convert_item(p, (j / I_A) * I_L + (j % I_A), scr, lane); }
    else for (int it = gw; it < n_items; it += NGW) convert_item(p, it, scr, lane);
    float* ss = (float*)(p.ws + WS_SSP); bf16* xb = (bf16*)(p.ws + WS_XB);
    for (int m0 = gw; m0 < MROWS; m0 += 2 * NGW) {
        f32x4 v[2][4];
#pragma unroll
        for (int q = 0; q < 2; ++q) { const int m = (m0 + q * NGW < MROWS) ? m0 + q * NGW : m0; const f32x4* xr = (const f32x4*)(p.x + (size_t)m * DM) + lane;
#pragma unroll
            for (int j = 0; j < 4; ++j) v[q][j] = xr[64 * j]; }
#pragma unroll
        for (int q = 0; q < 2; ++q) { const int m = m0 + q * NGW; if (m < MROWS) { float s = 0.f; u32x2* o8 = (u32x2*)(xb + (size_t)m * DM) + lane;
#pragma unroll
            for (int j = 0; j < 4; ++j) { const f32x4 t = v[q][j]; s += (t[0] * t[0] + t[1] * t[1]) + (t[2] * t[2] + t[3] * t[3]); u32x2 w; w.x = pk2(t[0], t[1]); w.y = pk2(t[2], t[3]); o8[64 * j] = w; }
            s = wave_sum(s); if (lane < 16) ss[(size_t)m * 16 + lane] = (lane == 0) ? s : 0.f; } }
    }
    const int gt = blockIdx.x * NTHR + threadIdx.x, NGT = G * NTHR;
    float* rc = (float*)(p.ws + WS_ROPE); float* rsn = rc + SEQ * 32;
    for (int i = gt; i < SEQ * 32; i += NGT) { const int pos = i >> 5, fi = i & 31;
        const float inv = exp2f(-(float)fi * (13.287712379549449f / 32.0f)); const float ang = (float)pos * inv;
        const float n = rintf(ang * 0.15915494309189535f); float rr = fmaf(-n, 6.2831854820251465f, ang); rr = fmaf(-n, -1.7484555e-7f, rr);
        rc[i] = __cosf(rr); rsn[i] = __sinf(rr); }
}

struct ScanLd { u32x4 kc[2]; unsigned kb[2], ka[2]; float li, lf; };
__device__ __forceinline__ void scan_load(ScanLd& L, const bf16* Krow, const bf16* Vrow, const float* Gp, int tok0, int fq, int lane, int gcol) {
    L.li = Gp[(size_t)(tok0 + lane) * 16 + gcol]; L.lf = Gp[(size_t)(tok0 + lane) * 16 + 8 + gcol];
#pragma unroll
    for (int ks = 0; ks < 2; ++ks) { const int base = tok0 + 32 * ks + 8 * fq;
        L.kc[ks] = *(const u32x4*)(Krow + base);
        L.kb[ks] = (base >= 2) ? *(const unsigned*)(Krow + base - 2) : 0u;
        L.ka[ks] = (base + 8 < SEQ) ? *(const unsigned*)(Krow + base + 8) : 0u; }
}
__device__ __forceinline__ void scan_wave(const Params& p, int layer, int sw, LAS float* wl, int lane, bool bar_mid) {
    const int ksl = sw & 7, dir = (sw >> 3) & 1, hh = (sw >> 4) & 3, b = sw >> 6;
    const int fr = lane & 15, fq = lane >> 4, kdim = 16 * ksl + fr;
    const float* cw = p.conv_w + (size_t)layer * 5 * 1024 + 512 + hh * 128 + kdim;
    float cwt[5];
#pragma unroll
    for (int t = 0; t < 5; ++t) cwt[t] = cw[t * 1024];
    const bf16* Krow = (const bf16*)(p.ws + WS_KTM) + ((size_t)((b * 4 + hh) * 128 + kdim)) * SEQ;
    const bf16* Vrow = (const bf16*)(p.ws + WS_VTM) + ((size_t)((b * 4 + hh) * 128 + fr)) * SEQ;
    const float* Gp = (const float*)(p.ws + WS_G) + (size_t)b * SEQ * 16;
    const int gcol = dir * 4 + hh;
    bf16* Ct = (bf16*)p.out; float* Nst = (float*)(p.ws + WS_N); float* Mst = (float*)(p.ws + WS_MST);
    const f32x4 z4 = {0.f, 0.f, 0.f, 0.f};
    f32x4 C[8], CN = z4; float mrun = -1e30f;
#pragma unroll
    for (int nt = 0; nt < 8; ++nt) C[nt] = z4;
    const bf16x8 ones = {0x3F80, 0x3F80, 0x3F80, 0x3F80, 0x3F80, 0x3F80, 0x3F80, 0x3F80};
    ScanLd cur, nxt;
    scan_load(cur, Krow, Vrow, Gp, (dir ? 31 : 0) * 64, fq, lane, gcol);
    for (int cs = 0; cs < 32; ++cs) {
        if (bar_mid && cs == 14) __syncthreads();
        const int pc = dir ? 31 - cs : cs;
        bf16x8 vv[8][2];
#pragma unroll
        for (int ks = 0; ks < 2; ++ks)
#pragma unroll
            for (int nt = 0; nt < 8; ++nt) vv[nt][ks] = *(const bf16x8*)(Vrow + (size_t)nt * 16 * SEQ + pc * 64 + 32 * ks + 8 * fq);
        if (cs + 1 < 32) scan_load(nxt, Krow, Vrow, Gp, (dir ? 30 - cs : cs + 1) * 64, fq, lane, gcol); else nxt = cur;
        const float pre = wave_incl_scan_dpp(cur.lf); const float total = __int_as_float(__builtin_amdgcn_readlane(__float_as_int(pre), 63));
        const float g = dir ? (pre - cur.lf + cur.li) : (total - pre + cur.li);
        const float gmax = wave_max_dpp(g);
        const float mn = fmaxf(total + mrun, gmax); const float decay = __expf(total + mrun - mn); const float w = __expf(g - mn);
        const size_t sidx = (size_t)((b * 4 + hh) * 2 + dir) * 32 + pc;
        { bf16* Cd = Ct + sidx * 16384 + (size_t)fr * 128 + 16 * ksl + 4 * fq;
#pragma unroll
          for (int nt = 0; nt < 8; ++nt) { u32x2 w0; w0.x = pk2(C[nt][0], C[nt][1]); w0.y = pk2(C[nt][2], C[nt][3]); *(u32x2*)(Cd + nt * 16 * 128) = w0; }
          if (fr == 0) *(f32x4*)(Nst + sidx * 128 + 16 * ksl + 4 * fq) = CN;
          if (ksl == 0 && lane == 0) Mst[sidx] = mrun; }
        wl[lane] = w;
        asm volatile("s_waitcnt lgkmcnt(0)" ::: "memory");
        bf16x8 afr[2];
#pragma unroll
        for (int ks = 0; ks < 2; ++ks) {
            const f32x4 wa = *(const LAS f32x4*)(wl + 32 * ks + 8 * fq), wb = *(const LAS f32x4*)(wl + 32 * ks + 8 * fq + 4);
            float r[12]; r[0] = bflo(cur.kb[ks]); r[1] = bfhi(cur.kb[ks]);
#pragma unroll
            for (int q = 0; q < 4; ++q) { r[2 + 2 * q] = bflo(cur.kc[ks][q]); r[3 + 2 * q] = bfhi(cur.kc[ks][q]); }
            r[10] = bflo(cur.ka[ks]); r[11] = bfhi(cur.ka[ks]);
            float o[8];
#pragma unroll
            for (int j = 0; j < 8; ++j) { float a = 0.f;
#pragma unroll
                for (int t = 0; t < 5; ++t) a = fmaf(cwt[t], r[j + t], a);
                a = a * __builtin_amdgcn_rcpf(1.0f + __expf(-a)); o[j] = a * 0.08838834764831845f * (j < 4 ? wa[j] : wb[j - 4]); }
            u32x4 pw; pw.x = pk2(o[0], o[1]); pw.y = pk2(o[2], o[3]); pw.z = pk2(o[4], o[5]); pw.w = pk2(o[6], o[7]);
            afr[ks] = __builtin_bit_cast(bf16x8, pw);
        }
        asm volatile("" ::: "memory");
        CN = CN * decay;
#pragma unroll
        for (int nt = 0; nt < 8; ++nt) { C[nt] = C[nt] * decay; C[nt] = MFMA16(afr[0], vv[nt][0], C[nt]); C[nt] = MFMA16(afr[1], vv[nt][1], C[nt]); }
        CN = MFMA16(afr[0], ones, CN); CN = MFMA16(afr[1], ones, CN);
        mrun = mn; cur = nxt;
    }
}

__device__ __forceinline__ void tile_par(int T, int f, int r, int L0, int& R, int& Lb, int& dsh) {
    if (T < 10) { dsh = 4; R = r; Lb = L0 - 64 + 16 * T + 4 * f; }
    else if (T < 22) { dsh = 2; R = 4 * f + (r & 3); Lb = L0 - 16 + 4 * (T - 10); }
    else { const int xx = T - 22; dsh = 0; R = 4 * (xx & 3) + f; Lb = L0 - 4 + 4 * (xx >> 2); }
}
template <int LIM> __device__ __forceinline__ void attn_step(f32x4 (&O)[4], float& mrun, float& lsum, const bf16x8 (&qf)[2], const bf16x8 k00, const bf16x8 k01, const bf16x8 k10, const bf16x8 k11,
                                                             const u32x2 (&v0)[4], const u32x2 (&v1)[4], int D0, int D1, bool ok0, bool ok1) {
    const f32x4 z4 = {0.f, 0.f, 0.f, 0.f};
    f32x4 s0 = MFMA16(k00, qf[0], z4); s0 = MFMA16(k01, qf[1], s0);
    f32x4 s1 = MFMA16(k10, qf[0], z4); s1 = MFMA16(k11, qf[1], s1);
    bool va[4], vb[4];
#pragma unroll
    for (int j = 0; j < 4; ++j) { va[j] = ok0 && ((unsigned)(D0 + 16 * j) <= (unsigned)(2 * LIM)); vb[j] = ok1 && ((unsigned)(D1 + 16 * j) <= (unsigned)(2 * LIM));
        s0[j] = va[j] ? s0[j] : -1e30f; s1[j] = vb[j] ? s1[j] : -1e30f; }
    float tm = fmaxf(fmaxf(fmaxf(s0[0], s0[1]), fmaxf(s0[2], s0[3])), fmaxf(fmaxf(s1[0], s1[1]), fmaxf(s1[2], s1[3])));
    tm = fmaxf(tm, __shfl_xor(tm, 16)); tm = fmaxf(tm, __shfl_xor(tm, 32));
    const float mn = fmaxf(mrun, tm);
    if (__any(mn > mrun)) { const float sc = __builtin_amdgcn_exp2f(mrun - mn); lsum *= sc;
#pragma unroll
        for (int d = 0; d < 4; ++d) O[d] = O[d] * sc; }
    mrun = mn;
    float pv[8]; float ps = 0.f;
#pragma unroll
    for (int j = 0; j < 4; ++j) { pv[j] = va[j] ? __builtin_amdgcn_exp2f(s0[j] - mn) : 0.f; pv[4 + j] = vb[j] ? __builtin_amdgcn_exp2f(s1[j] - mn) : 0.f; ps += pv[j] + pv[4 + j]; }
    lsum += ps;
    u32x4 pw; pw.x = pk2(pv[0], pv[1]); pw.y = pk2(pv[2], pv[3]); pw.z = pk2(pv[4], pv[5]); pw.w = pk2(pv[6], pv[7]);
    const bf16x8 pb = __builtin_bit_cast(bf16x8, pw);
#pragma unroll
    for (int d = 0; d < 4; ++d) { u32x4 vw; vw.x = v0[d].x; vw.y = v0[d].y; vw.z = v1[d].x; vw.w = v1[d].y; O[d] = MFMA16(__builtin_bit_cast(bf16x8, vw), pb, O[d]); }
}
#define KLD(ptr, lo, hi) do { lo = *(const bf16x8*)(ptr); hi = *(const bf16x8*)((ptr) + 32); } while (0)
#define VLD(ptr, v) do { _Pragma("unroll") for (int d_ = 0; d_ < 4; ++d_) v[d_] = *(const u32x2*)((ptr) + d_ * 64); } while (0)
__device__ __forceinline__ void attn_pair(const Params& p, int b, int h, int p0, int r0, int lane) {
    const int fr = lane & 15, fq = lane >> 4, fK = fr >> 2, jK = fr & 3; const int L0 = p0 >> 4;
    const f32x4 z4 = {0.f, 0.f, 0.f, 0.f};
    bf16* Yrow[2]; bf16x8 qf[2][2]; f32x4 O[2][4]; float mrun[2], lsum[2];
    const bf16* Kb = (const bf16*)(p.ws + WS_AK) + (ptrdiff_t)b * SEQ * 512 + h * 64 + 8 * fq;
    const bf16* Vb = (const bf16*)(p.ws + WS_VT16) + (ptrdiff_t)(b * 8 + h) * 131072 + fr * 4;
#pragma unroll
    for (int u = 0; u < 2; ++u) { const int pq = p0 + 16 * fr + r0 + 4 * u; Yrow[u] = (bf16*)(p.ws + WS_Y) + ((size_t)(b * SEQ + pq)) * 1024 + 512 + h * 64;
        qf[u][0] = *(const bf16x8*)(Yrow[u] + 8 * fq); qf[u][1] = *(const bf16x8*)(Yrow[u] + 32 + 8 * fq); mrun[u] = -1e30f; lsum[u] = 0.f;
#pragma unroll
        for (int d = 0; d < 4; ++d) O[u][d] = z4; }
    {
        const bf16* kp = Kb + (ptrdiff_t)(16 * (L0 - 64 + 4 * fK + jK) + r0) * 512;
        const bf16* vp = Vb + (ptrdiff_t)(r0 * 32 + (L0 >> 2) - 16 + fq) * 256;
        for (int pp = 0; pp < 5; ++pp) { const int T0 = 2 * pp; const int lq = L0 - 64 + 16 * T0;
            if (lq + 31 < 0 || lq >= 128) continue;
            const int D0 = 16 * (-64 + 16 * T0 + 4 * fq - fr) + 1024; const bool ok0 = (unsigned)(lq + 4 * fq) < 128u, ok1 = (unsigned)(lq + 16 + 4 * fq) < 128u;
            const bf16* k0p = kp + (ptrdiff_t)T0 * 256 * 512; const bf16* v0p = vp + (ptrdiff_t)T0 * 4 * 256;
#pragma unroll
            for (int u = 0; u < 2; ++u) { bf16x8 k00, k01, k10, k11; u32x2 v0[4], v1[4];
                KLD(k0p + u * 4 * 512, k00, k01); VLD(v0p + u * 4 * 32 * 256, v0);
                if (pp < 4) { KLD(k0p + u * 4 * 512 + 256 * 512, k10, k11); VLD(v0p + u * 4 * 32 * 256 + 4 * 256, v1); }
                else { k10 = k00; k11 = k01;
#pragma unroll
                    for (int d_ = 0; d_ < 4; ++d_) v1[d_] = v0[d_]; }
                attn_step<1024>(O[u], mrun[u], lsum[u], qf[u], k00, k01, k10, k11, v0, v1, D0, D0 + 256, ok0, ok1 && (pp < 4)); }
        }
    }
    {
        const bf16* kp = Kb + (ptrdiff_t)(16 * (L0 - 16 + jK) + 4 * fK + (r0 & 3)) * 512;
        const bf16* vp = Vb + (ptrdiff_t)((4 * fq + (r0 & 3)) * 32 + (L0 >> 2) - 4) * 256;
        for (int pp = 0; pp < 6; ++pp) { const int T0 = 2 * pp; const int lb = L0 - 16 + 4 * T0;
            const bool ok0 = (unsigned)lb < 128u, ok1 = (unsigned)(lb + 4) < 128u; if (!ok0 && !ok1) continue;
            const int D0 = 16 * (-16 + 4 * T0 - fr) + 4 * fq - (r0 & ~3) + 256;
            const bf16* k0p = kp + (ptrdiff_t)T0 * 64 * 512; const bf16* v0p = vp + (ptrdiff_t)T0 * 256;
            { bf16x8 k00, k01, k10, k11; u32x2 v0[4], v1[4];
                KLD(k0p, k00, k01); KLD(k0p + 64 * 512, k10, k11); VLD(v0p, v0); VLD(v0p + 256, v1);
                attn_step<256>(O[0], mrun[0], lsum[0], qf[0], k00, k01, k10, k11, v0, v1, D0, D0 + 64, ok0, ok1);
                attn_step<256>(O[1], mrun[1], lsum[1], qf[1], k00, k01, k10, k11, v0, v1, D0 - 4, D0 + 60, ok0, ok1); }
        }
    }
#pragma unroll
    for (int u = 0; u < 2; ++u) { float l2 = lsum[u]; l2 += __shfl_xor(l2, 16); l2 += __shfl_xor(l2, 32); const int pq = p0 + 16 * fr + r0 + 4 * u; const size_t qrow = (size_t)(b * SEQ + pq);
        const float* ml = (const float*)(p.ws + WS_P1ML) + (qrow * 8 + h) * 2; const float m1 = ml[0], l1 = ml[1];
        const float m = fmaxf(mrun[u], m1); const float a2 = __builtin_amdgcn_exp2f(mrun[u] - m), a1 = __builtin_amdgcn_exp2f(m1 - m) * l1; const float rden = 1.0f / (l2 * a2 + a1);
        const bf16* o1p = (const bf16*)(p.ws + WS_P1O) + qrow * 512 + h * 64 + 4 * fq;
#pragma unroll
        for (int d = 0; d < 4; ++d) { const u32x2 ow = *(const u32x2*)(o1p + 16 * d); u32x2 w;
            w.x = pk2((O[u][d][0] * a2 + bflo(ow.x) * a1) * rden, (O[u][d][1] * a2 + bfhi(ow.x) * a1) * rden); w.y = pk2((O[u][d][2] * a2 + bflo(ow.y) * a1) * rden, (O[u][d][3] * a2 + bfhi(ow.y) * a1) * rden);
            *(u32x2*)(Yrow[u] + 16 * d + 4 * fq) = w; } }
}
__device__ __forceinline__ void attn_quad_d1(const Params& p, int b, int h, int L, int lane) {
    const int fr = lane & 15, fq = lane >> 4, fK = fr >> 2, jK = fr & 3;
    const f32x4 z4 = {0.f, 0.f, 0.f, 0.f};
    bf16x8 qf[4][2]; f32x4 O[4][4]; float mrun[4], lsum[4];
    const bf16* Kb = (const bf16*)(p.ws + WS_AK) + (ptrdiff_t)b * SEQ * 512 + h * 64 + 8 * fq;
    const bf16* Vb = (const bf16*)(p.ws + WS_VT16) + (ptrdiff_t)(b * 8 + h) * 131072 + fr * 4;
#pragma unroll
    for (int i = 0; i < 4; ++i) { const bf16* qrow = (const bf16*)(p.ws + WS_Y) + ((size_t)(b * SEQ + 16 * (L + i) + fr)) * 1024 + 512 + h * 64;
        qf[i][0] = *(const bf16x8*)(qrow + 8 * fq); qf[i][1] = *(const bf16x8*)(qrow + 32 + 8 * fq); mrun[i] = -1e30f; lsum[i] = 0.f;
#pragma unroll
        for (int d = 0; d < 4; ++d) O[i][d] = z4; }
    const bf16* kp = Kb + (ptrdiff_t)(16 * (L - 4 + jK) + fK) * 512;
    const bf16* vp = Vb + (ptrdiff_t)(fq * 32 + (L >> 2) - 1) * 256;
    for (int kb = 0; kb < 3; ++kb) { const int lb = L - 4 + 4 * kb; if ((unsigned)lb >= 128u) continue;
#pragma unroll
        for (int th = 0; th < 2; ++th) { const int t0 = 2 * th;
            const int D0 = 16 * (-4 + 4 * kb) + 4 * t0 + fq - fr + 64;
            const bf16* k0p = kp + (ptrdiff_t)(64 * kb + 4 * t0) * 512; const bf16* v0p = vp + (ptrdiff_t)(128 * t0 + kb) * 256;
            bf16x8 k00, k01, k10, k11; u32x2 v0[4], v1[4];
            KLD(k0p, k00, k01); KLD(k0p + 4 * 512, k10, k11); VLD(v0p, v0); VLD(v0p + 128 * 256, v1);
#pragma unroll
            for (int i = 0; i < 4; ++i) { attn_step<64>(O[i], mrun[i], lsum[i], qf[i], k00, k01, k10, k11, v0, v1, D0 - 16 * i, D0 - 16 * i + 4, true, true); if (i & 1) __builtin_amdgcn_sched_barrier(0); } }
    }
#pragma unroll
    for (int i = 0; i < 4; ++i) { float l = lsum[i]; l += __shfl_xor(l, 16); l += __shfl_xor(l, 32); const float rl = 1.0f / l; const size_t qrow = (size_t)(b * SEQ + 16 * (L + i) + fr);
        bf16* o1p = (bf16*)(p.ws + WS_P1O) + qrow * 512 + h * 64 + 4 * fq;
#pragma unroll
        for (int d = 0; d < 4; ++d) { u32x2 w; w.x = pk2(O[i][d][0] * rl, O[i][d][1] * rl); w.y = pk2(O[i][d][2] * rl, O[i][d][3] * rl); *(u32x2*)(o1p + 16 * d) = w; }
        if (fq == 0) { float* ml = (float*)(p.ws + WS_P1ML) + (qrow * 8 + h) * 2; ml[0] = mrun[i]; ml[1] = l; } }
}
constexpr int QS_OFF = 0, KS_OFF = 17408, PF_OFF = 34816, PB_OFF = 44032, FL_OFF = 53248, QPITCH = 272, PPITCH = 144;
__device__ __forceinline__ void mout_unit(const Params& p, int layer, int u, LAS unsigned char* lds, int tid, int wave, int lane) {
    const int b = u >> 7, hh = (u >> 5) & 3, pc = u & 31, tok0 = pc * 64;
    const int fr = lane & 15, fq = lane >> 4;
    LAS float* FL = (LAS float*)(lds + FL_OFF);
    const float* Gp = (const float*)(p.ws + WS_G) + (size_t)(b * SEQ + tok0) * 16;
    const float* Mst = (const float*)(p.ws + WS_MST); const float* Nst = (const float*)(p.ws + WS_N);
    const bf16* Ct = (const bf16*)p.out;
    const size_t sid0 = (size_t)((b * 4 + hh) * 2 + 0) * 32 + pc, sid1 = (size_t)((b * 4 + hh) * 2 + 1) * 32 + pc;
    bf16x8 vaf[2], caf[2][4];
    { const bf16* Vr = (const bf16*)(p.ws + WS_VTM) + ((size_t)((b * 4 + hh) * 128 + 16 * wave + fr)) * SEQ + tok0;
#pragma unroll
      for (int ks = 0; ks < 2; ++ks) vaf[ks] = *(const bf16x8*)(Vr + 32 * ks + 8 * fq);
#pragma unroll
      for (int d = 0; d < 2; ++d) { const bf16* Cr = Ct + (d ? sid1 : sid0) * 16384 + (size_t)(16 * wave + fr) * 128;
#pragma unroll
          for (int kk = 0; kk < 4; ++kk) caf[d][kk] = *(const bf16x8*)(Cr + 32 * kk + 8 * fq); } }
    if (wave < 2) {
        const int dir = wave; const float li = Gp[lane * 16 + dir * 4 + hh], lf = Gp[lane * 16 + 8 + dir * 4 + hh];
        const float pre = wave_incl_scan_dpp(lf); const float total = __int_as_float(__builtin_amdgcn_readlane(__float_as_int(pre), 63));
        const float bt = dir ? (total - pre + lf) : pre; const float uu = li - bt;
        float pm;
        if (dir == 0) pm = wave_incl_max_dpp(uu); else pm = __shfl(wave_incl_max_dpp(__shfl(uu, 63 - lane)), 63 - lane);
        const float mprev = Mst[dir ? sid1 : sid0]; const float a = bt + mprev; const float mt = fmaxf(a, bt + pm);
        FL[(0 + 2 * dir) * 64 + lane] = bt - mt; FL[(1 + 2 * dir) * 64 + lane] = uu; FL[(4 + dir) * 64 + lane] = __expf(a - mt); FL[(6 + dir) * 64 + lane] = __expf(-mt);
    }
    {
        const bf16* QKm = (const bf16*)(p.ws + WS_QKM); const float* cwl = p.conv_w + (size_t)layer * 5 * 1024;
#pragma unroll
        for (int it4 = 0; it4 < 4; ++it4) { const int it = tid + it4 * NTHR; const int mat = it >> 10, rem = it & 1023, tok = rem >> 4, dg = rem & 15; const int col = mat * 512 + hh * 128 + 8 * dg;
            float a8[8];
#pragma unroll
            for (int j = 0; j < 8; ++j) a8[j] = 0.f;
#pragma unroll
            for (int t = 0; t < 5; ++t) { const int tt = tok0 + tok + t - 2;
                if (tt >= 0 && tt < SEQ) { const u32x4 xx = *(const u32x4*)(QKm + (size_t)(b * SEQ + tt) * 1024 + col);
                    const f32x4 w0 = *(const f32x4*)(cwl + t * 1024 + col), w1 = *(const f32x4*)(cwl + t * 1024 + col + 4);
                    a8[0] = fmaf(w0[0], bflo(xx.x), a8[0]); a8[1] = fmaf(w0[1], bfhi(xx.x), a8[1]); a8[2] = fmaf(w0[2], bflo(xx.y), a8[2]); a8[3] = fmaf(w0[3], bfhi(xx.y), a8[3]);
                    a8[4] = fmaf(w1[0], bflo(xx.z), a8[4]); a8[5] = fmaf(w1[1], bfhi(xx.z), a8[5]); a8[6] = fmaf(w1[2], bflo(xx.w), a8[6]); a8[7] = fmaf(w1[3], bfhi(xx.w), a8[7]); } }
            const float sc = mat ? 0.08838834764831845f : 1.0f;
#pragma unroll
            for (int j = 0; j < 8; ++j) a8[j] = a8[j] * __builtin_amdgcn_rcpf(1.0f + __expf(-a8[j])) * sc;
            u32x4 w; w.x = pk2(a8[0], a8[1]); w.y = pk2(a8[2], a8[3]); w.z = pk2(a8[4], a8[5]); w.w = pk2(a8[6], a8[7]);
            *(LAS u32x4*)(lds + (mat ? KS_OFF : QS_OFF) + tok * QPITCH + dg * 16) = w; }
    }
    __syncthreads();
    if (wave < 2) {
        const float* np = Nst + (wave ? sid1 : sid0) * 128; float acc = 0.f;
#pragma unroll
        for (int dg = 0; dg < 16; ++dg) { const u32x4 xx = *(const LAS u32x4*)(lds + QS_OFF + lane * QPITCH + dg * 16); const f32x4 n0 = *(const f32x4*)(np + 8 * dg), n1 = *(const f32x4*)(np + 8 * dg + 4);
            acc += bflo(xx.x) * n0[0] + bfhi(xx.x) * n0[1] + bflo(xx.y) * n0[2] + bfhi(xx.y) * n0[3] + bflo(xx.z) * n1[0] + bfhi(xx.z) * n1[1] + bflo(xx.w) * n1[2] + bfhi(xx.w) * n1[3]; }
        FL[(16 + wave) * 64 + lane] = acc;
    }
    {
        const int st = wave >> 1, tt0 = 2 * (wave & 1); const f32x4 z4 = {0.f, 0.f, 0.f, 0.f};
        bf16x8 ka[4];
#pragma unroll
        for (int ks = 0; ks < 4; ++ks) ka[ks] = *(const LAS bf16x8*)(lds + KS_OFF + (16 * st + fr) * QPITCH + (32 * ks + 8 * fq) * 2);
#pragma unroll
        for (int q = 0; q < 2; ++q) { const int t = 16 * (tt0 + q) + fr; f32x4 s = z4;
#pragma unroll
            for (int ks = 0; ks < 4; ++ks) { const bf16x8 qb = *(const LAS bf16x8*)(lds + QS_OFF + t * QPITCH + (32 * ks + 8 * fq) * 2); s = MFMA16(ka[ks], qb, s); }
            const float cf = FL[0 * 64 + t], cb = FL[2 * 64 + t]; float pf[4], pb[4]; float rf = 0.f, rb = 0.f;
#pragma unroll
            for (int j = 0; j < 4; ++j) { const int si = 16 * st + 4 * fq + j; const float uf = FL[1 * 64 + si], ub = FL[3 * 64 + si];
                pf[j] = (si <= t) ? s[j] * __expf(cf + uf) : 0.f; pb[j] = (si >= t) ? s[j] * __expf(cb + ub) : 0.f; rf += pf[j]; rb += pb[j]; }
            u32x2 w; w.x = pk2(pf[0], pf[1]); w.y = pk2(pf[2], pf[3]); *(LAS u32x2*)(lds + PF_OFF + t * PPITCH + (16 * st + 4 * fq) * 2) = w;
            w.x = pk2(pb[0], pb[1]); w.y = pk2(pb[2], pb[3]); *(LAS u32x2*)(lds + PB_OFF + t * PPITCH + (16 * st + 4 * fq) * 2) = w;
            rf += __shfl_xor(rf, 16); rf += __shfl_xor(rf, 32); rb += __shfl_xor(rb, 16); rb += __shfl_xor(rb, 32);
            if (fq == 0) { FL[(8 + st) * 64 + t] = rf; FL[(12 + st) * 64 + t] = rb; } }
    }
    __syncthreads();
    f32x4 aI[2][4], aX[2][4];
    {
        const f32x4 z4 = {0.f, 0.f, 0.f, 0.f};
#pragma unroll
        for (int d = 0; d < 2; ++d)
#pragma unroll
            for (int tt = 0; tt < 4; ++tt) { aI[d][tt] = z4; aX[d][tt] = z4; }
#pragma unroll
        for (int ks = 0; ks < 2; ++ks) { const bf16x8 va = vaf[ks];
#pragma unroll
            for (int tt = 0; tt < 4; ++tt) { const bf16x8 pfb = *(const LAS bf16x8*)(lds + PF_OFF + (16 * tt + fr) * PPITCH + (32 * ks + 8 * fq) * 2);
                const bf16x8 pbb = *(const LAS bf16x8*)(lds + PB_OFF + (16 * tt + fr) * PPITCH + (32 * ks + 8 * fq) * 2);
                aI[0][tt] = MFMA16(va, pfb, aI[0][tt]); aI[1][tt] = MFMA16(va, pbb, aI[1][tt]); } }
#pragma unroll
        for (int d = 0; d < 2; ++d) {
#pragma unroll
            for (int kk = 0; kk < 4; ++kk) { const bf16x8 ca = caf[d][kk];
#pragma unroll
                for (int tt = 0; tt < 4; ++tt) { const bf16x8 qb = *(const LAS bf16x8*)(lds + QS_OFF + (16 * tt + fr) * QPITCH + (32 * kk + 8 * fq) * 2); aX[d][tt] = MFMA16(ca, qb, aX[d][tt]); } } }
    }
    f32x4 hs[4];
#pragma unroll
    for (int tt = 0; tt < 4; ++tt) { const int t = 16 * tt + fr; const f32x4 z4 = {0.f, 0.f, 0.f, 0.f}; hs[tt] = z4;
#pragma unroll
        for (int d = 0; d < 2; ++d) { const float in = FL[(4 + d) * 64 + t]; const float den = ((FL[(8 + 4 * d) * 64 + t] + FL[(9 + 4 * d) * 64 + t]) + (FL[(10 + 4 * d) * 64 + t] + FL[(11 + 4 * d) * 64 + t])) + in * FL[(16 + d) * 64 + t];
            const float rd = 1.0f / fmaxf(fabsf(den), FL[(6 + d) * 64 + t]); hs[tt] += (aI[d][tt] + aX[d][tt] * in) * rd; }
        float sq = (hs[tt][0] * hs[tt][0] + hs[tt][1] * hs[tt][1]) + (hs[tt][2] * hs[tt][2] + hs[tt][3] * hs[tt][3]);
        sq += __shfl_xor(sq, 16); sq += __shfl_xor(sq, 32);
        if (fq == 0) FL[(18 + wave) * 64 + t] = sq; }
    __syncthreads();
    {
        const f32x4 hg = *(const f32x4*)(p.head_norm_g + layer * 512 + hh * 128 + 16 * wave + 4 * fq);
#pragma unroll
        for (int tt = 0; tt < 4; ++tt) { const int t = 16 * tt + fr; const float ssq = ((FL[18 * 64 + t] + FL[19 * 64 + t]) + (FL[20 * 64 + t] + FL[21 * 64 + t])) + ((FL[22 * 64 + t] + FL[23 * 64 + t]) + (FL[24 * 64 + t] + FL[25 * 64 + t])); const float rsd = rsqrtf(ssq * (1.0f / 128.0f) + 1e-6f);
            bf16* yp = (bf16*)(p.ws + WS_Y) + (size_t)(b * SEQ + tok0 + t) * 1024 + hh * 128 + 16 * wave + 4 * fq;
            const u32x2 gt = *(const u32x2*)yp;
            u32x2 w; w.x = pk2(hs[tt][0] * rsd * hg[0] * bflo(gt.x), hs[tt][1] * rsd * hg[1] * bfhi(gt.x)); w.y = pk2(hs[tt][2] * rsd * hg[2] * bflo(gt.y), hs[tt][3] * rsd * hg[3] * bfhi(gt.y));
            *(u32x2*)yp = w; }
    }
    __syncthreads();
}

#define XB_TMO      128
#define XB_XCNT(j)  (256  + 64 * (j))
#define XB_XSUB(j)  (1280 + 64 * (j))
#define XB_XGEN(j)  (2304 + 64 * (j))
#define XB_TOP      3328
#define XB_TOPGEN   3392
#define XCD_BAR_WORDS 3456
#define XB_SPIN_CAP (1u << 18)

__device__ __forceinline__ unsigned xb_ld(unsigned* p)              { return __hip_atomic_load(p, __ATOMIC_RELAXED, __HIP_MEMORY_SCOPE_AGENT); }
__device__ __forceinline__ unsigned xb_add(unsigned* p, unsigned v) { return __hip_atomic_fetch_add(p, v, __ATOMIC_RELAXED, __HIP_MEMORY_SCOPE_AGENT); }
__device__ __forceinline__ unsigned xb_xcc_id() { return (unsigned)__builtin_amdgcn_s_getreg((3 << 11) | 20) & 0xFu; }
#define XB_SPIN(cond, bar) do { unsigned _sp = 0; while (cond) { __builtin_amdgcn_s_sleep(1); \
    if ((++_sp & 255u) == 0u) { if (xb_ld(&(bar)[XB_TMO])) break; if (_sp > XB_SPIN_CAP) { atomicAdd(&(bar)[XB_TMO], 1u); break; } } } } while (0)

struct XcdBarrier {
    unsigned* bar; unsigned x;
    volatile LAS unsigned* st;
};

__device__ __forceinline__ XcdBarrier xcd_barrier_post(unsigned* bar, volatile LAS unsigned* st) {
    XcdBarrier b; b.bar = bar; b.x = xb_xcc_id(); b.st = st;
    if (threadIdx.x == 0) (void)xb_add(&bar[XB_XCNT(b.x)], 1u);
    return b;
}
__device__ __forceinline__ void xcd_barrier_complete(unsigned* bar, unsigned x, unsigned& nloc, unsigned& nx) {
    const unsigned G = gridDim.x * gridDim.y * gridDim.z;
    unsigned sum, cnt, mine, sp = 0u;
    for (;;) {
        sum = 0u; cnt = 0u; mine = 0u;
#pragma unroll
        for (unsigned j = 0; j < 16; ++j) { const unsigned c = xb_ld(&bar[XB_XCNT(j)]); sum += c; cnt += (c > 0u) ? 1u : 0u; mine = (j == x) ? c : mine; }
        if (sum == G) break;
        __builtin_amdgcn_s_sleep(1);
        if ((++sp & 255u) == 0u) { if (xb_ld(&bar[XB_TMO])) break; if (sp > XB_SPIN_CAP) { atomicAdd(&bar[XB_TMO], 1u); break; } }
    }
    nloc = mine > 0u ? mine : 1u; nx = cnt > 0u ? cnt : 1u;
}

__device__ __forceinline__ void xcd_barrier(const XcdBarrier& b) {
    asm volatile("s_waitcnt vmcnt(0)" ::: "memory");
    __syncthreads();
    if (threadIdx.x == 0) {
        unsigned* bar = b.bar;
        __builtin_amdgcn_s_waitcnt(0);
        unsigned nloc = b.st[0], nx = b.st[1];
        if (nloc == 0u) { xcd_barrier_complete(bar, b.x, nloc, nx); b.st[0] = nloc; b.st[1] = nx; }
        const unsigned old = xb_add(&bar[XB_XSUB(b.x)], 1u);
        const unsigned gen = old / nloc;
        if (old + 1u == (gen + 1u) * nloc) {
            __builtin_amdgcn_fence(__ATOMIC_RELEASE, "agent");
            asm volatile("s_waitcnt vmcnt(0)" ::: "memory");
            const unsigned og = xb_add(&bar[XB_TOP], 1u);
            const unsigned tg = og / nx;
            if (og + 1u == (tg + 1u) * nx) xb_add(&bar[XB_TOPGEN], 1u);
            else XB_SPIN(xb_ld(&bar[XB_TOPGEN]) == tg, bar);
            __builtin_amdgcn_fence(__ATOMIC_ACQUIRE, "agent");
            xb_add(&bar[XB_XGEN(b.x)], 1u);
            asm volatile("s_waitcnt vmcnt(0)" ::: "memory");
        } else {
            XB_SPIN(xb_ld(&bar[XB_XGEN(b.x)]) == gen, bar);
            __builtin_amdgcn_fence(__ATOMIC_ACQUIRE, "agent");
            asm volatile("s_waitcnt vmcnt(0)" ::: "memory");
        }
    }
    __syncthreads();
}

__global__ void __launch_bounds__(NTHR, 2) fwd_megakernel(Params p) {
    extern __shared__ __attribute__((aligned(16))) unsigned char lds_raw[];
    LAS unsigned char* lds = (LAS unsigned char*)lds_raw;
    cg::grid_group grid = cg::this_grid();
#define GRID_SYNC_CG() do { asm volatile("s_waitcnt vmcnt(0) lgkmcnt(0)" ::: "memory"); grid.sync(); \
        __builtin_amdgcn_fence(__ATOMIC_ACQUIRE, "agent"); asm volatile("s_waitcnt vmcnt(0)" ::: "memory"); __syncthreads(); } while (0)
#define GRID_SYNC() do { XcdBarrier xb_; xb_.bar = (unsigned*)(p.ws + WS_CTL); xb_.x = xb_xcc_id(); xb_.st = (volatile LAS unsigned*)(lds + LDS_MISC); xcd_barrier(xb_); } while (0)
    const int tid = threadIdx.x, lane = tid & 63, wave = __builtin_amdgcn_readfirstlane(tid >> 6), G = gridDim.x, bid = blockIdx.x;
    const int vcu = (G % 8 == 0) ? (bid % 8) * (G / 8) + bid / 8 : bid;
    float* ss = (float*)(p.ws + WS_SSP);
    { volatile LAS unsigned* st0 = (volatile LAS unsigned*)(lds + LDS_MISC); if (threadIdx.x < 2) st0[threadIdx.x] = 0u; __syncthreads(); }
    (void)xcd_barrier_post((unsigned*)(p.ws + WS_CTL), (volatile LAS unsigned*)(lds + LDS_MISC));
    bf16* xb = (bf16*)(p.ws + WS_XB);

    const bool defer = (G == 256);
    p0_prologue(p, lds, wave, lane, G, defer ? -1 : 2 * I_L);
    if (G == 0x7fffffff) GRID_SYNC_CG();
    GRID_SYNC();

    for (int layer = 0; layer < 2; ++layer) {
#define RELANE() int tid = threadIdx.x; asm volatile("" : "+v"(tid)); const int lane = tid & 63, wave = __builtin_amdgcn_readfirstlane(tid >> 6)
        {
            pg8::Gemm g{xb, (const bf16*)(p.ws + WS_WIN) + (size_t)layer * NINP * DM, MROWS, NINP, DM};
            pg8::StaticOrder S; S.init(MROWS, NINP, G, bid);
            pg8::EpiIn E{ss + (size_t)(2 * layer) * MROWS * 16, p.ws, p.gate_i_b + layer * 8, p.gate_f_b + layer * 8};
            static_assert(pg8::EpiIn::O_ROPE == WS_ROPE && pg8::EpiIn::O_G == WS_G && pg8::EpiIn::O_QKM == WS_QKM && pg8::EpiIn::O_KTM == WS_KTM && pg8::EpiIn::O_VTM == WS_VTM && pg8::EpiIn::O_AK == WS_AK && pg8::EpiIn::O_VT16 == WS_VT16 && pg8::EpiIn::O_Y == WS_Y, "ws map");
            pg8::gemm_phase<pg8::EpiIn, pg8::StaticOrder, true, true>(lds, g, S, E);
            if (defer && bid >= 192) { RELANE(); LAS float* scr = (LAS float*)(lds + wave * 16384);
                for (int it = layer * I_L + I_IN + I_OUT + (bid - 192) * NWAVE + wave; it < (layer + 1) * I_L; it += 64 * NWAVE) convert_item(p, it, scr, lane); }
        }
        GRID_SYNC();
        {
            RELANE();
            volatile LAS unsigned* ctr = (volatile LAS unsigned*)(lds + LDS_MISC + 16);
            if (tid == 0) *ctr = 0u;
            const int nU = (512 - vcu + G - 1) / G;
            const bool fast = (G * 2 == 512);
            if (fast && wave < 2) {
                __builtin_amdgcn_s_setprio(3);
                scan_wave(p, layer, vcu * 2 + wave, (LAS float*)(lds + wave * 256), lane, true);
                __builtin_amdgcn_s_setprio(0);
            } else {
                const int w0 = fast ? 2 : 0, nw = fast ? 6 : NWAVE;
                for (int I = wave - w0; I < 4 * nU; I += nw) { const int au = vcu + G * (I >> 2); const int b = au >> 6, h = (au >> 3) & 7, p0 = (au & 7) * 256;
                    attn_quad_d1(p, b, h, (p0 >> 4) + 4 * (I & 3), lane); }
                asm volatile("s_waitcnt vmcnt(0)" ::: "memory");
                __syncthreads();
                if (!fast && wave < 2) for (int sw = vcu * 2 + wave; sw < 512; sw += G * 2) scan_wave(p, layer, sw, (LAS float*)(lds + wave * 256), lane, false);
            }
            {
                const int nQ = 8 * nU;
                for (;;) { unsigned Q = 0; if (lane == 0) Q = atomicAdd((unsigned*)(lds_raw + LDS_MISC + 16), 1u); Q = (unsigned)__builtin_amdgcn_readfirstlane((int)Q);
                    if ((int)Q >= nQ) break;
                    const int au = vcu + G * (int)(Q >> 3); const int b = au >> 6, h = (au >> 3) & 7, p0 = (au & 7) * 256; attn_pair(p, b, h, p0, (int)((Q & 3) + 8 * ((Q >> 2) & 1)), lane); }
            }
        }
        GRID_SYNC();
        { RELANE(); for (int u = vcu; u < 1024; u += G) mout_unit(p, layer, u, lds, tid, wave, lane); }
        GRID_SYNC();
        {
            pg8::Gemm g{(const bf16*)(p.ws + WS_Y), (const bf16*)(p.ws + WS_WOUT) + (size_t)layer * DM * DM, MROWS, DM, DM};
            pg8::StaticOrder S; S.init(MROWS, DM, G, bid);
            pg8::EpiRes E{xb, ss + (size_t)(2 * layer + 1) * MROWS * 16};
            pg8::gemm_phase<pg8::EpiRes, pg8::StaticOrder, true, true>(lds, g, S, E);
        }
        GRID_SYNC();
        {
            pg8::Gemm g{xb, (const bf16*)(p.ws + WS_WUP) + (size_t)layer * FF * DM, MROWS, FF, DM};
            pg8::StaticOrder S; S.init(MROWS, FF, G, bid);
            pg8::EpiUp E{ss + (size_t)(2 * layer + 1) * MROWS * 16, (bf16*)(p.ws + WS_U)};
            pg8::gemm_phase<pg8::EpiUp, pg8::StaticOrder, true, true>(lds, g, S, E);
        }
        GRID_SYNC();
        {
            pg8::Gemm g{(const bf16*)(p.ws + WS_U), (const bf16*)(p.ws + WS_WDN) + (size_t)layer * DM * FF, MROWS, DM, FF};
            pg8::StaticOrder S; S.init(MROWS, DM, G, bid);
            pg8::EpiRes E{xb, ss + (size_t)(2 * layer + 2) * MROWS * 16};
            pg8::gemm_phase<pg8::EpiRes, pg8::StaticOrder, true, true>(lds, g, S, E);
        }
        GRID_SYNC();
    }
    {
        RELANE();
        const int gw = bid * NWAVE + wave, NGW = G * NWAVE;
        for (int m = gw; m < MROWS; m += NGW) { const float rsd = rsqrtf(pg8::row_ss(ss + (size_t)4 * MROWS * 16, m) * (1.0f / 1024.0f) + 1e-6f);
            const u32x2* xr = (const u32x2*)(xb + (size_t)m * DM) + lane; f32x4* orow = (f32x4*)(p.out + (size_t)m * DM) + lane; const f32x4* gr = (const f32x4*)p.final_g + lane;
#pragma unroll
            for (int j = 0; j < 4; ++j) { const u32x2 w = xr[64 * j]; const f32x4 g4 = gr[64 * j]; f32x4 o; o[0] = bflo(w.x) * rsd * g4[0]; o[1] = bfhi(w.x) * rsd * g4[1]; o[2] = bflo(w.y) * rsd * g4[2]; o[3] = bfhi(w.y) * rsd * g4[3]; orow[64 * j] = o; } }
    }
}

extern "C" void kernel_launch(void* const* d_in, const int* in_sizes, int n_in, void* d_out, int out_size, void* d_ws, size_t ws_size, hipStream_t stream) {
    static int grid = 0;
    if (grid == 0) {
        int dev = 0, cus = 0, per_cu = 0;
        (void)hipGetDevice(&dev);
        (void)hipDeviceGetAttribute(&cus, hipDeviceAttributeMultiprocessorCount, dev);
        (void)hipFuncSetAttribute((const void*)fwd_megakernel, hipFuncAttributeMaxDynamicSharedMemorySize, LDS_BYTES);
        (void)hipOccupancyMaxActiveBlocksPerMultiprocessor(&per_cu, (const void*)fwd_megakernel, NTHR, LDS_BYTES);
        if (per_cu < 1) per_cu = 1;
        grid = cus * per_cu;
        if (ws_size < WS_END) { fprintf(stderr, "kernel_launch: workspace too small (%zu)\n", ws_size); grid = -1; }
    }
    if (grid < 0) return;
    Params p{};
    p.x = (const float*)d_in[0]; p.norm1_g = (const float*)d_in[1]; p.w_in = (const float*)d_in[2]; p.conv_w = (const float*)d_in[3];
    p.gate_i_b = (const float*)d_in[4]; p.gate_f_b = (const float*)d_in[5]; p.head_norm_g = (const float*)d_in[6]; p.w_out = (const float*)d_in[7];
    p.norm2_g = (const float*)d_in[8]; p.w_up = (const float*)d_in[9]; p.w_down = (const float*)d_in[10]; p.final_g = (const float*)d_in[11];
    p.out = (float*)d_out; p.ws = (unsigned char*)d_ws;
    (void)hipMemsetAsync((char*)d_ws + WS_CTL, 0, CTL_BYTES, stream);
    void* args[] = {&p};
    hipError_t e = hipLaunchCooperativeKernel((void*)fwd_megakernel, dim3(grid), dim3(NTHR), args, LDS_BYTES, stream);
    if (e != hipSuccess) fprintf(stderr, "cooperative launch failed: %s (grid %d)\n", hipGetErrorString(e), grid);
}
```

```cpp
#include <hip/hip_runtime.h>
#include <hip/hip_cooperative_groups.h>
#include <cstdio>
#include <cstdint>
#include <cmath>
namespace cg = cooperative_groups;
namespace pg8 {
#define PG8_LAS __attribute__((address_space(3)))
typedef unsigned short bf16_t;
typedef short bf16x8 __attribute__((ext_vector_type(8)));
typedef float f32x4 __attribute__((ext_vector_type(4)));
typedef unsigned u32x4 __attribute__((ext_vector_type(4)));
constexpr int BM = 256, BK = 64, HALF = 128, HTB = HALF * BK * 2  , STAGE_BYTES = 8 * HTB, NXCD = 8, WGM = 4;

__host__ __device__ __forceinline__ int lds_byte(int r, int c) { const int st = (r >> 4) * 2 + (c >> 5), rr = r & 15, cc = c & 31, ob = rr * 64 + cc * 2; return st * 1024 + (ob ^ (((ob >> 9) & 1) << 5)); }
__host__ __device__ __forceinline__ void stage_rc(int b, int& R, int& C) { const int st = b / 1024, sb = b % 1024, swz = sb ^ (((sb >> 9) & 1) << 5); R = (st >> 1) * 16 + swz / 64; C = (st & 1) * 32 + (swz % 64) / 2; }
__host__ __device__ __forceinline__ int perm32(int rho) { const int n = rho >> 4, i = rho & 15; return 8 * (i >> 2) + 4 * n + (i & 3); }

struct Unit { int pm, pn; };
struct Gemm { const bf16_t* A; const bf16_t* Bt; int M, N, K; };

struct StaticOrder {
    int nM, nN, nwg, G, c;
    __host__ __device__ void init(int M, int N, int G_, int c_) { nM = M / BM; nN = N / BM; nwg = nM * nN; G = G_; c = c_; }
    __host__ __device__ bool next(int i, Unit& u) const {
        const long L = (long)i * G + c; if (L >= nwg) return false;
        int wgid = (int)L; { const int q = nwg / NXCD, r = nwg % NXCD, xcd = wgid % NXCD, off = wgid / NXCD; wgid = (xcd < r ? xcd * (q + 1) : r * (q + 1) + (xcd - r) * q) + off; }
        const int nig = WGM * nN, gid = wgid / nig, fm = gid * WGM, gsz = (nM - fm) < WGM ? (nM - fm) : WGM;
        u.pm = fm + ((wgid % nig) % gsz); u.pn = (wgid % nig) / gsz; return true;
    }
    __device__ __forceinline__ void a_ready(const Unit&) const {}
    __device__ __forceinline__ void done(const Unit&) const {}
};

typedef float f32x2c_t __attribute__((ext_vector_type(2))); typedef __bf16 bf16x2c_t __attribute__((ext_vector_type(2)));
__device__ __forceinline__ unsigned cvt_pk_bf16(float lo, float hi) { f32x2c_t v = {lo, hi}; bf16x2c_t b = __builtin_convertvector(v, bf16x2c_t); return __builtin_bit_cast(unsigned, b); }
typedef float f32x2 __attribute__((ext_vector_type(2)));
__device__ __forceinline__ unsigned short bf16_1(float v) { return (unsigned short)(cvt_pk_bf16(v, v) & 0xffffu); }
__device__ __forceinline__ float row_ss(const float* ssp, int row) { const f32x4* q = (const f32x4*)(ssp + (size_t)row * 16); const f32x4 a = q[0], b = q[1], c = q[2], d = q[3];
    return (((a[0] + a[1]) + (a[2] + a[3])) + ((b[0] + b[1]) + (b[2] + b[3]))) + (((c[0] + c[1]) + (c[2] + c[3])) + ((d[0] + d[1]) + (d[2] + d[3]))); }
__device__ __forceinline__ float row_ss_q(const float* ssp, int row, int fq) { const f32x4 a = *(const f32x4*)(ssp + (size_t)row * 16 + 4 * fq); float t = (a[0] + a[1]) + (a[2] + a[3]);
    t += __shfl_xor(t, 16); t += __shfl_xor(t, 32); return t; }
struct EpiIn {
    static constexpr bool PERM = true, AFTER_DRAIN = false;
    const float* ss; unsigned char* ws; const float* gib; const float* gfb;
    static constexpr size_t O_ROPE = 512 * 1024, O_G = 3u << 20, O_QKM = 120u << 20, O_KTM = 152u << 20, O_VTM = 168u << 20, O_AK = 184u << 20, O_VT16 = 200u << 20, O_Y = 216u << 20;
    __device__ __forceinline__ void operator()(const f32x4 (&acc)[2][2][4][2], const Unit& u, int wr, int wc, int fr_, int fq_) const {
        int fr = fr_, fq = fq_; asm volatile("" : "+v"(fr), "+v"(fq));
        const int pn = u.pn;
        const int rbase = u.pm * BM + wr * 64 + fr;
        float rsv[2][4];
#pragma unroll
        for (int ai = 0; ai < 2; ++ai)
#pragma unroll
            for (int m = 0; m < 4; ++m) rsv[ai][m] = row_ss_q(ss, rbase + ai * HALF + m * 16, fq);
#pragma unroll
        for (int ai = 0; ai < 2; ++ai)
#pragma unroll
            for (int m = 0; m < 4; ++m) rsv[ai][m] = rsqrtf(rsv[ai][m] * (1.0f / 1024.0f) + 1e-6f);
        if (pn < 4) {
            bf16_t* QKm = (bf16_t*)(ws + O_QKM);
#pragma unroll
            for (int ai = 0; ai < 2; ++ai)
#pragma unroll
                for (int m = 0; m < 4; ++m) { const int row = rbase + ai * HALF + m * 16; const float r = rsv[ai][m]; bf16_t* rowp = QKm + (size_t)row * 1024 + pn * 256 + wc * 32 + 8 * fq;
#pragma unroll
                    for (int bj = 0; bj < 2; ++bj) { const f32x4 v0 = acc[ai][bj][m][0] * r, v1 = acc[ai][bj][m][1] * r; u32x4 w;
                        w.x = cvt_pk_bf16(v0[0], v0[1]); w.y = cvt_pk_bf16(v0[2], v0[3]); w.z = cvt_pk_bf16(v1[0], v1[1]); w.w = cvt_pk_bf16(v1[2], v1[3]);
                        *(u32x4*)(rowp + bj * HALF) = w; }
                    asm volatile("" ::: "memory"); }
        }
        if ((pn >= 2 && pn < 6)) {
            const int row0 = u.pm * BM; const int b = row0 >> 11;
            unsigned char* ub = ws + ((pn < 4) ? O_KTM : O_VTM) + ((size_t)(((b * 4 + 2 * (pn & 1)) * 128 + wc * 32) * 2048 + (row0 & 2047) + wr * 64)) * 2;
            const unsigned voff = (unsigned)((8 * fq) * 2048 + fr) * 2u;
#pragma unroll
            for (int ai = 0; ai < 2; ++ai)
#pragma unroll
                for (int m = 0; m < 4; m += 2) { const float r0 = rsv[ai][m], r1 = rsv[ai][m + 1];
#pragma unroll
                    for (int bj = 0; bj < 2; ++bj)
#pragma unroll
                        for (int n = 0; n < 2; ++n)
#pragma unroll
                            for (int j = 0; j < 4; ++j) { const unsigned w = cvt_pk_bf16(acc[ai][bj][m][n][j] * r0, acc[ai][bj][m + 1][n][j] * r1);
                                unsigned char* q = ub + (size_t)(((bj * 128 + 4 * n + j) * 2048 + ai * HALF + m * 16) * 2) + voff;
                                *(bf16_t*)q = (bf16_t)(w & 0xffffu); *(bf16_t*)(q + 32) = (bf16_t)(w >> 16); }
                    asm volatile("" ::: "memory"); }
        } else if (pn == 6 || pn == 7) {
            bf16_t* Y = (bf16_t*)(ws + O_Y);
#pragma unroll
            for (int ai = 0; ai < 2; ++ai)
#pragma unroll
                for (int m = 0; m < 4; ++m) { const int row = rbase + ai * HALF + m * 16; const float r = rsv[ai][m]; bf16_t* rowp = Y + (size_t)row * 1024 + (pn - 6) * 256 + wc * 32 + 8 * fq;
#pragma unroll
                    for (int bj = 0; bj < 2; ++bj) { f32x4 v0 = acc[ai][bj][m][0] * r, v1 = acc[ai][bj][m][1] * r;
#pragma unroll
                        for (int j = 0; j < 4; ++j) { v0[j] = __builtin_amdgcn_rcpf(1.0f + __expf(-v0[j])); v1[j] = __builtin_amdgcn_rcpf(1.0f + __expf(-v1[j])); }
                        u32x4 w; w.x = cvt_pk_bf16(v0[0], v0[1]); w.y = cvt_pk_bf16(v0[2], v0[3]); w.z = cvt_pk_bf16(v1[0], v1[1]); w.w = cvt_pk_bf16(v1[2], v1[3]);
                        *(u32x4*)(rowp + bj * HALF) = w; }
                    asm volatile("" ::: "memory"); }
        } else if (pn >= 8 && pn < 12) {
            const bool isk = pn >= 10; const int head = 4 * (pn & 1) + wc; const float qs = isk ? 1.0f : 0.125f * 1.4426950408889634f;
            const float* ropeC = (const float*)(ws + O_ROPE) + 8 * fq; const float* ropeS = ropeC + 2048 * 32;
            f32x4 tb[2][4];
            { const int pos = rbase & 2047; tb[0][0] = *(const f32x4*)(ropeC + pos * 32); tb[0][1] = *(const f32x4*)(ropeC + pos * 32 + 4); tb[0][2] = *(const f32x4*)(ropeS + pos * 32); tb[0][3] = *(const f32x4*)(ropeS + pos * 32 + 4); }
#pragma unroll
            for (int it = 0; it < 8; ++it) { const int ai = it >> 2, m = it & 3; const int row = rbase + ai * HALF + m * 16; const float r = rsv[ai][m] * qs;
                if (it < 7) { const int pos2 = (rbase + ((it + 1) >> 2) * HALF + ((it + 1) & 3) * 16) & 2047;
                    tb[(it + 1) & 1][0] = *(const f32x4*)(ropeC + pos2 * 32); tb[(it + 1) & 1][1] = *(const f32x4*)(ropeC + pos2 * 32 + 4); tb[(it + 1) & 1][2] = *(const f32x4*)(ropeS + pos2 * 32); tb[(it + 1) & 1][3] = *(const f32x4*)(ropeS + pos2 * 32 + 4); }
                const f32x4 c0 = tb[it & 1][0], c1 = tb[it & 1][1], s0 = tb[it & 1][2], s1 = tb[it & 1][3];
                const f32x4 a0 = acc[ai][0][m][0] * r, a1 = acc[ai][0][m][1] * r, b0 = acc[ai][1][m][0] * r, b1 = acc[ai][1][m][1] * r;
                const f32x4 o10 = a0 * c0 - b0 * s0, o11 = a1 * c1 - b1 * s1, o20 = a0 * s0 + b0 * c0, o21 = a1 * s1 + b1 * c1;
                bf16_t* dst = isk ? ((bf16_t*)(ws + O_AK) + (size_t)row * 512 + head * 64 + 8 * fq) : ((bf16_t*)(ws + O_Y) + (size_t)row * 1024 + 512 + head * 64 + 8 * fq);
                u32x4 w; w.x = cvt_pk_bf16(o10[0], o10[1]); w.y = cvt_pk_bf16(o10[2], o10[3]); w.z = cvt_pk_bf16(o11[0], o11[1]); w.w = cvt_pk_bf16(o11[2], o11[3]);
                *(u32x4*)(dst) = w;
                w.x = cvt_pk_bf16(o20[0], o20[1]); w.y = cvt_pk_bf16(o20[2], o20[3]); w.z = cvt_pk_bf16(o21[0], o21[1]); w.w = cvt_pk_bf16(o21[2], o21[3]);
                *(u32x4*)(dst + 32) = w;
                asm volatile("" ::: "memory"); }
        } else if (pn == 12 || pn == 13) {
            const int row0 = u.pm * BM; const int b = row0 >> 11;
            typedef unsigned u32x2v __attribute__((ext_vector_type(2)));
            unsigned char* ub = ws + O_VT16 + ((size_t)((((b * 8 + 4 * (pn - 12) + (wc >> 1)) * 16 * 32 + ((row0 & 2047) >> 6) + wr) * 256) + (wc & 1) * 128)) * 2;
            const unsigned voff = (unsigned)(fr * 32 * 256 + 8 * fq * 4) * 2u;
#pragma unroll
            for (int ai = 0; ai < 2; ++ai) { const float r0 = rsv[ai][0], r1 = rsv[ai][1], r2 = rsv[ai][2], r3 = rsv[ai][3];
#pragma unroll
                for (int bj = 0; bj < 2; ++bj)
#pragma unroll
                    for (int n = 0; n < 2; ++n)
#pragma unroll
                        for (int j = 0; j < 4; ++j) { u32x2v w; w.x = cvt_pk_bf16(acc[ai][bj][0][n][j] * r0, acc[ai][bj][1][n][j] * r1); w.y = cvt_pk_bf16(acc[ai][bj][2][n][j] * r2, acc[ai][bj][3][n][j] * r3);
                            *(u32x2v*)(ub + (size_t)((bj * 262144 + 2 * ai * 256 + (4 * n + j) * 4) * 2) + voff) = w; }
                asm volatile("" ::: "memory"); }
        } else if (pn == 14) {
            if (wc == 0 && fq < 2) {
                float* G = (float*)(ws + O_G);
#pragma unroll
                for (int ai = 0; ai < 2; ++ai)
#pragma unroll
                    for (int m = 0; m < 4; ++m) { const int row = rbase + ai * HALF + m * 16; const float r = rsv[ai][m];
#pragma unroll
                        for (int n = 0; n < 2; ++n) { f32x4 v = acc[ai][0][m][n] * r; f32x4 o;
#pragma unroll
                            for (int j = 0; j < 4; ++j) { const int c8 = 4 * n + j;
                                if (fq == 0) o[j] = v[j] + gib[c8];
                                else { const float x = v[j] + gfb[c8]; o[j] = fminf(x, 0.0f) - __logf(1.0f + __expf(-fabsf(x))); } }
                            *(f32x4*)(G + (size_t)row * 16 + 8 * fq + 4 * n) = o; }
                        asm volatile("" ::: "memory"); }
            }
        }
    }
};
struct EpiRes {
    static constexpr bool PERM = true, AFTER_DRAIN = false;
    bf16_t* xb; float* ssn;
    __device__ __forceinline__ void operator()(const f32x4 (&acc)[2][2][4][2], const Unit& u, int wr, int wc, int fr, int fq) const {
        const int col0 = u.pn * BM + wc * 32 + 8 * fq;
#pragma unroll
        for (int ai = 0; ai < 2; ++ai)
#pragma unroll
            for (int m = 0; m < 4; ++m) { const int row = u.pm * BM + ai * HALF + wr * 64 + m * 16 + fr; bf16_t* rp = xb + (size_t)row * 1024 + col0; float sq = 0.f;
#pragma unroll
                for (int bj = 0; bj < 2; ++bj) { const u32x4 b = *(const u32x4*)(rp + bj * HALF);
                    const f32x4 v0 = acc[ai][bj][m][0], v1 = acc[ai][bj][m][1];
                    const float o0 = __uint_as_float(b.x << 16) + v0[0], o1 = __uint_as_float(b.x & 0xffff0000u) + v0[1], o2 = __uint_as_float(b.y << 16) + v0[2], o3 = __uint_as_float(b.y & 0xffff0000u) + v0[3];
                    const float o4 = __uint_as_float(b.z << 16) + v1[0], o5 = __uint_as_float(b.z & 0xffff0000u) + v1[1], o6 = __uint_as_float(b.w << 16) + v1[2], o7 = __uint_as_float(b.w & 0xffff0000u) + v1[3];
                    u32x4 w; w.x = cvt_pk_bf16(o0, o1); w.y = cvt_pk_bf16(o2, o3); w.z = cvt_pk_bf16(o4, o5); w.w = cvt_pk_bf16(o6, o7);
                    *(u32x4*)(rp + bj * HALF) = w;
                    sq += ((o0 * o0 + o1 * o1) + (o2 * o2 + o3 * o3)) + ((o4 * o4 + o5 * o5) + (o6 * o6 + o7 * o7)); }
                sq += __shfl_xor(sq, 16); sq += __shfl_xor(sq, 32);
                if (fq == 0) ssn[(size_t)row * 16 + u.pn * 4 + wc] = sq; }
    }
};
struct EpiUp {
    static constexpr bool PERM = true, AFTER_DRAIN = false;
    const float* ss; bf16_t* U;
    __device__ __forceinline__ void operator()(const f32x4 (&acc)[2][2][4][2], const Unit& u, int wr, int wc, int fr, int fq) const {
        const int rbase = u.pm * BM + wr * 64 + fr;
        float rsv[2][4];
#pragma unroll
        for (int ai = 0; ai < 2; ++ai)
#pragma unroll
            for (int m = 0; m < 4; ++m) rsv[ai][m] = row_ss_q(ss, rbase + ai * HALF + m * 16, fq);
#pragma unroll
        for (int ai = 0; ai < 2; ++ai)
#pragma unroll
            for (int m = 0; m < 4; ++m) { const int row = rbase + ai * HALF + m * 16; const float r = rsqrtf(rsv[ai][m] * (1.0f / 1024.0f) + 1e-6f);
                bf16_t* rowp = U + (size_t)row * 4096 + u.pn * BM + wc * 32 + 8 * fq;
#pragma unroll
                for (int bj = 0; bj < 2; ++bj) { f32x4 v0 = acc[ai][bj][m][0] * r, v1 = acc[ai][bj][m][1] * r;
#pragma unroll
                    for (int j = 0; j < 4; ++j) { v0[j] = fmaxf(v0[j], 0.f); v0[j] *= v0[j]; v1[j] = fmaxf(v1[j], 0.f); v1[j] *= v1[j]; }
                    u32x4 w; w.x = cvt_pk_bf16(v0[0], v0[1]); w.y = cvt_pk_bf16(v0[2], v0[3]); w.z = cvt_pk_bf16(v1[0], v1[1]); w.w = cvt_pk_bf16(v1[2], v1[3]);
                    *(u32x4*)(rowp + bj * HALF) = w; } }
    }
};
template <class Epi, class Sched, bool ALIGN_EPI = false, bool SP2 = false>
__device__ __forceinline__ void gemm_phase(PG8_LAS unsigned char* lds, const Gemm g, const Sched& S, const Epi& E) {
    int tid_ = threadIdx.x; asm volatile("" : "+v"(tid_));
    const int tid = tid_, wid = __builtin_amdgcn_readfirstlane(tid >> 6), lane = tid & 63, wr = wid >> 2, wc = wid & 3, fr = lane & 15, fq = lane >> 4;
    const int K = g.K, nt = K / BK;
    unsigned voffA[2], voffB[2];
#pragma unroll
    for (int i = 0; i < 2; ++i) { int R, C; stage_rc(tid * 16 + i * 8192, R, C); const int Rb = Epi::PERM ? ((R & ~31) + perm32(R & 31)) : R;
        voffA[i] = (unsigned)(R * K + C) * 2u; voffB[i] = (unsigned)(Rb * K + C) * 2u; }
    const size_t kstep = (size_t)(BK * 2);
    const size_t hstep = (size_t)HALF * K * 2;
    const size_t tstep = 2 * hstep;
    const unsigned ldsw = (unsigned)wid * 1024u;
    const int aoff = lds_byte(wr * 64 + fr, fq * 8), boff = lds_byte(wc * 32 + fr, fq * 8);
#define PG8_SA(b, h) (((b) * 2 + (h)) * HTB)
#define PG8_SB(b, h) ((4 + (b) * 2 + (h)) * HTB)
#define PG8_STAGE(bufoff, gbase, voff) do { _Pragma("unroll") for (int _i = 0; _i < 2; ++_i) \
        __builtin_amdgcn_global_load_lds((const unsigned*)((const char*)(gbase) + (voff)[_i]), (PG8_LAS unsigned*)(lds + (bufoff) + ldsw + _i * 8192), 16, 0, 0); } while (0)
#define PG8_LDA(dst, b, h) do { _Pragma("unroll") for (int m = 0; m < 4; ++m) _Pragma("unroll") for (int k = 0; k < 2; ++k) dst[m][k] = *(const PG8_LAS bf16x8*)(lds + PG8_SA(b, h) + aoff + m * 2048 + k * 1024); } while (0)
#define PG8_LDB(dst, b, h) do { _Pragma("unroll") for (int n = 0; n < 2; ++n) _Pragma("unroll") for (int k = 0; k < 2; ++k) dst[n][k] = *(const PG8_LAS bf16x8*)(lds + PG8_SB(b, h) + boff + n * 2048 + k * 1024); } while (0)
#define PG8_MMA(ai, bj, At, Bt) do { __builtin_amdgcn_s_setprio(1); _Pragma("unroll") for (int m = 0; m < 4; ++m) _Pragma("unroll") for (int n = 0; n < 2; ++n) _Pragma("unroll") for (int k = 0; k < 2; ++k) \
        acc[ai][bj][m][n] = __builtin_amdgcn_mfma_f32_16x16x32_bf16(Bt[n][k], At[m][k], acc[ai][bj][m][n], 0, 0, 0); __builtin_amdgcn_s_setprio(0); } while (0)
#define PG8_WAIT_V(n) asm volatile("s_waitcnt vmcnt(" #n ")" ::: "memory")
#define PG8_WAIT_L(n) asm volatile("s_waitcnt lgkmcnt(" #n ")" ::: "memory")
#define PG8_BAR __builtin_amdgcn_s_barrier()
#define PG8_SCHED __builtin_amdgcn_sched_barrier(0)
    Unit cur, nxt; int ui = 0;
    if (!S.next(0, cur)) return;
    f32x4 acc[2][2][4][2];
#pragma unroll
    for (int a = 0; a < 2; ++a)
#pragma unroll
        for (int b = 0; b < 2; ++b)
#pragma unroll
            for (int m = 0; m < 4; ++m)
#pragma unroll
                for (int n = 0; n < 2; ++n) acc[a][b][m][n] = (f32x4){0.f, 0.f, 0.f, 0.f};
    bf16x8 At[4][2], B0[2][2], B1[2][2];
    const char* cA = (const char*)g.A + (size_t)cur.pm * tstep; const char* cB = (const char*)g.Bt + (size_t)cur.pn * tstep;
    S.a_ready(cur);
    if constexpr (SP2) {
        PG8_STAGE(PG8_SB(0, 0), cB, voffB); PG8_STAGE(PG8_SB(0, 1), cB + hstep, voffB); PG8_STAGE(PG8_SA(0, 0), cA, voffA); PG8_STAGE(PG8_SA(0, 1), cA + hstep, voffA);
        if (wr == 1) PG8_BAR;
        PG8_WAIT_V(2); PG8_BAR;
        PG8_STAGE(PG8_SB(1, 0), cB + kstep, voffB); PG8_STAGE(PG8_SA(1, 0), cA + kstep, voffA); PG8_STAGE(PG8_SB(1, 1), cB + hstep + kstep, voffB);
        PG8_WAIT_V(6); PG8_BAR;
    } else {
        PG8_STAGE(PG8_SB(0, 0), cB, voffB); PG8_STAGE(PG8_SA(0, 0), cA, voffA); PG8_STAGE(PG8_SB(0, 1), cB + hstep, voffB); PG8_STAGE(PG8_SA(0, 1), cA + hstep, voffA);
        if (wr == 1) PG8_BAR;
        PG8_WAIT_V(4); PG8_BAR;
        PG8_STAGE(PG8_SB(1, 0), cB + kstep, voffB); PG8_STAGE(PG8_SA(1, 0), cA + kstep, voffA); PG8_STAGE(PG8_SB(1, 1), cB + hstep + kstep, voffB);
        PG8_WAIT_V(6); PG8_BAR;
    }
    for (;;) {
        const bool has_next = S.next(ui + 1, nxt);
        const char* nA = has_next ? (const char*)g.A + (size_t)nxt.pm * tstep : cA; const char* nB = has_next ? (const char*)g.Bt + (size_t)nxt.pn * tstep : cB;
        for (int t = 0; t < nt; t += 2) {
            const bool last = (t == nt - 2);
            const char* a1 = cA + (size_t)(t + 1) * kstep;
            const char* a2 = last ? nA : cA + (size_t)(t + 2) * kstep; const char* b2 = last ? nB : cB + (size_t)(t + 2) * kstep;
            const char* a3 = a2 + kstep; const char* b3 = b2 + kstep;
            if (last && has_next) S.a_ready(nxt);
            if constexpr (SP2) {
            PG8_LDB(B0, 0, 0); PG8_LDB(B1, 0, 1); PG8_SCHED; PG8_LDA(At, 0, 0); PG8_STAGE(PG8_SA(1, 1), a1 + hstep, voffA);
            PG8_WAIT_V(8); PG8_WAIT_L(0); PG8_BAR; PG8_MMA(0, 0, At, B0); PG8_MMA(0, 1, At, B1); PG8_BAR; PG8_SCHED;
            PG8_LDA(At, 0, 1); PG8_STAGE(PG8_SB(0, 0), b2, voffB); PG8_STAGE(PG8_SB(0, 1), b2 + hstep, voffB); PG8_STAGE(PG8_SA(0, 0), a2, voffA);
            PG8_WAIT_V(8); PG8_WAIT_L(0); PG8_BAR; PG8_MMA(1, 0, At, B0); PG8_MMA(1, 1, At, B1); PG8_BAR; PG8_SCHED;
            PG8_LDB(B0, 1, 0); PG8_LDB(B1, 1, 1); PG8_SCHED; PG8_LDA(At, 1, 0); PG8_STAGE(PG8_SA(0, 1), a2 + hstep, voffA);
            PG8_WAIT_V(8); PG8_WAIT_L(0); PG8_BAR; PG8_MMA(0, 0, At, B0); PG8_MMA(0, 1, At, B1); PG8_BAR; PG8_SCHED;
            PG8_LDA(At, 1, 1); PG8_STAGE(PG8_SB(1, 0), b3, voffB); PG8_STAGE(PG8_SB(1, 1), b3 + hstep, voffB); PG8_STAGE(PG8_SA(1, 0), a3, voffA);
            PG8_WAIT_V(8); PG8_WAIT_L(0); PG8_BAR; PG8_MMA(1, 0, At, B0); PG8_MMA(1, 1, At, B1); PG8_BAR; PG8_SCHED;
            } else {
            PG8_LDB(B0, 0, 0); PG8_SCHED; PG8_LDA(At, 0, 0); PG8_STAGE(PG8_SA(1, 1), a1 + hstep, voffA);
            PG8_WAIT_L(8); PG8_BAR; PG8_WAIT_L(0); PG8_MMA(0, 0, At, B0); PG8_BAR; PG8_SCHED;
            PG8_LDB(B1, 0, 1); PG8_STAGE(PG8_SB(0, 0), b2, voffB);
            PG8_BAR; PG8_WAIT_L(0); PG8_MMA(0, 1, At, B1); PG8_BAR;
            PG8_LDA(At, 0, 1); PG8_STAGE(PG8_SA(0, 0), a2, voffA);
            PG8_BAR; PG8_WAIT_L(0); PG8_MMA(1, 0, At, B0); PG8_BAR; PG8_SCHED;
            PG8_STAGE(PG8_SB(0, 1), b2 + hstep, voffB);
            PG8_WAIT_V(6); PG8_BAR; PG8_MMA(1, 1, At, B1); PG8_BAR;
            PG8_LDB(B0, 1, 0); PG8_SCHED; PG8_LDA(At, 1, 0); PG8_STAGE(PG8_SA(0, 1), a2 + hstep, voffA);
            PG8_WAIT_L(8); PG8_BAR; PG8_WAIT_L(0); PG8_MMA(0, 0, At, B0); PG8_BAR; PG8_SCHED;
            PG8_LDB(B1, 1, 1); PG8_STAGE(PG8_SB(1, 0), b3, voffB);
            PG8_BAR; PG8_WAIT_L(0); PG8_MMA(0, 1, At, B1); PG8_BAR;
            PG8_LDA(At, 1, 1); PG8_STAGE(PG8_SA(1, 0), a3, voffA);
            PG8_BAR; PG8_WAIT_L(0); PG8_MMA(1, 0, At, B0); PG8_BAR; PG8_SCHED;
            PG8_STAGE(PG8_SB(1, 1), b3 + hstep, voffB);
            PG8_WAIT_V(6); PG8_BAR; PG8_MMA(1, 1, At, B1); PG8_BAR;
            }
        }
        if constexpr (ALIGN_EPI) { if (wr == 0) PG8_BAR; }
        if constexpr (!Epi::AFTER_DRAIN) { E(acc, cur, wr, wc, fr, fq); S.done(cur); }
        if (!has_next) break;
#pragma unroll
        for (int a = 0; a < 2; ++a)
#pragma unroll
            for (int b = 0; b < 2; ++b)
#pragma unroll
                for (int m = 0; m < 4; ++m)
#pragma unroll
                    for (int n = 0; n < 2; ++n) acc[a][b][m][n] = (f32x4){0.f, 0.f, 0.f, 0.f};
        cur = nxt; cA = nA; cB = nB; ++ui;
        if constexpr (ALIGN_EPI) { if (wr == 1) PG8_BAR; }
    }
    PG8_WAIT_V(0);
    if constexpr (!ALIGN_EPI) { if (wr == 0) PG8_BAR; }
    PG8_BAR;
    if constexpr (Epi::AFTER_DRAIN) { E.fused(acc, cur, wr, wc, fr, fq, lds, wid, lane); S.done(cur); }
#undef PG8_SA
#undef PG8_SB
#undef PG8_STAGE
#undef PG8_LDA
#undef PG8_LDB
#undef PG8_MMA
#undef PG8_WAIT_V
#undef PG8_WAIT_L
#undef PG8_BAR
#undef PG8_SCHED
}
}
#define LAS __attribute__((address_space(3)))
typedef unsigned short bf16;
typedef short bf16x8 __attribute__((ext_vector_type(8)));
typedef float f32x4 __attribute__((ext_vector_type(4)));
typedef unsigned u32x4 __attribute__((ext_vector_type(4)));
typedef unsigned u32x2 __attribute__((ext_vector_type(2)));
constexpr int SEQ = 2048, DM = 1024, MROWS = 16384, FF = 4096, NINP = 3840, NINL = 3600, NTHR = 512, NWAVE = 8;
constexpr size_t MiB = 1u << 20;
constexpr size_t WS_SS = 0, WS_ROPE = 512 * 1024, WS_N = 1 * MiB, WS_MST = 2 * MiB, WS_G = 3 * MiB;
constexpr size_t WS_WIN = 4 * MiB, WS_WOUT = 19 * MiB, WS_WUP = 23 * MiB, WS_WDN = 39 * MiB;
constexpr size_t WS_XB = 56 * MiB;
constexpr size_t WS_SSP = 88 * MiB;
constexpr size_t WS_P1O = 93 * MiB, WS_P1ML = 109 * MiB;
constexpr size_t WS_U = 120 * MiB;
constexpr size_t WS_QKM = 120 * MiB, WS_KTM = 152 * MiB, WS_VTM = 168 * MiB, WS_AK = 184 * MiB, WS_VT16 = 200 * MiB, WS_Y = 216 * MiB, WS_END = 248 * MiB;
constexpr size_t WS_CTL = 2 * MiB + 256 * 1024, CTL_BYTES = 16384;
constexpr int LDS_BYTES = 147456, LDS_MISC = 131072 + 320;

struct Params {
    const float *x, *norm1_g, *w_in, *conv_w, *gate_i_b, *gate_f_b, *head_norm_g, *w_out, *norm2_g, *w_up, *w_down, *final_g;
    float* out; unsigned char* ws;
};

__device__ __forceinline__ unsigned pk2(float lo, float hi) { return pg8::cvt_pk_bf16(lo, hi); }
__device__ __forceinline__ float bflo(unsigned w) { return __uint_as_float(w << 16); }
__device__ __forceinline__ float bfhi(unsigned w) { return __uint_as_float(w & 0xffff0000u); }
__device__ __forceinline__ float wave_sum(float v) {
#pragma unroll
    for (int o = 1; o < 64; o <<= 1) v += __shfl_xor(v, o);
    return v;
}
__device__ __forceinline__ float wave_max(float v) {
#pragma unroll
    for (int o = 1; o < 64; o <<= 1) v = fmaxf(v, __shfl_xor(v, o));
    return v;
}
__device__ __forceinline__ float wave_incl_scan(float v, int lane) {
#pragma unroll
    for (int o = 1; o < 64; o <<= 1) { const float t = __shfl_up(v, o); if (lane >= o) v += t; }
    return v;
}

#define DPP_STEP_ADD(v, ctrl, rm) do { const int t_ = __builtin_amdgcn_update_dpp(0, __float_as_int(v), (ctrl), (rm), 0xf, false); v += __int_as_float(t_); } while (0)
#define DPP_STEP_MAX(v, ctrl, rm) do { const int t_ = __builtin_amdgcn_update_dpp((int)0xff800000, __float_as_int(v), (ctrl), (rm), 0xf, false); v = fmaxf(v, __int_as_float(t_)); } while (0)
__device__ __forceinline__ float wave_incl_scan_dpp(float v) {
    DPP_STEP_ADD(v, 0x111, 0xf); DPP_STEP_ADD(v, 0x112, 0xf); DPP_STEP_ADD(v, 0x114, 0xf); DPP_STEP_ADD(v, 0x118, 0xf); DPP_STEP_ADD(v, 0x142, 0xa); DPP_STEP_ADD(v, 0x143, 0xc);
    return v;
}
__device__ __forceinline__ float wave_incl_max_dpp(float v) {
    DPP_STEP_MAX(v, 0x111, 0xf); DPP_STEP_MAX(v, 0x112, 0xf); DPP_STEP_MAX(v, 0x114, 0xf); DPP_STEP_MAX(v, 0x118, 0xf); DPP_STEP_MAX(v, 0x142, 0xa); DPP_STEP_MAX(v, 0x143, 0xc);
    return v;
}
__device__ __forceinline__ float wave_max_dpp(float v) {
    DPP_STEP_MAX(v, 0x111, 0xf); DPP_STEP_MAX(v, 0x112, 0xf); DPP_STEP_MAX(v, 0x114, 0xf); DPP_STEP_MAX(v, 0x118, 0xf); DPP_STEP_MAX(v, 0x142, 0xa); DPP_STEP_MAX(v, 0x143, 0xc);
    return __int_as_float(__builtin_amdgcn_readlane(__float_as_int(v), 63));
}
#define MFMA16(a, b, c) __builtin_amdgcn_mfma_f32_16x16x32_bf16((a), (b), (c), 0, 0, 0)

__device__ __forceinline__ int win_src_col(int nb, int& nvalid) {
    nvalid = 32;
    if (nb < 2048) return nb;
    if (nb < 3072) { int xx = nb - 2048; const int isk = xx >> 9; xx &= 511; const int T = xx >> 8, bj = (xx >> 7) & 1, hl = (xx >> 5) & 3; return 2064 + isk * 512 + 64 * (4 * T + hl) + 32 * bj; }
    if (nb < 3584) return 3088 + (nb - 3072);
    if (nb == 3584) { nvalid = 16; return 2048; }
    nvalid = 0; return 0;
}
__device__ __forceinline__ void transpose_item(const float* W, int K, int Nsrc, int src_col, int nvalid, const float* g, bf16* WT, int dst_row, int k0, LAS float* scr, int lane) {
    const int c = lane & 31;
    float wv[32];
#pragma unroll
    for (int i = 0; i < 32; ++i) { const int kk = 2 * i + (lane >> 5); wv[i] = (c < nvalid) ? W[(size_t)(k0 + kk) * Nsrc + src_col + c] : 0.f; }
    if (g) {
#pragma unroll
        for (int i = 0; i < 32; ++i) wv[i] *= g[k0 + 2 * i + (lane >> 5)]; }
#pragma unroll
    for (int i = 0; i < 32; ++i) scr[(2 * i + (lane >> 5)) * 33 + c] = wv[i];
    asm volatile("s_waitcnt lgkmcnt(0)" ::: "memory");
    const int ch = lane & 7;
#pragma unroll
    for (int j = 0; j < 4; ++j) { const int n = (lane >> 3) + 8 * j; const LAS float* s = scr + (8 * ch) * 33 + n;
        u32x4 o; o.x = pk2(s[0 * 33], s[1 * 33]); o.y = pk2(s[2 * 33], s[3 * 33]); o.z = pk2(s[4 * 33], s[5 * 33]); o.w = pk2(s[6 * 33], s[7 * 33]);
        *(u32x4*)(WT + (size_t)(dst_row + n) * K + k0 + 8 * ch) = o; }
    asm volatile("s_waitcnt lgkmcnt(0)" ::: "memory");
}
constexpr int I_IN = 16 * (NINP / 32), I_OUT = 16 * 32, I_UP = 16 * 128, I_DN = 64 * 32, I_L = I_IN + I_OUT + I_UP + I_DN;
__device__ __forceinline__ void convert_item(const Params& p, int it, LAS float* scr, int lane) {
    const int l = it / I_L; int r = it % I_L;
    if (r < I_IN) { const int nblk = NINP / 32, kb = r / nblk, nb = (r % nblk) * 32; int nv; const int sc = win_src_col(nb, nv);
        transpose_item(p.w_in + (size_t)l * DM * NINL, DM, NINL, sc, nv, p.norm1_g + l * DM, (bf16*)(p.ws + WS_WIN) + (size_t)l * NINP * DM, nb, kb * 64, scr, lane); return; }
    r -= I_IN;
    if (r < I_OUT) { const int kb = r / 32, nb = (r % 32) * 32;
        transpose_item(p.w_out + (size_t)l * DM * DM, DM, DM, nb, 32, nullptr, (bf16*)(p.ws + WS_WOUT) + (size_t)l * DM * DM, nb, kb * 64, scr, lane); return; }
    r -= I_OUT;
    if (r < I_UP) { const int kb = r / 128, nb = (r % 128) * 32;
        transpose_item(p.w_up + (size_t)l * DM * FF, DM, FF, nb, 32, p.norm2_g + l * DM, (bf16*)(p.ws + WS_WUP) + (size_t)l * FF * DM, nb, kb * 64, scr, lane); return; }
    r -= I_UP;
    { const int kb = r / 32, nb = (r % 32) * 32;
        transpose_item(p.w_down + (size_t)l * FF * DM, FF, DM, nb, 32, nullptr, (bf16*)(p.ws + WS_WDN) + (size_t)l * DM * FF, nb, kb * 64, scr, lane); }
}
__device__ __forceinline__ void p0_prologue(const Params& p, LAS unsigned char* lds, int wave, int lane, int G, int n_items) {
    LAS float* scr = (LAS float*)(lds + wave * 16384);
    const int gw = blockIdx.x * NWAVE + wave, NGW = G * NWAVE;
    if (n_items < 0) { constexpr int I_A = I_IN + I_OUT;
        for (int j = gw; j < 2 * I_A; j += NGW) convert_item(p, (j / I_A) * I_L + (j % I_A), scr, lane); }
    else for (int it = gw; it < n_items; it += NGW) convert_item(p, it, scr, lane);
    float* ss = (float*)(p.ws + WS_SSP); bf16* xb = (bf16*)(p.ws + WS_XB);
    for (int m0 = gw; m0 < MROWS; m0 += 2 * NGW) {
        f32x4 v[2][4];
#pragma unroll
        for (int q = 0; q < 2; ++q) { const int m = (m0 + q * NGW < MROWS) ? m0 + q * NGW : m0; const f32x4* xr = (const f32x4*)(p.x + (size_t)m * DM) + lane;
#pragma unroll
            for (int j = 0; j < 4; ++j) v[q][j] = xr[64 * j]; }
#pragma unroll
        for (int q = 0; q < 2; ++q) { const int m = m0 + q * NGW; if (m < MROWS) { float s = 0.f; u32x2* o8 = (u32x2*)(xb + (size_t)m * DM) + lane;
#pragma unroll
            for (int j = 0; j < 4; ++j) { const f32x4 t = v[q][j]; s += (t[0] * t[0] + t[1] * t[1]) + (t[2] * t[2] + t[3] * t[3]); u32x2 w; w.x = pk2(t[0], t[1]); w.y = pk2(t[2], t[3]); o8[64 * j] = w; }
            s = wave_sum(s); if (lane < 16) ss[(size_t)m * 16 + lane] = (lane == 0) ? s : 0.f; } }
    }
    const int gt = blockIdx.x * NTHR + threadIdx.x, NGT = G * NTHR;
    float* rc = (float*)(p.ws + WS_ROPE); float* rsn = rc + SEQ * 32;
    for (int i = gt; i < SEQ * 32; i += NGT) { const int pos = i >> 5, fi = i & 31;
        const float inv = exp2f(-(float)fi * (13.287712379549449f / 32.0f)); const float ang = (float)pos * inv;
        const float n = rintf(ang * 0.15915494309189535f); float rr = fmaf(-n, 6.2831854820251465f, ang); rr = fmaf(-n, -1.7484555e-7f, rr);
        rc[i] = __cosf(rr); rsn[i] = __sinf(rr); }
}

struct ScanLd { u32x4 kc[2]; unsigned kb[2], ka[2]; float li, lf; };
__device__ __forceinline__ void scan_load(ScanLd& L, const bf16* Krow, const bf16* Vrow, const float* Gp, int tok0, int fq, int lane, int gcol) {
    L.li = Gp[(size_t)(tok0 + lane) * 16 + gcol]; L.lf = Gp[(size_t)(tok0 + lane) * 16 + 8 + gcol];
#pragma unroll
    for (int ks = 0; ks < 2; ++ks) { const int base = tok0 + 32 * ks + 8 * fq;
        L.kc[ks] = *(const u32x4*)(Krow + base);
        L.kb[ks] = (base >= 2) ? *(const unsigned*)(Krow + base - 2) : 0u;
        L.ka[ks] = (base + 8 < SEQ) ? *(const unsigned*)(Krow + base + 8) : 0u; }
}
__device__ __forceinline__ void scan_wave(const Params& p, int layer, int sw, LAS float* wl, int lane, bool bar_mid) {
    const int ksl = sw & 7, dir = (sw >> 3) & 1, hh = (sw >> 4) & 3, b = sw >> 6;
    const int fr = lane & 15, fq = lane >> 4, kdim = 16 * ksl + fr;
    const float* cw = p.conv_w + (size_t)layer * 5 * 1024 + 512 + hh * 128 + kdim;
    float cwt[5];
#pragma unroll
    for (int t = 0; t < 5; ++t) cwt[t] = cw[t * 1024];
    const bf16* Krow = (const bf16*)(p.ws + WS_KTM) + ((size_t)((b * 4 + hh) * 128 + kdim)) * SEQ;
    const bf16* Vrow = (const bf16*)(p.ws + WS_VTM) + ((size_t)((b * 4 + hh) * 128 + fr)) * SEQ;
    const float* Gp = (const float*)(p.ws + WS_G) + (size_t)b * SEQ * 16;
    const int gcol = dir * 4 + hh;
    bf16* Ct = (bf16*)p.out; float* Nst = (float*)(p.ws + WS_N); float* Mst = (float*)(p.ws + WS_MST);
    const f32x4 z4 = {0.f, 0.f, 0.f, 0.f};
    f32x4 C[8], CN = z4; float mrun = -1e30f;
#pragma unroll
    for (int nt = 0; nt < 8; ++nt) C[nt] = z4;
    const bf16x8 ones = {0x3F80, 0x3F80, 0x3F80, 0x3F80, 0x3F80, 0x3F80, 0x3F80, 0x3F80};
    ScanLd cur, nxt;
    scan_load(cur, Krow, Vrow, Gp, (dir ? 31 : 0) * 64, fq, lane, gcol);
    for (int cs = 0; cs < 32; ++cs) {
        if (bar_mid && cs == 14) __syncthreads();
        const int pc = dir ? 31 - cs : cs;
        bf16x8 vv[8][2];
#pragma unroll
        for (int ks = 0; ks < 2; ++ks)
#pragma unroll
            for (int nt = 0; nt < 8; ++nt) vv[nt][ks] = *(const bf16x8*)(Vrow + (size_t)nt * 16 * SEQ + pc * 64 + 32 * ks + 8 * fq);
        if (cs + 1 < 32) scan_load(nxt, Krow, Vrow, Gp, (dir ? 30 - cs : cs + 1) * 64, fq, lane, gcol); else nxt = cur;
        const float pre = wave_incl_scan_dpp(cur.lf); const float total = __int_as_float(__builtin_amdgcn_readlane(__float_as_int(pre), 63));
        const float g = dir ? (pre - cur.lf + cur.li) : (total - pre + cur.li);
        const float gmax = wave_max_dpp(g);
        const float mn = fmaxf(total + mrun, gmax); const float decay = __expf(total + mrun - mn); const float w = __expf(g - mn);
        const size_t sidx = (size_t)((b * 4 + hh) * 2 + dir) * 32 + pc;
        { bf16* Cd = Ct + sidx * 16384 + (size_t)fr * 128 + 16 * ksl + 4 * fq;
#pragma unroll
          for (int nt = 0; nt < 8; ++nt) { u32x2 w0; w0.x = pk2(C[nt][0], C[nt][1]); w0.y = pk2(C[nt][2], C[nt][3]); *(u32x2*)(Cd + nt * 16 * 128) = w0; }
          if (fr == 0) *(f32x4*)(Nst + sidx * 128 + 16 * ksl + 4 * fq) = CN;
          if (ksl == 0 && lane == 0) Mst[sidx] = mrun; }
        wl[lane] = w;
        asm volatile("s_waitcnt lgkmcnt(0)" ::: "memory");
        bf16x8 afr[2];
#pragma unroll
        for (int ks = 0; ks < 2; ++ks) {
            const f32x4 wa = *(const LAS f32x4*)(wl + 32 * ks + 8 * fq), wb = *(const LAS f32x4*)(wl + 32 * ks + 8 * fq + 4);
            float r[12]; r[0] = bflo(cur.kb[ks]); r[1] = bfhi(cur.kb[ks]);
#pragma unroll
            for (int q = 0; q < 4; ++q) { r[2 + 2 * q] = bflo(cur.kc[ks][q]); r[3 + 2 * q] = bfhi(cur.kc[ks][q]); }
            r[10] = bflo(cur.ka[ks]); r[11] = bfhi(cur.ka[ks]);
            float o[8];
#pragma unroll
            for (int j = 0; j < 8; ++j) { float a = 0.f;
#pragma unroll
                for (int t = 0; t < 5; ++t) a = fmaf(cwt[t], r[j + t], a);
                a = a * __builtin_amdgcn_rcpf(1.0f + __expf(-a)); o[j] = a * 0.08838834764831845f * (j < 4 ? wa[j] : wb[j - 4]); }
            u32x4 pw; pw.x = pk2(o[0], o[1]); pw.y = pk2(o[2], o[3]); pw.z = pk2(o[4], o[5]); pw.w = pk2(o[6], o[7]);
            afr[ks] = __builtin_bit_cast(bf16x8, pw);
        }
        asm volatile("" ::: "memory");
        CN = CN * decay;
#pragma unroll
        for (int nt = 0; nt < 8; ++nt) { C[nt] = C[nt] * decay; C[nt] = MFMA16(afr[0], vv[nt][0], C[nt]); C[nt] = MFMA16(afr[1], vv[nt][1], C[nt]); }
        CN = MFMA16(afr[0], ones, CN); CN = MFMA16(afr[1], ones, CN);
        mrun = mn; cur = nxt;
    }
}

__device__ __forceinline__ void tile_par(int T, int f, int r, int L0, int& R, int& Lb, int& dsh) {
    if (T < 10) { dsh = 4; R = r; Lb = L0 - 64 + 16 * T + 4 * f; }
    else if (T < 22) { dsh = 2; R = 4 * f + (r & 3); Lb = L0 - 16 + 4 * (T - 10); }
    else { const int xx = T - 22; dsh = 0; R = 4 * (xx & 3) + f; Lb = L0 - 4 + 4 * (xx >> 2); }
}
template <int LIM> __device__ __forceinline__ void attn_step(f32x4 (&O)[4], float& mrun, float& lsum, const bf16x8 (&qf)[2], const bf16x8 k00, const bf16x8 k01, const bf16x8 k10, const bf16x8 k11,
                                                             const u32x2 (&v0)[4], const u32x2 (&v1)[4], int D0, int D1, bool ok0, bool ok1) {
    const f32x4 z4 = {0.f, 0.f, 0.f, 0.f};
    f32x4 s0 = MFMA16(k00, qf[0], z4); s0 = MFMA16(k01, qf[1], s0);
    f32x4 s1 = MFMA16(k10, qf[0], z4); s1 = MFMA16(k11, qf[1], s1);
    bool va[4], vb[4];
#pragma unroll
    for (int j = 0; j < 4; ++j) { va[j] = ok0 && ((unsigned)(D0 + 16 * j) <= (unsigned)(2 * LIM)); vb[j] = ok1 && ((unsigned)(D1 + 16 * j) <= (unsigned)(2 * LIM));
        s0[j] = va[j] ? s0[j] : -1e30f; s1[j] = vb[j] ? s1[j] : -1e30f; }
    float tm = fmaxf(fmaxf(fmaxf(s0[0], s0[1]), fmaxf(s0[2], s0[3])), fmaxf(fmaxf(s1[0], s1[1]), fmaxf(s1[2], s1[3])));
    tm = fmaxf(tm, __shfl_xor(tm, 16)); tm = fmaxf(tm, __shfl_xor(tm, 32));
    const float mn = fmaxf(mrun, tm);
    if (__any(mn > mrun)) { const float sc = __builtin_amdgcn_exp2f(mrun - mn); lsum *= sc;
#pragma unroll
        for (int d = 0; d < 4; ++d) O[d] = O[d] * sc; }
    mrun = mn;
    float pv[8]; float ps = 0.f;
#pragma unroll
    for (int j = 0; j < 4; ++j) { pv[j] = va[j] ? __builtin_amdgcn_exp2f(s0[j] - mn) : 0.f; pv[4 + j] = vb[j] ? __builtin_amdgcn_exp2f(s1[j] - mn) : 0.f; ps += pv[j] + pv[4 + j]; }
    lsum += ps;
    u32x4 pw; pw.x = pk2(pv[0], pv[1]); pw.y = pk2(pv[2], pv[3]); pw.z = pk2(pv[4], pv[5]); pw.w = pk2(pv[6], pv[7]);
    const bf16x8 pb = __builtin_bit_cast(bf16x8, pw);
#pragma unroll
    for (int d = 0; d < 4; ++d) { u32x4 vw; vw.x = v0[d].x; vw.y = v0[d].y; vw.z = v1[d].x; vw.w = v1[d].y; O[d] = MFMA16(__builtin_bit_cast(bf16x8, vw), pb, O[d]); }
}
#define KLD(ptr, lo, hi) do { lo = *(const bf16x8*)(ptr); hi = *(const bf16x8*)((ptr) + 32); } while (0)
#define VLD(ptr, v) do { _Pragma("unroll") for (int d_ = 0; d_ < 4; ++d_) v[d_] = *(const u32x2*)((ptr) + d_ * 64); } while (0)
__device__ __forceinline__ void attn_pair(const Params& p, int b, int h, int p0, int r0, int lane) {
    const int fr = lane & 15, fq = lane >> 4, fK = fr >> 2, jK = fr & 3; const int L0 = p0 >> 4;
    const f32x4 z4 = {0.f, 0.f, 0.f, 0.f};
    bf16* Yrow[2]; bf16x8 qf[2][2]; f32x4 O[2][4]; float mrun[2], lsum[2];
    const bf16* Kb = (const bf16*)(p.ws + WS_AK) + (ptrdiff_t)b * SEQ * 512 + h * 64 + 8 * fq;
    const bf16* Vb = (const bf16*)(p.ws + WS_VT16) + (ptrdiff_t)(b * 8 + h) * 131072 + fr * 4;
#pragma unroll
    for (int u = 0; u < 2; ++u) { const int pq = p0 + 16 * fr + r0 + 4 * u; Yrow[u] = (bf16*)(p.ws + WS_Y) + ((size_t)(b * SEQ + pq)) * 1024 + 512 + h * 64;
        qf[u][0] = *(const bf16x8*)(Yrow[u] + 8 * fq); qf[u][1] = *(const bf16x8*)(Yrow[u] + 32 + 8 * fq); mrun[u] = -1e30f; lsum[u] = 0.f;
#pragma unroll
        for (int d = 0; d < 4; ++d) O[u][d] = z4; }
    {
        const bf16* kp = Kb + (ptrdiff_t)(16 * (L0 - 64 + 4 * fK + jK) + r0) * 512;
        const bf16* vp = Vb + (ptrdiff_t)(r0 * 32 + (L0 >> 2) - 16 + fq) * 256;
        for (int pp = 0; pp < 5; ++pp) { const int T0 = 2 * pp; const int lq = L0 - 64 + 16 * T0;
            if (lq + 31 < 0 || lq >= 128) continue;
            const int D0 = 16 * (-64 + 16 * T0 + 4 * fq - fr) + 1024; const bool ok0 = (unsigned)(lq + 4 * fq) < 128u, ok1 = (unsigned)(lq + 16 + 4 * fq) < 128u;
            const bf16* k0p = kp + (ptrdiff_t)T0 * 256 * 512; const bf16* v0p = vp + (ptrdiff_t)T0 * 4 * 256;
#pragma unroll
            for (int u = 0; u < 2; ++u) { bf16x8 k00, k01, k10, k11; u32x2 v0[4], v1[4];
                KLD(k0p + u * 4 * 512, k00, k01); VLD(v0p + u * 4 * 32 * 256, v0);
                if (pp < 4) { KLD(k0p + u * 4 * 512 + 256 * 512, k10, k11); VLD(v0p + u * 4 * 32 * 256 + 4 * 256, v1); }
                else { k10 = k00; k11 = k01;
#pragma unroll
                    for (int d_ = 0; d_ < 4; ++d_) v1[d_] = v0[d_]; }
                attn_step<1024>(O[u], mrun[u], lsum[u], qf[u], k00, k01, k10, k11, v0, v1, D0, D0 + 256, ok0, ok1 && (pp < 4)); }
        }
    }
    {
        const bf16* kp = Kb + (ptrdiff_t)(16 * (L0 - 16 + jK) + 4 * fK + (r0 & 3)) * 512;
        const bf16* vp = Vb + (ptrdiff_t)((4 * fq + (r0 & 3)) * 32 + (L0 >> 2) - 4) * 256;
        for (int pp = 0; pp < 6; ++pp) { const int T0 = 2 * pp; const int lb = L0 - 16 + 4 * T0;
            const bool ok0 = (unsigned)lb < 128u, ok1 = (unsigned)(lb + 4) < 128u; if (!ok0 && !ok1) continue;
            const int D0 = 16 * (-16 + 4 * T0 - fr) + 4 * fq - (r0 & ~3) + 256;
            const bf16* k0p = kp + (ptrdiff_t)T0 * 64 * 512; const bf16* v0p = vp + (ptrdiff_t)T0 * 256;
            { bf16x8 k00, k01, k10, k11; u32x2 v0[4], v1[4];
                KLD(k0p, k00, k01); KLD(k0p + 64 * 512, k10, k11); VLD(v0p, v0); VLD(v0p + 256, v1);
                attn_step<256>(O[0], mrun[0], lsum[0], qf[0], k00, k01, k10, k11, v0, v1, D0, D0 + 64, ok0, ok1);
                attn_step<256>(O[1], mrun[1], lsum[1], qf[1], k00, k01, k10, k11, v0, v1, D0 - 4, D0 + 60, ok0, ok1); }
        }
    }
#pragma unroll
    for (int u = 0; u < 2; ++u) { float l2 = lsum[u]; l2 += __shfl_xor(l2, 16); l2 += __shfl_xor(l2, 32); const int pq = p0 + 16 * fr + r0 + 4 * u; const size_t qrow = (size_t)(b * SEQ + pq);
        const float* ml = (const float*)(p.ws + WS_P1ML) + (qrow * 8 + h) * 2; const float m1 = ml[0], l1 = ml[1];
        const float m = fmaxf(mrun[u], m1); const float a2 = __builtin_amdgcn_exp2f(mrun[u] - m), a1 = __builtin_amdgcn_exp2f(m1 - m) * l1; const float rden = 1.0f / (l2 * a2 + a1);
        const bf16* o1p = (const bf16*)(p.ws + WS_P1O) + qrow * 512 + h * 64 + 4 * fq;
#pragma unroll
        for (int d = 0; d < 4; ++d) { const u32x2 ow = *(const u32x2*)(o1p + 16 * d); u32x2 w;
            w.x = pk2((O[u][d][0] * a2 + bflo(ow.x) * a1) * rden, (O[u][d][1] * a2 + bfhi(ow.x) * a1) * rden); w.y = pk2((O[u][d][2] * a2 + bflo(ow.y) * a1) * rden, (O[u][d][3] * a2 + bfhi(ow.y) * a1) * rden);
            *(u32x2*)(Yrow[u] + 16 * d + 4 * fq) = w; } }
}
__device__ __forceinline__ void attn_quad_d1(const Params& p, int b, int h, int L, int lane) {
    const int fr = lane & 15, fq = lane >> 4, fK = fr >> 2, jK = fr & 3;
    const f32x4 z4 = {0.f, 0.f, 0.f, 0.f};
    bf16x8 qf[4][2]; f32x4 O[4][4]; float mrun[4], lsum[4];
    const bf16* Kb = (const bf16*)(p.ws + WS_AK) + (ptrdiff_t)b * SEQ * 512 + h * 64 + 8 * fq;
    const bf16* Vb = (const bf16*)(p.ws + WS_VT16) + (ptrdiff_t)(b * 8 + h) * 131072 + fr * 4;
#pragma unroll
    for (int i = 0; i < 4; ++i) { const bf16* qrow = (const bf16*)(p.ws + WS_Y) + ((size_t)(b * SEQ + 16 * (L + i) + fr)) * 1024 + 512 + h * 64;
        qf[i][0] = *(const bf16x8*)(qrow + 8 * fq); qf[i][1] = *(const bf16x8*)(qrow + 32 + 8 * fq); mrun[i] = -1e30f; lsum[i] = 0.f;
#pragma unroll
        for (int d = 0; d < 4; ++d) O[i][d] = z4; }
    const bf16* kp = Kb + (ptrdiff_t)(16 * (L - 4 + jK) + fK) * 512;
    const bf16* vp = Vb + (ptrdiff_t)(fq * 32 + (L >> 2) - 1) * 256;
    for (int kb = 0; kb < 3; ++kb) { const int lb = L - 4 + 4 * kb; if ((unsigned)lb >= 128u) continue;
#pragma unroll
        for (int th = 0; th < 2; ++th) { const int t0 = 2 * th;
            const int D0 = 16 * (-4 + 4 * kb) + 4 * t0 + fq - fr + 64;
            const bf16* k0p = kp + (ptrdiff_t)(64 * kb + 4 * t0) * 512; const bf16* v0p = vp + (ptrdiff_t)(128 * t0 + kb) * 256;
            bf16x8 k00, k01, k10, k11; u32x2 v0[4], v1[4];
            KLD(k0p, k00, k01); KLD(k0p + 4 * 512, k10, k11); VLD(v0p, v0); VLD(v0p + 128 * 256, v1);
#pragma unroll
            for (int i = 0; i < 4; ++i) { attn_step<64>(O[i], mrun[i], lsum[i], qf[i], k00, k01, k10, k11, v0, v1, D0 - 16 * i, D0 - 16 * i + 4, true, true); if (i & 1) __builtin_amdgcn_sched_barrier(0); } }
    }
#pragma unroll
    for (int i = 0; i < 4; ++i) { float l = lsum[i]; l += __shfl_xor(l, 16); l += __shfl_xor(l, 32); const float rl = 1.0f / l; const size_t qrow = (size_t)(b * SEQ + 16 * (L + i) + fr);
        bf16* o1p = (bf16*)(p.ws + WS_P1O) + qrow * 512 + h * 64 + 4 * fq;
#pragma unroll
        for (int d = 0; d < 4; ++d) { u32x2 w; w.x = pk2(O[i][d][0] * rl, O[i][d][1] * rl); w.y = pk2(O[i][d][2] * rl, O[i][d][3] * rl); *(u32x2*)(o1p + 16 * d) = w; }
        if (fq == 0) { float* ml = (float*)(p.ws + WS_P1ML) + (qrow * 8 + h) * 2; ml[0] = mrun[i]; ml[1] = l; } }
}
constexpr int QS_OFF = 0, KS_OFF = 17408, PF_OFF = 34816, PB_OFF = 44032, FL_OFF = 53248, QPITCH = 272, PPITCH = 144;
__device__ __forceinline__ void mout_unit(const Params& p, int layer, int u, LAS unsigned char* lds, int tid, int wave, int lane) {
    const int b = u >> 7, hh = (u >> 5) & 3, pc = u & 31, tok0 = pc * 64;
    const int fr = lane & 15, fq = lane >> 4;
    LAS float* FL = (LAS float*)(lds + FL_OFF);
    const float* Gp = (const float*)(p.ws + WS_G) + (size_t)(b * SEQ + tok0) * 16;
    const float* Mst = (const float*)(p.ws + WS_MST); const float* Nst = (const float*)(p.ws + WS_N);
    const bf16* Ct = (const bf16*)p.out;
    const size_t sid0 = (size_t)((b * 4 + hh) * 2 + 0) * 32 + pc, sid1 = (size_t)((b * 4 + hh) * 2 + 1) * 32 + pc;
    bf16x8 vaf[2], caf[2][4];
    { const bf16* Vr = (const bf16*)(p.ws + WS_VTM) + ((size_t)((b * 4 + hh) * 128 + 16 * wave + fr)) * SEQ + tok0;
#pragma unroll
      for (int ks = 0; ks < 2; ++ks) vaf[ks] = *(const bf16x8*)(Vr + 32 * ks + 8 * fq);
#pragma unroll
      for (int d = 0; d < 2; ++d) { const bf16* Cr = Ct + (d ? sid1 : sid0) * 16384 + (size_t)(16 * wave + fr) * 128;
#pragma unroll
          for (int kk = 0; kk < 4; ++kk) caf[d][kk] = *(const bf16x8*)(Cr + 32 * kk + 8 * fq); } }
    if (wave < 2) {
        const int dir = wave; const float li = Gp[lane * 16 + dir * 4 + hh], lf = Gp[lane * 16 + 8 + dir * 4 + hh];
        const float pre = wave_incl_scan_dpp(lf); const float total = __int_as_float(__builtin_amdgcn_readlane(__float_as_int(pre), 63));
        const float bt = dir ? (total - pre + lf) : pre; const float uu = li - bt;
        float pm;
        if (dir == 0) pm = wave_incl_max_dpp(uu); else pm = __shfl(wave_incl_max_dpp(__shfl(uu, 63 - lane)), 63 - lane);
        const float mprev = Mst[dir ? sid1 : sid0]; const float a = bt + mprev; const float mt = fmaxf(a, bt + pm);
        FL[(0 + 2 * dir) * 64 + lane] = bt - mt; FL[(1 + 2 * dir) * 64 + lane] = uu; FL[(4 + dir) * 64 + lane] = __expf(a - mt); FL[(6 + dir) * 64 + lane] = __expf(-mt);
    }
    {
        const bf16* QKm = (const bf16*)(p.ws + WS_QKM); const float* cwl = p.conv_w + (size_t)layer * 5 * 1024;
#pragma unroll
        for (int it4 = 0; it4 < 4; ++it4) { const int it = tid + it4 * NTHR; const int mat = it >> 10, rem = it & 1023, tok = rem >> 4, dg = rem & 15; const int col = mat * 512 + hh * 128 + 8 * dg;
            float a8[8];
#pragma unroll
            for (int j = 0; j < 8; ++j) a8[j] = 0.f;
#pragma unroll
            for (int t = 0; t < 5; ++t) { const int tt = tok0 + tok + t - 2;
                if (tt >= 0 && tt < SEQ) { const u32x4 xx = *(const u32x4*)(QKm + (size_t)(b * SEQ + tt) * 1024 + col);
                    const f32x4 w0 = *(const f32x4*)(cwl + t * 1024 + col), w1 = *(const f32x4*)(cwl + t * 1024 + col + 4);
                    a8[0] = fmaf(w0[0], bflo(xx.x), a8[0]); a8[1] = fmaf(w0[1], bfhi(xx.x), a8[1]); a8[2] = fmaf(w0[2], bflo(xx.y), a8[2]); a8[3] = fmaf(w0[3], bfhi(xx.y), a8[3]);
                    a8[4] = fmaf(w1[0], bflo(xx.z), a8[4]); a8[5] = fmaf(w1[1], bfhi(xx.z), a8[5]); a8[6] = fmaf(w1[2], bflo(xx.w), a8[6]); a8[7] = fmaf(w1[3], bfhi(xx.w), a8[7]); } }
            const float sc = mat ? 0.08838834764831845f : 1.0f;
#pragma unroll
            for (int j = 0; j < 8; ++j) a8[j] = a8[j] * __builtin_amdgcn_rcpf(1.0f + __expf(-a8[j])) * sc;
            u32x4 w; w.x = pk2(a8[0], a8[1]); w.y = pk2(a8[2], a8[3]); w.z = pk2(a8[4], a8[5]); w.w = pk2(a8[6], a8[7]);
            *(LAS u32x4*)(lds + (mat ? KS_OFF : QS_OFF) + tok * QPITCH + dg * 16) = w; }
    }
    __syncthreads();
    if (wave < 2) {
        const float* np = Nst + (wave ? sid1 : sid0) * 128; float acc = 0.f;
#pragma unroll
        for (int dg = 0; dg < 16; ++dg) { const u32x4 xx = *(const LAS u32x4*)(lds + QS_OFF + lane * QPITCH + dg * 16); const f32x4 n0 = *(const f32x4*)(np + 8 * dg), n1 = *(const f32x4*)(np + 8 * dg + 4);
            acc += bflo(xx.x) * n0[0] + bfhi(xx.x) * n0[1] + bflo(xx.y) * n0[2] + bfhi(xx.y) * n0[3] + bflo(xx.z) * n1[0] + bfhi(xx.z) * n1[1] + bflo(xx.w) * n1[2] + bfhi(xx.w) * n1[3]; }
        FL[(16 + wave) * 64 + lane] = acc;
    }
    {
        const int st = wave >> 1, tt0 = 2 * (wave & 1); const f32x4 z4 = {0.f, 0.f, 0.f, 0.f};
        bf16x8 ka[4];
#pragma unroll
        for (int ks = 0; ks < 4; ++ks) ka[ks] = *(const LAS bf16x8*)(lds + KS_OFF + (16 * st + fr) * QPITCH + (32 * ks + 8 * fq) * 2);
#pragma unroll
        for (int q = 0; q < 2; ++q) { const int t = 16 * (tt0 + q) + fr; f32x4 s = z4;
#pragma unroll
            for (int ks = 0; ks < 4; ++ks) { const bf16x8 qb = *(const LAS bf16x8*)(lds + QS_OFF + t * QPITCH + (32 * ks + 8 * fq) * 2); s = MFMA16(ka[ks], qb, s); }
            const float cf = FL[0 * 64 + t], cb = FL[2 * 64 + t]; float pf[4], pb[4]; float rf = 0.f, rb = 0.f;
#pragma unroll
            for (int j = 0; j < 4; ++j) { const int si = 16 * st + 4 * fq + j; const float uf = FL[1 * 64 + si], ub = FL[3 * 64 + si];
                pf[j] = (si <= t) ? s[j] * __expf(cf + uf) : 0.f; pb[j] = (si >= t) ? s[j] * __expf(cb + ub) : 0.f; rf += pf[j]; rb += pb[j]; }
            u32x2 w; w.x = pk2(pf[0], pf[1]); w.y = pk2(pf[2], pf[3]); *(LAS u32x2*)(lds + PF_OFF + t * PPITCH + (16 * st + 4 * fq) * 2) = w;
            w.x = pk2(pb[0], pb[1]); w.y = pk2(pb[2], pb[3]); *(LAS u32x2*)(lds + PB_OFF + t * PPITCH + (16 * st + 4 * fq) * 2) = w;
            rf += __shfl_xor(rf, 16); rf += __shfl_xor(rf, 32); rb += __shfl_xor(rb, 16); rb += __shfl_xor(rb, 32);
            if (fq == 0) { FL[(8 + st) * 64 + t] = rf; FL[(12 + st) * 64 + t] = rb; } }
    }
    __syncthreads();
    f32x4 aI[2][4], aX[2][4];
    {
        const f32x4 z4 = {0.f, 0.f, 0.f, 0.f};
#pragma unroll
        for (int d = 0; d < 2; ++d)
#pragma unroll
            for (int tt = 0; tt < 4; ++tt) { aI[d][tt] = z4; aX[d][tt] = z4; }
#pragma unroll
        for (int ks = 0; ks < 2; ++ks) { const bf16x8 va = vaf[ks];
#pragma unroll
            for (int tt = 0; tt < 4; ++tt) { const bf16x8 pfb = *(const LAS bf16x8*)(lds + PF_OFF + (16 * tt + fr) * PPITCH + (32 * ks + 8 * fq) * 2);
                const bf16x8 pbb = *(const LAS bf16x8*)(lds + PB_OFF + (16 * tt + fr) * PPITCH + (32 * ks + 8 * fq) * 2);
                aI[0][tt] = MFMA16(va, pfb, aI[0][tt]); aI[1][tt] = MFMA16(va, pbb, aI[1][tt]); } }
#pragma unroll
        for (int d = 0; d < 2; ++d) {
#pragma unroll
            for (int kk = 0; kk < 4; ++kk) { const bf16x8 ca = caf[d][kk];
#pragma unroll
                for (int tt = 0; tt < 4; ++tt) { const bf16x8 qb = *(const LAS bf16x8*)(lds + QS_OFF + (16 * tt + fr) * QPITCH + (32 * kk + 8 * fq) * 2); aX[d][tt] = MFMA16(ca, qb, aX[d][tt]); } } }
    }
    f32x4 hs[4];
#pragma unroll
    for (int tt = 0; tt < 4; ++tt) { const int t = 16 * tt + fr; const f32x4 z4 = {0.f, 0.f, 0.f, 0.f}; hs[tt] = z4;
#pragma unroll
        for (int d = 0; d < 2; ++d) { const float in = FL[(4 + d) * 64 + t]; const float den = ((FL[(8 + 4 * d) * 64 + t] + FL[(9 + 4 * d) * 64 + t]) + (FL[(10 + 4 * d) * 64 + t] + FL[(11 + 4 * d) * 64 + t])) + in * FL[(16 + d) * 64 + t];
            const float rd = 1.0f / fmaxf(fabsf(den), FL[(6 + d) * 64 + t]); hs[tt] += (aI[d][tt] + aX[d][tt] * in) * rd; }
        float sq = (hs[tt][0] * hs[tt][0] + hs[tt][1] * hs[tt][1]) + (hs[tt][2] * hs[tt][2] + hs[tt][3] * hs[tt][3]);
        sq += __shfl_xor(sq, 16); sq += __shfl_xor(sq, 32);
        if (fq == 0) FL[(18 + wave) * 64 + t] = sq; }
    __syncthreads();
    {
        const f32x4 hg = *(const f32x4*)(p.head_norm_g + layer * 512 + hh * 128 + 16 * wave + 4 * fq);
#pragma unroll
        for (int tt = 0; tt < 4; ++tt) { const int t = 16 * tt + fr; const float ssq = ((FL[18 * 64 + t] + FL[19 * 64 + t]) + (FL[20 * 64 + t] + FL[21 * 64 + t])) + ((FL[22 * 64 + t] + FL[23 * 64 + t]) + (FL[24 * 64 + t] + FL[25 * 64 + t])); const float rsd = rsqrtf(ssq * (1.0f / 128.0f) + 1e-6f);
            bf16* yp = (bf16*)(p.ws + WS_Y) + (size_t)(b * SEQ + tok0 + t) * 1024 + hh * 128 + 16 * wave + 4 * fq;
            const u32x2 gt = *(const u32x2*)yp;
            u32x2 w; w.x = pk2(hs[tt][0] * rsd * hg[0] * bflo(gt.x), hs[tt][1] * rsd * hg[1] * bfhi(gt.x)); w.y = pk2(hs[tt][2] * rsd * hg[2] * bflo(gt.y), hs[tt][3] * rsd * hg[3] * bfhi(gt.y));
            *(u32x2*)yp = w; }
    }
    __syncthreads();
}

#define XB_TMO      128
#define XB_XCNT(j)  (256  + 64 * (j))
#define XB_XSUB(j)  (1280 + 64 * (j))
#define XB_XGEN(j)  (2304 + 64 * (j))
#define XB_TOP      3328
#define XB_TOPGEN   3392
#define XCD_BAR_WORDS 3456
#define XB_SPIN_CAP (1u << 18)

__device__ __forceinline__ unsigned xb_ld(unsigned* p)              { return __hip_atomic_load(p, __ATOMIC_RELAXED, __HIP_MEMORY_SCOPE_AGENT); }
__device__ __forceinline__ unsigned xb_add(unsigned* p, unsigned v) { return __hip_atomic_fetch_add(p, v, __ATOMIC_RELAXED, __HIP_MEMORY_SCOPE_AGENT); }
__device__ __forceinline__ unsigned xb_xcc_id() { return (unsigned)__builtin_amdgcn_s_getreg((3 << 11) | 20) & 0xFu; }
#define XB_SPIN(cond, bar) do { unsigned _sp = 0; while (cond) { __builtin_amdgcn_s_sleep(1); \
    if ((++_sp & 255u) == 0u) { if (xb_ld(&(bar)[XB_TMO])) break; if (_sp > XB_SPIN_CAP) { atomicAdd(&(bar)[XB_TMO], 1u); break; } } } } while (0)

struct XcdBarrier {
    unsigned* bar; unsigned x;
    volatile LAS unsigned* st;
};

__device__ __forceinline__ XcdBarrier xcd_barrier_post(unsigned* bar, volatile LAS unsigned* st) {
    XcdBarrier b; b.bar = bar; b.x = xb_xcc_id(); b.st = st;
    if (threadIdx.x == 0) (void)xb_add(&bar[XB_XCNT(b.x)], 1u);
    return b;
}
__device__ __forceinline__ void xcd_barrier_complete(unsigned* bar, unsigned x, unsigned& nloc, unsigned& nx) {
    const unsigned G = gridDim.x * gridDim.y * gridDim.z;
    unsigned sum, cnt, mine, sp = 0u;
    for (;;) {
        sum = 0u; cnt = 0u; mine = 0u;
#pragma unroll
        for (unsigned j = 0; j < 16; ++j) { const unsigned c = xb_ld(&bar[XB_XCNT(j)]); sum += c; cnt += (c > 0u) ? 1u : 0u; mine = (j == x) ? c : mine; }
        if (sum == G) break;
        __builtin_amdgcn_s_sleep(1);
        if ((++sp & 255u) == 0u) { if (xb_ld(&bar[XB_TMO])) break; if (sp > XB_SPIN_CAP) { atomicAdd(&bar[XB_TMO], 1u); break; } }
    }
    nloc = mine > 0u ? mine : 1u; nx = cnt > 0u ? cnt : 1u;
}

__device__ __forceinline__ void xcd_barrier(const XcdBarrier& b) {
    asm volatile("s_waitcnt vmcnt(0)" ::: "memory");
    __syncthreads();
    if (threadIdx.x == 0) {
        unsigned* bar = b.bar;
        __builtin_amdgcn_s_waitcnt(0);
        unsigned nloc = b.st[0], nx = b.st[1];
        if (nloc == 0u) { xcd_barrier_complete(bar, b.x, nloc, nx); b.st[0] = nloc; b.st[1] = nx; }
        const unsigned old = xb_add(&bar[XB_XSUB(b.x)], 1u);
        const unsigned gen = old / nloc;
        if (old + 1u == (gen + 1u) * nloc) {
            __builtin_amdgcn_fence(__ATOMIC_RELEASE, "agent");
            asm volatile("s_waitcnt vmcnt(0)" ::: "memory");
            const unsigned og = xb_add(&bar[XB_TOP], 1u);
            const unsigned tg = og / nx;
            if (og + 1u == (tg + 1u) * nx) xb_add(&bar[XB_TOPGEN], 1u);
            else XB_SPIN(xb_ld(&bar[XB_TOPGEN]) == tg, bar);
            __builtin_amdgcn_fence(__ATOMIC_ACQUIRE, "agent");
            xb_add(&bar[XB_XGEN(b.x)], 1u);
            asm volatile("s_waitcnt vmcnt(0)" ::: "memory");
        } else {
            XB_SPIN(xb_ld(&bar[XB_XGEN(b.x)]) == gen, bar);
            __builtin_amdgcn_fence(__ATOMIC_ACQUIRE, "agent");
            asm volatile("s_waitcnt vmcnt(0)" ::: "memory");
        }
    }
    __syncthreads();
}

__global__ void __launch_bounds__(NTHR, 2) fwd_megakernel(Params p) {
    extern __shared__ __attribute__((aligned(16))) unsigned char lds_raw[];
    LAS unsigned char* lds = (LAS unsigned char*)lds_raw;
    cg::grid_group grid = cg::this_grid();
#define GRID_SYNC_CG() do { asm volatile("s_waitcnt vmcnt(0) lgkmcnt(0)" ::: "memory"); grid.sync(); \
        __builtin_amdgcn_fence(__ATOMIC_ACQUIRE, "agent"); asm volatile("s_waitcnt vmcnt(0)" ::: "memory"); __syncthreads(); } while (0)
#define GRID_SYNC() do { XcdBarrier xb_; xb_.bar = (unsigned*)(p.ws + WS_CTL); xb_.x = xb_xcc_id(); xb_.st = (volatile LAS unsigned*)(lds + LDS_MISC); xcd_barrier(xb_); } while (0)
    const int tid = threadIdx.x, lane = tid & 63, wave = __builtin_amdgcn_readfirstlane(tid >> 6), G = gridDim.x, bid = blockIdx.x;
    const int vcu = (G % 8 == 0) ? (bid % 8) * (G / 8) + bid / 8 : bid;
    float* ss = (float*)(p.ws + WS_SSP);
    { volatile LAS unsigned* st0 = (volatile LAS unsigned*)(lds + LDS_MISC); if (threadIdx.x < 2) st0[threadIdx.x] = 0u; __syncthreads(); }
    (void)xcd_barrier_post((unsigned*)(p.ws + WS_CTL), (volatile LAS unsigned*)(lds + LDS_MISC));
    bf16* xb = (bf16*)(p.ws + WS_XB);

    const bool defer = (G == 256);
    p0_prologue(p, lds, wave, lane, G, defer ? -1 : 2 * I_L);
    if (G == 0x7fffffff) GRID_SYNC_CG();
    GRID_SYNC();

    for (int layer = 0; layer < 2; ++layer) {
#define RELANE() int tid = threadIdx.x; asm volatile("" : "+v"(tid)); const int lane = tid & 63, wave = __builtin_amdgcn_readfirstlane(tid >> 6)
        {
            pg8::Gemm g{xb, (const bf16*)(p.ws + WS_WIN) + (size_t)layer * NINP * DM, MROWS, NINP, DM};
            pg8::StaticOrder S; S.init(MROWS, NINP, G, bid);
            pg8::EpiIn E{ss + (size_t)(2 * layer) * MROWS * 16, p.ws, p.gate_i_b + layer * 8, p.gate_f_b + layer * 8};
            static_assert(pg8::EpiIn::O_ROPE == WS_ROPE && pg8::EpiIn::O_G == WS_G && pg8::EpiIn::O_QKM == WS_QKM && pg8::EpiIn::O_KTM == WS_KTM && pg8::EpiIn::O_VTM == WS_VTM && pg8::EpiIn::O_AK == WS_AK && pg8::EpiIn::O_VT16 == WS_VT16 && pg8::EpiIn::O_Y == WS_Y, "ws map");
            pg8::gemm_phase<pg8::EpiIn, pg8::StaticOrder, true, true>(lds, g, S, E);
            if (defer && bid >= 192) { RELANE(); LAS float* scr = (LAS float*)(lds + wave * 16384);
                for (int it = layer * I_L + I_IN + I_OUT + (bid - 192) * NWAVE + wave; it < (layer + 1) * I_L; it += 64 * NWAVE) convert_item(p, it, scr, lane); }
        }
        GRID_SYNC();
        {
            RELANE();
            volatile LAS unsigned* ctr = (volatile LAS unsigned*)(lds + LDS_MISC + 16);
            if (tid == 0) *ctr = 0u;
            const int nU = (512 - vcu + G - 1) / G;
            const bool fast = (G * 2 == 512);
            if (fast && wave < 2) {
                __builtin_amdgcn_s_setprio(3);
                scan_wave(p, layer, vcu * 2 + wave, (LAS float*)(lds + wave * 256), lane, true);
                __builtin_amdgcn_s_setprio(0);
            } else {
                const int w0 = fast ? 2 : 0, nw = fast ? 6 : NWAVE;
                for (int I = wave - w0; I < 4 * nU; I += nw) { const int au = vcu + G * (I >> 2); const int b = au >> 6, h = (au >> 3) & 7, p0 = (au & 7) * 256;
                    attn_quad_d1(p, b, h, (p0 >> 4) + 4 * (I & 3), lane); }
                asm volatile("s_waitcnt vmcnt(0)" ::: "memory");
                __syncthreads();
                if (!fast && wave < 2) for (int sw = vcu * 2 + wave; sw < 512; sw += G * 2) scan_wave(p, layer, sw, (LAS float*)(lds + wave * 256), lane, false);
            }
            {
                const int nQ = 8 * nU;
                for (;;) { unsigned Q = 0; if (lane == 0) Q = atomicAdd((unsigned*)(lds_raw + LDS_MISC + 16), 1u); Q = (unsigned)__builtin_amdgcn_readfirstlane((int)Q);
                    if ((int)Q >= nQ) break;
                    const int au = vcu + G * (int)(Q >> 3); const int b = au >> 6, h = (au >> 3) & 7, p0 = (au & 7) * 256; attn_pair(p, b, h, p0, (int)((Q & 3) + 8 * ((Q >> 2) & 1)), lane); }
            }
        }
        GRID_SYNC();
        { RELANE(); for (int u = vcu; u < 1024; u += G) mout_unit(p, layer, u, lds, tid, wave, lane); }
        GRID_SYNC();
        {
            pg8::Gemm g{(const bf16*)(p.ws + WS_Y), (const bf16*)(p.ws + WS_WOUT) + (size_t)layer * DM * DM, MROWS, DM, DM};
            pg8::StaticOrder S; S.init(MROWS, DM, G, bid);
            pg8::EpiRes E{xb, ss + (size_t)(2 * layer + 1) * MROWS * 16};
            pg8::gemm_phase<pg8::EpiRes, pg8::StaticOrder, true, true>(lds, g, S, E);
        }
        GRID_SYNC();
        {
            pg8::Gemm g{xb, (const bf16*)(p.ws + WS_WUP) + (size_t)layer * FF * DM, MROWS, FF, DM};
            pg8::StaticOrder S; S.init(MROWS, FF, G, bid);
            pg8::EpiUp E{ss + (size_t)(2 * layer + 1) * MROWS * 16, (bf16*)(p.ws + WS_U)};
            pg8::gemm_phase<pg8::EpiUp, pg8::StaticOrder, true, true>(lds, g, S, E);
        }
        GRID_SYNC();
        {
            pg8::Gemm g{(const bf16*)(p.ws + WS_U), (const bf16*)(p.ws + WS_WDN) + (size_t)layer * DM * FF, MROWS, DM, FF};
            pg8::StaticOrder S; S.init(MROWS, DM, G, bid);
            pg8::EpiRes E{xb, ss + (size_t)(2 * layer + 2) * MROWS * 16};
            pg8::gemm_phase<pg8::EpiRes, pg8::StaticOrder, true, true>(lds, g, S, E);
        }
        GRID_SYNC();
    }
    {
        RELANE();
        const int gw = bid * NWAVE + wave, NGW = G * NWAVE;
        for (int m = gw; m < MROWS; m += NGW) { const float rsd = rsqrtf(pg8::row_ss(ss + (size_t)4 * MROWS * 16, m) * (1.0f / 1024.0f) + 1e-6f);
            const u32x2* xr = (const u32x2*)(xb + (size_t)m * DM) + lane; f32x4* orow = (f32x4*)(p.out + (size_t)m * DM) + lane; const f32x4* gr = (const f32x4*)p.final_g + lane;
#pragma unroll
            for (int j = 0; j < 4; ++j) { const u32x2 w = xr[64 * j]; const f32x4 g4 = gr[64 * j]; f32x4 o; o[0] = bflo(w.x) * rsd * g4[0]; o[1] = bfhi(w.x) * rsd * g4[1]; o[2] = bflo(w.y) * rsd * g4[2]; o[3] = bfhi(w.y) * rsd * g4[3]; orow[64 * j] = o; } }
    }
}

extern "C" void kernel_launch(void* const* d_in, const int* in_sizes, int n_in, void* d_out, int out_size, void* d_ws, size_t ws_size, hipStream_t stream) {
    static int grid = 0;
    if (grid == 0) {
        int dev = 0, cus = 0, per_cu = 0;
        (void)hipGetDevice(&dev);
        (void)hipDeviceGetAttribute(&cus, hipDeviceAttributeMultiprocessorCount, dev);
        (void)hipFuncSetAttribute((const void*)fwd_megakernel, hipFuncAttributeMaxDynamicSharedMemorySize, LDS_BYTES);
        (void)hipOccupancyMaxActiveBlocksPerMultiprocessor(&per_cu, (const void*)fwd_megakernel, NTHR, LDS_BYTES);
        if (per_cu < 1) per_cu = 1;
        grid = cus * per_cu;
        if (ws_size < WS_END) { fprintf(stderr, "kernel_launch: workspace too small (%zu)\n", ws_size); grid = -1; }
    }
    if (grid < 0) return;
    Params p{};
    p.x = (const float*)d_in[0]; p.norm1_g = (const float*)d_in[1]; p.w_in = (const float*)d_in[2]; p.conv_w = (const float*)d_in[3];
    p.gate_i_b = (const float*)d_in[4]; p.gate_f_b = (const float*)d_in[5]; p.head_norm_g = (const float*)d_in[6]; p.w_out = (const float*)d_in[7];
    p.norm2_g = (const float*)d_in[8]; p.w_up = (const float*)d_in[9]; p.w_down = (const float*)d_in[10]; p.final_g = (const float*)d_in[11];
    p.out = (float*)d_out; p.ws = (unsigned char*)d_ws;
    (void)hipMemsetAsync((char*)d_ws + WS_CTL, 0, CTL_BYTES, stream);
    void* args[] = {&p};
    hipError_t e = hipLaunchCooperativeKernel((void*)fwd_megakernel, dim3(grid), dim3(NTHR), args, LDS_BYTES, stream);
    if (e != hipSuccess) fprintf(stderr, "cooperative launch failed: %s (grid %d)\n", hipGetErrorString(e), grid);
}
```

```cpp
#include <hip/hip_runtime.h>
#include <hip/hip_cooperative_groups.h>
#include <cstdio>
#include <cstdint>
#include <cmath>
namespace cg = cooperative_groups;
namespace pg8 {
#define PG8_LAS __attribute__((address_space(3)))
typedef unsigned short bf16_t;
typedef short bf16x8 __attribute__((ext_vector_type(8)));
typedef float f32x4 __attribute__((ext_vector_type(4)));
typedef unsigned u32x4 __attribute__((ext_vector_type(4)));
constexpr int BM = 256, BK = 64, HALF = 128, HTB = HALF * BK * 2  , STAGE_BYTES = 8 * HTB, NXCD = 8, WGM = 4;

__host__ __device__ __forceinline__ int lds_byte(int r, int c) { const int st = (r >> 4) * 2 + (c >> 5), rr = r & 15, cc = c & 31, ob = rr * 64 + cc * 2; return st * 1024 + (ob ^ (((ob >> 9) & 1) << 5)); }
__host__ __device__ __forceinline__ void stage_rc(int b, int& R, int& C) { const int st = b / 1024, sb = b % 1024, swz = sb ^ (((sb >> 9) & 1) << 5); R = (st >> 1) * 16 + swz / 64; C = (st & 1) * 32 + (swz % 64) / 2; }
__host__ __device__ __forceinline__ int perm32(int rho) { const int n = rho >> 4, i = rho & 15; return 8 * (i >> 2) + 4 * n + (i & 3); }

struct Unit { int pm, pn; };
struct Gemm { const bf16_t* A; const bf16_t* Bt; int M, N, K; };

struct StaticOrder {
    int nM, nN, nwg, G, c;
    __host__ __device__ void init(int M, int N, int G_, int c_) { nM = M / BM; nN = N / BM; nwg = nM * nN; G = G_; c = c_; }
    __host__ __device__ bool next(int i, Unit& u) const {
        const long L = (long)i * G + c; if (L >= nwg) return false;
        int wgid = (int)L; { const int q = nwg / NXCD, r = nwg % NXCD, xcd = wgid % NXCD, off = wgid / NXCD; wgid = (xcd < r ? xcd * (q + 1) : r * (q + 1) + (xcd - r) * q) + off; }
        const int nig = WGM * nN, gid = wgid / nig, fm = gid * WGM, gsz = (nM - fm) < WGM ? (nM - fm) : WGM;
        u.pm = fm + ((wgid % nig) % gsz); u.pn = (wgid % nig) / gsz; return true;
    }
    __device__ __forceinline__ void a_ready(const Unit&) const {}
    __device__ __forceinline__ void done(const Unit&) const {}
};

typedef float f32x2c_t __attribute__((ext_vector_type(2))); typedef __bf16 bf16x2c_t __attribute__((ext_vector_type(2)));
__device__ __forceinline__ unsigned cvt_pk_bf16(float lo, float hi) { f32x2c_t v = {lo, hi}; bf16x2c_t b = __builtin_convertvector(v, bf16x2c_t); return __builtin_bit_cast(unsigned, b); }
typedef float f32x2 __attribute__((ext_vector_type(2)));
__device__ __forceinline__ unsigned short bf16_1(float v) { return (unsigned short)(cvt_pk_bf16(v, v) & 0xffffu); }
__device__ __forceinline__ float row_ss(const float* ssp, int row) { const f32x4* q = (const f32x4*)(ssp + (size_t)row * 16); const f32x4 a = q[0], b = q[1], c = q[2], d = q[3];
    return (((a[0] + a[1]) + (a[2] + a[3])) + ((b[0] + b[1]) + (b[2] + b[3]))) + (((c[0] + c[1]) + (c[2] + c[3])) + ((d[0] + d[1]) + (d[2] + d[3]))); }
__device__ __forceinline__ float row_ss_q(const float* ssp, int row, int fq) { const f32x4 a = *(const f32x4*)(ssp + (size_t)row * 16 + 4 * fq); float t = (a[0] + a[1]) + (a[2] + a[3]);
    t += __shfl_xor(t, 16); t += __shfl_xor(t, 32); return t; }
struct EpiIn {
    static constexpr bool PERM = true, AFTER_DRAIN = false;
    const float* ss; unsigned char* ws; const float* gib; const float* gfb;
    static constexpr size_t O_ROPE = 512 * 1024, O_G = 3u << 20, O_QKM = 120u << 20, O_KTM = 152u << 20, O_VTM = 168u << 20, O_AK = 184u << 20, O_VT16 = 200u << 20, O_Y = 216u << 20;
    __device__ __forceinline__ void operator()(const f32x4 (&acc)[2][2][4][2], const Unit& u, int wr, int wc, int fr_, int fq_) const {
        int fr = fr_, fq = fq_; asm volatile("" : "+v"(fr), "+v"(fq));
        const int pn = u.pn;
        const int rbase = u.pm * BM + wr * 64 + fr;
        float rsv[2][4];
#pragma unroll
        for (int ai = 0; ai < 2; ++ai)
#pragma unroll
            for (int m = 0; m < 4; ++m) rsv[ai][m] = row_ss_q(ss, rbase + ai * HALF + m * 16, fq);
#pragma unroll
        for (int ai = 0; ai < 2; ++ai)
#pragma unroll
            for (int m = 0; m < 4; ++m) rsv[ai][m] = rsqrtf(rsv[ai][m] * (1.0f / 1024.0f) + 1e-6f);
        if (pn < 4) {
            bf16_t* QKm = (bf16_t*)(ws + O_QKM);
#pragma unroll
            for (int ai = 0; ai < 2; ++ai)
#pragma unroll
                for (int m = 0; m < 4; ++m) { const int row = rbase + ai * HALF + m * 16; const float r = rsv[ai][m]; bf16_t* rowp = QKm + (size_t)row * 1024 + pn * 256 + wc * 32 + 8 * fq;
#pragma unroll
                    for (int bj = 0; bj < 2; ++bj) { const f32x4 v0 = acc[ai][bj][m][0] * r, v1 = acc[ai][bj][m][1] * r; u32x4 w;
                        w.x = cvt_pk_bf16(v0[0], v0[1]); w.y = cvt_pk_bf16(v0[2], v0[3]); w.z = cvt_pk_bf16(v1[0], v1[1]); w.w = cvt_pk_bf16(v1[2], v1[3]);
                        *(u32x4*)(rowp + bj * HALF) = w; }
                    asm volatile("" ::: "memory"); }
        }
        if ((pn >= 2 && pn < 6)) {
            const int row0 = u.pm * BM; const int b = row0 >> 11;
            unsigned char* ub = ws + ((pn < 4) ? O_KTM : O_VTM) + ((size_t)(((b * 4 + 2 * (pn & 1)) * 128 + wc * 32) * 2048 + (row0 & 2047) + wr * 64)) * 2;
            const unsigned voff = (unsigned)((8 * fq) * 2048 + fr) * 2u;
#pragma unroll
            for (int ai = 0; ai < 2; ++ai)
#pragma unroll
                for (int m = 0; m < 4; m += 2) { const float r0 = rsv[ai][m], r1 = rsv[ai][m + 1];
#pragma unroll
                    for (int bj = 0; bj < 2; ++bj)
#pragma unroll
                        for (int n = 0; n < 2; ++n)
#pragma unroll
                            for (int j = 0; j < 4; ++j) { const unsigned w = cvt_pk_bf16(acc[ai][bj][m][n][j] * r0, acc[ai][bj][m + 1][n][j] * r1);
                                unsigned char* q = ub + (size_t)(((bj * 128 + 4 * n + j) * 2048 + ai * HALF + m * 16) * 2) + voff;
                                *(bf16_t*)q = (bf16_t)(w & 0xffffu); *(bf16_t*)(q + 32) = (bf16_t)(w >> 16); }
                    asm volatile("" ::: "memory"); }
        } else if (pn == 6 || pn == 7) {
            bf16_t* Y = (bf16_t*)(ws + O_Y);
#pragma unroll
            for (int ai = 0; ai < 2; ++ai)
#pragma unroll
                for (int m = 0; m < 4; ++m) { const int row = rbase + ai * HALF + m * 16; const float r = rsv[ai][m]; bf16_t* rowp = Y + (size_t)row * 1024 + (pn - 6) * 256 + wc * 32 + 8 * fq;
#pragma unroll
                    for (int bj = 0; bj < 2; ++bj) { f32x4 v0 = acc[ai][bj][m][0] * r, v1 = acc[ai][bj][m][1] * r;
#pragma unroll
                        for (int j = 0; j < 4; ++j) { v0[j] = __builtin_amdgcn_rcpf(1.0f + __expf(-v0[j])); v1[j] = __builtin_amdgcn_rcpf(1.0f + __expf(-v1[j])); }
                        u32x4 w; w.x = cvt_pk_bf16(v0[0], v0[1]); w.y = cvt_pk_bf16(v0[2], v0[3]); w.z = cvt_pk_bf16(v1[0], v1[1]); w.w = cvt_pk_bf16(v1[2], v1[3]);
                        *(u32x4*)(rowp + bj * HALF) = w; }
                    asm volatile("" ::: "memory"); }
        } else if (pn >= 8 && pn < 12) {
            const bool isk = pn >= 10; const int head = 4 * (pn & 1) + wc; const float qs = isk ? 1.0f : 0.125f * 1.4426950408889634f;
            const float* ropeC = (const float*)(ws + O_ROPE) + 8 * fq; const float* ropeS = ropeC + 2048 * 32;
            f32x4 tb[2][4];
            { const int pos = rbase & 2047; tb[0][0] = *(const f32x4*)(ropeC + pos * 32); tb[0][1] = *(const f32x4*)(ropeC + pos * 32 + 4); tb[0][2] = *(const f32x4*)(ropeS + pos * 32); tb[0][3] = *(const f32x4*)(ropeS + pos * 32 + 4); }
#pragma unroll
            for (int it = 0; it < 8; ++it) { const int ai = it >> 2, m = it & 3; const int row = rbase + ai * HALF + m * 16; const float r = rsv[ai][m] * qs;
                if (it < 7) { const int pos2 = (rbase + ((it + 1) >> 2) * HALF + ((it + 1) & 3) * 16) & 2047;
                    tb[(it + 1) & 1][0] = *(const f32x4*)(ropeC + pos2 * 32); tb[(it + 1) & 1][1] = *(const f32x4*)(ropeC + pos2 * 32 + 4); tb[(it + 1) & 1][2] = *(const f32x4*)(ropeS + pos2 * 32); tb[(it + 1) & 1][3] = *(const f32x4*)(ropeS + pos2 * 32 + 4); }
                const f32x4 c0 = tb[it & 1][0], c1 = tb[it & 1][1], s0 = tb[it & 1][2], s1 = tb[it & 1][3];
                const f32x4 a0 = acc[ai][0][m][0] * r, a1 = acc[ai][0][m][1] * r, b0 = acc[ai][1][m][0] * r, b1 = acc[ai][1][m][1] * r;
                const f32x4 o10 = a0 * c0 - b0 * s0, o11 = a1 * c1 - b1 * s1, o20 = a0 * s0 + b0 * c0, o21 = a1 * s1 + b1 * c1;
                bf16_t* dst = isk ? ((bf16_t*)(ws + O_AK) + (size_t)row * 512 + head * 64 + 8 * fq) : ((bf16_t*)(ws + O_Y) + (size_t)row * 1024 + 512 + head * 64 + 8 * fq);
                u32x4 w; w.x = cvt_pk_bf16(o10[0], o10[1]); w.y = cvt_pk_bf16(o10[2], o10[3]); w.z = cvt_pk_bf16(o11[0], o11[1]); w.w = cvt_pk_bf16(o11[2], o11[3]);
                *(u32x4*)(dst) = w;
                w.x = cvt_pk_bf16(o20[0], o20[1]); w.y = cvt_pk_bf16(o20[2], o20[3]); w.z = cvt_pk_bf16(o21[0], o21[1]); w.w = cvt_pk_bf16(o21[2], o21[3]);
                *(u32x4*)(dst + 32) = w;
                asm volatile("" ::: "memory"); }
        } else if (pn == 12 || pn == 13) {
            const int row0 = u.pm * BM; const int b = row0 >> 11;
            typedef unsigned u32x2v __attribute__((ext_vector_type(2)));
            unsigned char* ub = ws + O_VT16 + ((size_t)((((b * 8 + 4 * (pn - 12) + (wc >> 1)) * 16 * 32 + ((row0 & 2047) >> 6) + wr) * 256) + (wc & 1) * 128)) * 2;
            const unsigned voff = (unsigned)(fr * 32 * 256 + 8 * fq * 4) * 2u;
#pragma unroll
            for (int ai = 0; ai < 2; ++ai) { const float r0 = rsv[ai][0], r1 = rsv[ai][1], r2 = rsv[ai][2], r3 = rsv[ai][3];
#pragma unroll
                for (int bj = 0; bj < 2; ++bj)
#pragma unroll
                    for (int n = 0; n < 2; ++n)
#pragma unroll
                        for (int j = 0; j < 4; ++j) { u32x2v w; w.x = cvt_pk_bf16(acc[ai][bj][0][n][j] * r0, acc[ai][bj][1][n][j] * r1); w.y = cvt_pk_bf16(acc[ai][bj][2][n][j] * r2, acc[ai][bj][3][n][j] * r3);
                            *(u32x2v*)(ub + (size_t)((bj * 262144 + 2 * ai * 256 + (4 * n + j) * 4) * 2) + voff) = w; }
                asm volatile("" ::: "memory"); }
        } else if (pn == 14) {
            if (wc == 0 && fq < 2) {
                float* G = (float*)(ws + O_G);
#pragma unroll
                for (int ai = 0; ai < 2; ++ai)
#pragma unroll
                    for (int m = 0; m < 4; ++m) { const int row = rbase + ai * HALF + m * 16; const float r = rsv[ai][m];
#pragma unroll
                        for (int n = 0; n < 2; ++n) { f32x4 v = acc[ai][0][m][n] * r; f32x4 o;
#pragma unroll
                            for (int j = 0; j < 4; ++j) { const int c8 = 4 * n + j;
                                if (fq == 0) o[j] = v[j] + gib[c8];
                                else { const float x = v[j] + gfb[c8]; o[j] = fminf(x, 0.0f) - __logf(1.0f + __expf(-fabsf(x))); } }
                            *(f32x4*)(G + (size_t)row * 16 + 8 * fq + 4 * n) = o; }
                        asm volatile("" ::: "memory"); }
            }
        }
    }
};
struct EpiRes {
    static constexpr bool PERM = true, AFTER_DRAIN = false;
    bf16_t* xb; float* ssn;
    __device__ __forceinline__ void operator()(const f32x4 (&acc)[2][2][4][2], const Unit& u, int wr, int wc, int fr, int fq) const {
        const int col0 = u.pn * BM + wc * 32 + 8 * fq;
#pragma unroll
        for (int ai = 0; ai < 2; ++ai)
#pragma unroll
            for (int m = 0; m < 4; ++m) { const int row = u.pm * BM + ai * HALF + wr * 64 + m * 16 + fr; bf16_t* rp = xb + (size_t)row * 1024 + col0; float sq = 0.f;
#pragma unroll
                for (int bj = 0; bj < 2; ++bj) { const u32x4 b = *(const u32x4*)(rp + bj * HALF);
                    const f32x4 v0 = acc[ai][bj][m][0], v1 = acc[ai][bj][m][1];
                    const float o0 = __uint_as_float(b.x << 16) + v0[0], o1 = __uint_as_float(b.x & 0xffff0000u) + v0[1], o2 = __uint_as_float(b.y << 16) + v0[2], o3 = __uint_as_float(b.y & 0xffff0000u) + v0[3];
                    const float o4 = __uint_as_float(b.z << 16) + v1[0], o5 = __uint_as_float(b.z & 0xffff0000u) + v1[1], o6 = __uint_as_float(b.w << 16) + v1[2], o7 = __uint_as_float(b.w & 0xffff0000u) + v1[3];
                    u32x4 w; w.x = cvt_pk_bf16(o0, o1); w.y = cvt_pk_bf16(o2, o3); w.z = cvt_pk_bf16(o4, o5); w.w = cvt_pk_bf16(o6, o7);
                    *(u32x4*)(rp + bj * HALF) = w;
                    sq += ((o0 * o0 + o1 * o1) + (o2 * o2 + o3 * o3)) + ((o4 * o4 + o5 * o5) + (o6 * o6 + o7 * o7)); }
                sq += __shfl_xor(sq, 16); sq += __shfl_xor(sq, 32);
                if (fq == 0) ssn[(size_t)row * 16 + u.pn * 4 + wc] = sq; }
    }
};
struct EpiUp {
    static constexpr bool PERM = true, AFTER_DRAIN = false;
    const float* ss; bf16_t* U;
    __device__ __forceinline__ void operator()(const f32x4 (&acc)[2][2][4][2], const Unit& u, int wr, int wc, int fr, int fq) const {
        const int rbase = u.pm * BM + wr * 64 + fr;
        float rsv[2][4];
#pragma unroll
        for (int ai = 0; ai < 2; ++ai)
#pragma unroll
            for (int m = 0; m < 4; ++m) rsv[ai][m] = row_ss_q(ss, rbase + ai * HALF + m * 16, fq);
#pragma unroll
        for (int ai = 0; ai < 2; ++ai)
#pragma unroll
            for (int m = 0; m < 4; ++m) { const int row = rbase + ai * HALF + m * 16; const float r = rsqrtf(rsv[ai][m] * (1.0f / 1024.0f) + 1e-6f);
                bf16_t* rowp = U + (size_t)row * 4096 + u.pn * BM + wc * 32 + 8 * fq;
#pragma unroll
                for (int bj = 0; bj < 2; ++bj) { f32x4 v0 = acc[ai][bj][m][0] * r, v1 = acc[ai][bj][m][1] * r;
#pragma unroll
                    for (int j = 0; j < 4; ++j) { v0[j] = fmaxf(v0[j], 0.f); v0[j] *= v0[j]; v1[j] = fmaxf(v1[j], 0.f); v1[j] *= v1[j]; }
                    u32x4 w; w.x = cvt_pk_bf16(v0[0], v0[1]); w.y = cvt_pk_bf16(v0[2], v0[3]); w.z = cvt_pk_bf16(v1[0], v1[1]); w.w = cvt_pk_bf16(v1[2], v1[3]);
                    *(u32x4*)(rowp + bj * HALF) = w; } }
    }
};
template <class Epi, class Sched, bool ALIGN_EPI = false, bool SP2 = false>
__device__ __forceinline__ void gemm_phase(PG8_LAS unsigned char* lds, const Gemm g, const Sched& S, const Epi& E) {
    int tid_ = threadIdx.x; asm volatile("" : "+v"(tid_));
    const int tid = tid_, wid = __builtin_amdgcn_readfirstlane(tid >> 6), lane = tid & 63, wr = wid >> 2, wc = wid & 3, fr = lane & 15, fq = lane >> 4;
    const int K = g.K, nt = K / BK;
    unsigned voffA[2], voffB[2];
#pragma unroll
    for (int i = 0; i < 2; ++i) { int R, C; stage_rc(tid * 16 + i * 8192, R, C); const int Rb = Epi::PERM ? ((R & ~31) + perm32(R & 31)) : R;
        voffA[i] = (unsigned)(R * K + C) * 2u; voffB[i] = (unsigned)(Rb * K + C) * 2u; }
    const size_t kstep = (size_t)(BK * 2);
    const size_t hstep = (size_t)HALF * K * 2;
    const size_t tstep = 2 * hstep;
    const unsigned ldsw = (unsigned)wid * 1024u;
    const int aoff = lds_byte(wr * 64 + fr, fq * 8), boff = lds_byte(wc * 32 + fr, fq * 8);
#define PG8_SA(b, h) (((b) * 2 + (h)) * HTB)
#define PG8_SB(b, h) ((4 + (b) * 2 + (h)) * HTB)
#define PG8_STAGE(bufoff, gbase, voff) do { _Pragma("unroll") for (int _i = 0; _i < 2; ++_i) \
        __builtin_amdgcn_global_load_lds((const unsigned*)((const char*)(gbase) + (voff)[_i]), (PG8_LAS unsigned*)(lds + (bufoff) + ldsw + _i * 8192), 16, 0, 0); } while (0)
#define PG8_LDA(dst, b, h) do { _Pragma("unroll") for (int m = 0; m < 4; ++m) _Pragma("unroll") for (int k = 0; k < 2; ++k) dst[m][k] = *(const PG8_LAS bf16x8*)(lds + PG8_SA(b, h) + aoff + m * 2048 + k * 1024); } while (0)
#define PG8_LDB(dst, b, h) do { _Pragma("unroll") for (int n = 0; n < 2; ++n) _Pragma("unroll") for (int k = 0; k < 2; ++k) dst[n][k] = *(const PG8_LAS bf16x8*)(lds + PG8_SB(b, h) + boff + n * 2048 + k * 1024); } while (0)
#define PG8_MMA(ai, bj, At, Bt) do { __builtin_amdgcn_s_setprio(1); _Pragma("unroll") for (int m = 0; m < 4; ++m) _Pragma("unroll") for (int n = 0; n < 2; ++n) _Pragma("unroll") for (int k = 0; k < 2; ++k) \
        acc[ai][bj][m][n] = __builtin_amdgcn_mfma_f32_16x16x32_bf16(Bt[n][k], At[m][k], acc[ai][bj][m][n], 0, 0, 0); __builtin_amdgcn_s_setprio(0); } while (0)
#define PG8_WAIT_V(n) asm volatile("s_waitcnt vmcnt(" #n ")" ::: "memory")
#define PG8_WAIT_L(n) asm volatile("s_waitcnt lgkmcnt(" #n ")" ::: "memory")
#define PG8_BAR __builtin_amdgcn_s_barrier()
#define PG8_SCHED __builtin_amdgcn_sched_barrier(0)
    Unit cur, nxt; int ui = 0;
    if (!S.next(0, cur)) return;
    f32x4 acc[2][2][4][2];
#pragma unroll
    for (int a = 0; a < 2; ++a)
#pragma unroll
        for (int b = 0; b < 2; ++b)
#pragma unroll
            for (int m = 0; m < 4; ++m)
#pragma unroll
                for (int n = 0; n < 2; ++n) acc[a][b][m][n] = (f32x4){0.f, 0.f, 0.f, 0.f};
    bf16x8 At[4][2], B0[2][2], B1[2][2];
    const char* cA = (const char*)g.A + (size_t)cur.pm * tstep; const char* cB = (const char*)g.Bt + (size_t)cur.pn * tstep;
    S.a_ready(cur);
    if constexpr (SP2) {
        PG8_STAGE(PG8_SB(0, 0), cB, voffB); PG8_STAGE(PG8_SB(0, 1), cB + hstep, voffB); PG8_STAGE(PG8_SA(0, 0), cA, voffA); PG8_STAGE(PG8_SA(0, 1), cA + hstep, voffA);
        if (wr == 1) PG8_BAR;
        PG8_WAIT_V(2); PG8_BAR;
        PG8_STAGE(PG8_SB(1, 0), cB + kstep, voffB); PG8_STAGE(PG8_SA(1, 0), cA + kstep, voffA); PG8_STAGE(PG8_SB(1, 1), cB + hstep + kstep, voffB);
        PG8_WAIT_V(6); PG8_BAR;
    } else {
        PG8_STAGE(PG8_SB(0, 0), cB, voffB); PG8_STAGE(PG8_SA(0, 0), cA, voffA); PG8_STAGE(PG8_SB(0, 1), cB + hstep, voffB); PG8_STAGE(PG8_SA(0, 1), cA + hstep, voffA);
        if (wr == 1) PG8_BAR;
        PG8_WAIT_V(4); PG8_BAR;
        PG8_STAGE(PG8_SB(1, 0), cB + kstep, voffB); PG8_STAGE(PG8_SA(1, 0), cA + kstep, voffA); PG8_STAGE(PG8_SB(1, 1), cB + hstep + kstep, voffB);
        PG8_WAIT_V(6); PG8_BAR;
    }
    for (;;) {
        const bool has_next = S.next(ui + 1, nxt);
        const char* nA = has_next ? (const char*)g.A + (size_t)nxt.pm * tstep : cA; const char* nB = has_next ? (const char*)g.Bt + (size_t)nxt.pn * tstep : cB;
        for (int t = 0; t < nt; t += 2) {
            const bool last = (t == nt - 2);
            const char* a1 = cA + (size_t)(t + 1) * kstep;
            const char* a2 = last ? nA : cA + (size_t)(t + 2) * kstep; const char* b2 = last ? nB : cB + (size_t)(t + 2) * kstep;
            const char* a3 = a2 + kstep; const char* b3 = b2 + kstep;
            if (last && has_next) S.a_ready(nxt);
            if constexpr (SP2) {
            PG8_LDB(B0, 0, 0); PG8_LDB(B1, 0, 1); PG8_SCHED; PG8_LDA(At, 0, 0); PG8_STAGE(PG8_SA(1, 1), a1 + hstep, voffA);
            PG8_WAIT_V(8); PG8_WAIT_L(0); PG8_BAR; PG8_MMA(0, 0, At, B0); PG8_MMA(0, 1, At, B1); PG8_BAR; PG8_SCHED;
            PG8_LDA(At, 0, 1); PG8_STAGE(PG8_SB(0, 0), b2, voffB); PG8_STAGE(PG8_SB(0, 1), b2 + hstep, voffB); PG8_STAGE(PG8_SA(0, 0), a2, voffA);
            PG8_WAIT_V(8); PG8_WAIT_L(0); PG8_BAR; PG8_MMA(1, 0, At, B0); PG8_MMA(1, 1, At, B1); PG8_BAR; PG8_SCHED;
            PG8_LDB(B0, 1, 0); PG8_LDB(B1, 1, 1); PG8_SCHED; PG8_LDA(At, 1, 0); PG8_STAGE(PG8_SA(0, 1), a2 + hstep, voffA);
            PG8_WAIT_V(8); PG8_WAIT_L(0); PG8_BAR; PG8_MMA(0, 0, At, B0); PG8_MMA(0, 1, At, B1); PG8_BAR; PG8_SCHED;
            PG8_LDA(At, 1, 1); PG8_STAGE(PG8_SB(1, 0), b3, voffB); PG8_STAGE(PG8_SB(1, 1), b3 + hstep, voffB); PG8_STAGE(PG8_SA(1, 0), a3, voffA);
            PG8_WAIT_V(8); PG8_WAIT_L(0); PG8_BAR; PG8_MMA(1, 0, At, B0); PG8_MMA(1, 1, At, B1); PG8_BAR; PG8_SCHED;
            } else {
            PG8_LDB(B0, 0, 0); PG8_SCHED; PG8_LDA(At, 0, 0); PG8_STAGE(PG8_SA(1, 1), a1 + hstep, voffA);
            PG8_WAIT_L(8); PG8_BAR; PG8_WAIT_L(0); PG8_MMA(0, 0, At, B0); PG8_BAR; PG8_SCHED;
            PG8_LDB(B1, 0, 1); PG8_STAGE(PG8_SB(0, 0), b2, voffB);
            PG8_BAR; PG8_WAIT_L(0); PG8_MMA(0, 1, At, B1); PG8_BAR;
            PG8_LDA(At, 0, 1); PG8_STAGE(PG8_SA(0, 0), a2, voffA);
            PG8_BAR; PG8_WAIT_L(0); PG8_MMA(1, 0, At, B0); PG8_BAR; PG8_SCHED;
            PG8_STAGE(PG8_SB(0, 1), b2 + hstep, voffB);
            PG8_WAIT_V(6); PG8_BAR; PG8_MMA(1, 1, At, B1); PG8_BAR;
            PG8_LDB(B0, 1, 0); PG8_SCHED; PG8_LDA(At, 1, 0); PG8_STAGE(PG8_SA(0, 1), a2 + hstep, voffA);
            PG8_WAIT_L(8); PG8_BAR; PG8_WAIT_L(0); PG8_MMA(0, 0, At, B0); PG8_BAR; PG8_SCHED;
            PG8_LDB(B1, 1, 1); PG8_STAGE(PG8_SB(1, 0), b3, voffB);
            PG8_BAR; PG8_WAIT_L(0); PG8_MMA(0, 1, At, B1); PG8_BAR;
            PG8_LDA(At, 1, 1); PG8_STAGE(PG8_SA(1, 0), a3, voffA);
            PG8_BAR; PG8_WAIT_L(0); PG8_MMA(1, 0, At, B0); PG8_BAR; PG8_SCHED;
            PG8_STAGE(PG8_SB(1, 1), b3 + hstep, voffB);
            PG8_WAIT_V(6); PG8_BAR; PG8_MMA(1, 1, At, B1); PG8_BAR;
            }
        }
        if constexpr (ALIGN_EPI) { if (wr == 0) PG8_BAR; }
        if constexpr (!Epi::AFTER_DRAIN) { E(acc, cur, wr, wc, fr, fq); S.done(cur); }
        if (!has_next) break;
#pragma unroll
        for (int a = 0; a < 2; ++a)
#pragma unroll
            for (int b = 0; b < 2; ++b)
#pragma unroll
                for (int m = 0; m < 4; ++m)
#pragma unroll
                    for (int n = 0; n < 2; ++n) acc[a][b][m][n] = (f32x4){0.f, 0.f, 0.f, 0.f};
        cur = nxt; cA = nA; cB = nB; ++ui;
        if constexpr (ALIGN_EPI) { if (wr == 1) PG8_BAR; }
    }
    PG8_WAIT_V(0);
    if constexpr (!ALIGN_EPI) { if (wr == 0) PG8_BAR; }
    PG8_BAR;
    if constexpr (Epi::AFTER_DRAIN) { E.fused(acc, cur, wr, wc, fr, fq, lds, wid, lane); S.done(cur); }
#undef PG8_SA
#undef PG8_SB
#undef PG8_STAGE
#undef PG8_LDA
#undef PG8_LDB
#undef PG8_MMA
#undef PG8_WAIT_V
#undef PG8_WAIT_L
#undef PG8_BAR
#undef PG8_SCHED
}
}
#define LAS __attribute__((address_space(3)))
typedef unsigned short bf16;
typedef short bf16x8 __attribute__((ext_vector_type(8)));
typedef float f32x4 __attribute__((ext_vector_type(4)));
typedef unsigned u32x4 __attribute__((ext_vector_type(4)));
typedef unsigned u32x2 __attribute__((ext_vector_type(2)));
constexpr int SEQ = 2048, DM = 1024, MROWS = 16384, FF = 4096, NINP = 3840, NINL = 3600, NTHR = 512, NWAVE = 8;
constexpr size_t MiB = 1u << 20;
constexpr size_t WS_SS = 0, WS_ROPE = 512 * 1024, WS_N = 1 * MiB, WS_MST = 2 * MiB, WS_G = 3 * MiB;
constexpr size_t WS_WIN = 4 * MiB, WS_WOUT = 19 * MiB, WS_WUP = 23 * MiB, WS_WDN = 39 * MiB;
constexpr size_t WS_XB = 56 * MiB;
constexpr size_t WS_SSP = 88 * MiB;
constexpr size_t WS_P1O = 93 * MiB, WS_P1ML = 109 * MiB;
constexpr size_t WS_U = 120 * MiB;
constexpr size_t WS_QKM = 120 * MiB, WS_KTM = 152 * MiB, WS_VTM = 168 * MiB, WS_AK = 184 * MiB, WS_VT16 = 200 * MiB, WS_Y = 216 * MiB, WS_END = 248 * MiB;
constexpr size_t WS_CTL = 2 * MiB + 256 * 1024, CTL_BYTES = 16384;
constexpr int LDS_BYTES = 147456, LDS_MISC = 131072 + 320;

struct Params {
    const float *x, *norm1_g, *w_in, *conv_w, *gate_i_b, *gate_f_b, *head_norm_g, *w_out, *norm2_g, *w_up, *w_down, *final_g;
    float* out; unsigned char* ws;
};

__device__ __forceinline__ unsigned pk2(float lo, float hi) { return pg8::cvt_pk_bf16(lo, hi); }
__device__ __forceinline__ float bflo(unsigned w) { return __uint_as_float(w << 16); }
__device__ __forceinline__ float bfhi(unsigned w) { return __uint_as_float(w & 0xffff0000u); }
__device__ __forceinline__ float wave_sum(float v) {
#pragma unroll
    for (int o = 1; o < 64; o <<= 1) v += __shfl_xor(v, o);
    return v;
}
__device__ __forceinline__ float wave_max(float v) {
#pragma unroll
    for (int o = 1; o < 64; o <<= 1) v = fmaxf(v, __shfl_xor(v, o));
    return v;
}
__device__ __forceinline__ float wave_incl_scan(float v, int lane) {
#pragma unroll
    for (int o = 1; o < 64; o <<= 1) { const float t = __shfl_up(v, o); if (lane >= o) v += t; }
    return v;
}

#define DPP_STEP_ADD(v, ctrl, rm) do { const int t_ = __builtin_amdgcn_update_dpp(0, __float_as_int(v), (ctrl), (rm), 0xf, false); v += __int_as_float(t_); } while (0)
#define DPP_STEP_MAX(v, ctrl, rm) do { const int t_ = __builtin_amdgcn_update_dpp((int)0xff800000, __float_as_int(v), (ctrl), (rm), 0xf, false); v = fmaxf(v, __int_as_float(t_)); } while (0)
__device__ __forceinline__ float wave_incl_scan_dpp(float v) {
    DPP_STEP_ADD(v, 0x111, 0xf); DPP_STEP_ADD(v, 0x112, 0xf); DPP_STEP_ADD(v, 0x114, 0xf); DPP_STEP_ADD(v, 0x118, 0xf); DPP_STEP_ADD(v, 0x142, 0xa); DPP_STEP_ADD(v, 0x143, 0xc);
    return v;
}
__device__ __forceinline__ float wave_incl_max_dpp(float v) {
    DPP_STEP_MAX(v, 0x111, 0xf); DPP_STEP_MAX(v, 0x112, 0xf); DPP_STEP_MAX(v, 0x114, 0xf); DPP_STEP_MAX(v, 0x118, 0xf); DPP_STEP_MAX(v, 0x142, 0xa); DPP_STEP_MAX(v, 0x143, 0xc);
    return v;
}
__device__ __forceinline__ float wave_max_dpp(float v) {
    DPP_STEP_MAX(v, 0x111, 0xf); DPP_STEP_MAX(v, 0x112, 0xf); DPP_STEP_MAX(v, 0x114, 0xf); DPP_STEP_MAX(v, 0x118, 0xf); DPP_STEP_MAX(v, 0x142, 0xa); DPP_STEP_MAX(v, 0x143, 0xc);
    return __int_as_float(__builtin_amdgcn_readlane(__float_as_int(v), 63));
}
#define MFMA16(a, b, c) __builtin_amdgcn_mfma_f32_16x16x32_bf16((a), (b), (c), 0, 0, 0)

__device__ __forceinline__ int win_src_col(int nb, int& nvalid) {
    nvalid = 32;
    if (nb < 2048) return nb;
    if (nb < 3072) { int xx = nb - 2048; const int isk = xx >> 9; xx &= 511; const int T = xx >> 8, bj = (xx >> 7) & 1, hl = (xx >> 5) & 3; return 2064 + isk * 512 + 64 * (4 * T + hl) + 32 * bj; }
    if (nb < 3584) return 3088 + (nb - 3072);
    if (nb == 3584) { nvalid = 16; return 2048; }
    nvalid = 0; return 0;
}
__device__ __forceinline__ void transpose_item(const float* W, int K, int Nsrc, int src_col, int nvalid, const float* g, bf16* WT, int dst_row, int k0, LAS float* scr, int lane) {
    const int c = lane & 31;
    float wv[32];
#pragma unroll
    for (int i = 0; i < 32; ++i) { const int kk = 2 * i + (lane >> 5); wv[i] = (c < nvalid) ? W[(size_t)(k0 + kk) * Nsrc + src_col + c] : 0.f; }
    if (g) {
#pragma unroll
        for (int i = 0; i < 32; ++i) wv[i] *= g[k0 + 2 * i + (lane >> 5)]; }
#pragma unroll
    for (int i = 0; i < 32; ++i) scr[(2 * i + (lane >> 5)) * 33 + c] = wv[i];
    asm volatile("s_waitcnt lgkmcnt(0)" ::: "memory");
    const int ch = lane & 7;
#pragma unroll
    for (int j = 0; j < 4; ++j) { const int n = (lane >> 3) + 8 * j; const LAS float* s = scr + (8 * ch) * 33 + n;
        u32x4 o; o.x = pk2(s[0 * 33], s[1 * 33]); o.y = pk2(s[2 * 33], s[3 * 33]); o.z = pk2(s[4 * 33], s[5 * 33]); o.w = pk2(s[6 * 33], s[7 * 33]);
        *(u32x4*)(WT + (size_t)(dst_row + n) * K + k0 + 8 * ch) = o; }
    asm volatile("s_waitcnt lgkmcnt(0)" ::: "memory");
}
constexpr int I_IN = 16 * (NINP / 32), I_OUT = 16 * 32, I_UP = 16 * 128, I_DN = 64 * 32, I_L = I_IN + I_OUT + I_UP + I_DN;
__device__ __forceinline__ void convert_item(const Params& p, int it, LAS float* scr, int lane) {
    const int l = it / I_L; int r = it % I_L;
    if (r < I_IN) { const int nblk = NINP / 32, kb = r / nblk, nb = (r % nblk) * 32; int nv; const int sc = win_src_col(nb, nv);
        transpose_item(p.w_in + (size_t)l * DM * NINL, DM, NINL, sc, nv, p.norm1_g + l * DM, (bf16*)(p.ws + WS_WIN) + (size_t)l * NINP * DM, nb, kb * 64, scr, lane); return; }
    r -= I_IN;
    if (r < I_OUT) { const int kb = r / 32, nb = (r % 32) * 32;
        transpose_item(p.w_out + (size_t)l * DM * DM, DM, DM, nb, 32, nullptr, (bf16*)(p.ws + WS_WOUT) + (size_t)l * DM * DM, nb, kb * 64, scr, lane); return; }
    r -= I_OUT;
    if (r < I_UP) { const int kb = r / 128, nb = (r % 128) * 32;
        transpose_item(p.w_up + (size_t)l * DM * FF, DM, FF, nb, 32, p.norm2_g + l * DM, (bf16*)(p.ws + WS_WUP) + (size_t)l * FF * DM, nb, kb * 64, scr, lane); return; }
    r -= I_UP;
    { const int kb = r / 32, nb = (r % 32) * 32;
        transpose_item(p.w_down + (size_t)l * FF * DM, FF, DM, nb, 32, nullptr, (bf16*)(p.ws + WS_WDN) + (size_t)l * DM * FF, nb, kb * 64, scr, lane); }
}
__device__ __forceinline__ void p0_prologue(const Params& p, LAS unsigned char* lds, int wave, int lane, int G, int n_items) {
    LAS float* scr = (LAS float*)(lds + wave * 16384);
    const int gw = blockIdx.x * NWAVE + wave, NGW = G * NWAVE;
    if (n_items < 0) { constexpr int I_A = I_IN + I_OUT;
        for (int j = gw; j < 2 * I_A; j += NGW) convert_item(p, (j / I_A) * I_L + (j % I_A), scr, lane); }
    else for (int it = gw; it < n_items; it += NGW) convert_item(p, it, scr, lane);
    float* ss = (float*)(p.ws + WS_SSP); bf16* xb = (bf16*)(p.ws + WS_XB);
    for (int m0 = gw; m0 < MROWS; m0 += 2 * NGW) {
        f32x4 v[2][4];
#pragma unroll
        for (int q = 0; q < 2; ++q) { const int m = (m0 + q * NGW < MROWS) ? m0 + q * NGW : m0; const f32x4* xr = (const f32x4*)(p.x + (size_t)m * DM) + lane;
#pragma unroll
            for (int j = 0; j < 4; ++j) v[q][j] = xr[64 * j]; }
#pragma unroll
        for (int q = 0; q < 2; ++q) { const int m = m0 + q * NGW; if (m < MROWS) { float s = 0.f; u32x2* o8 = (u32x2*)(xb + (size_t)m * DM) + lane;
#pragma unroll
            for (int j = 0; j < 4; ++j) { const f32x4 t = v[q][j]; s += (t[0] * t[0] + t[1] * t[1]) + (t[2] * t[2] + t[3] * t[3]); u32x2 w; w.x = pk2(t[0], t[1]); w.y = pk2(t[2], t[3]); o8[64 * j] = w; }
            s = wave_sum(s); if (lane < 16) ss[(size_t)m * 16 + lane] = (lane == 0) ? s : 0.f; } }
    }
    const int gt = blockIdx.x * NTHR + threadIdx.x, NGT = G * NTHR;
    float* rc = (float*)(p.ws + WS_ROPE); float* rsn = rc + SEQ * 32;
    for (int i = gt; i < SEQ * 32; i += NGT) { const int pos = i >> 5, fi = i & 31;
        const float inv = exp2f(-(float)fi * (13.287712379549449f / 32.0f)); const float ang = (float)pos * inv;
        const float n = rintf(ang * 0.15915494309189535f); float rr = fmaf(-n, 6.2831854820251465f, ang); rr = fmaf(-n, -1.7484555e-7f, rr);
        rc[i] = __cosf(rr); rsn[i] = __sinf(rr); }
}

struct ScanLd { u32x4 kc[2]; unsigned kb[2], ka[2]; float li, lf; };
__device__ __forceinline__ void scan_load(ScanLd& L, const bf16* Krow, const bf16* Vrow, const float* Gp, int tok0, int fq, int lane, int gcol) {
    L.li = Gp[(size_t)(tok0 + lane) * 16 + gcol]; L.lf = Gp[(size_t)(tok0 + lane) * 16 + 8 + gcol];
#pragma unroll
    for (int ks = 0; ks < 2; ++ks) { const int base = tok0 + 32 * ks + 8 * fq;
        L.kc[ks] = *(const u32x4*)(Krow + base);
        L.kb[ks] = (base >= 2) ? *(const unsigned*)(Krow + base - 2) : 0u;
        L.ka[ks] = (base + 8 < SEQ) ? *(const unsigned*)(Krow + base + 8) : 0u; }
}
__device__ __forceinline__ void scan_wave(const Params& p, int layer, int sw, LAS float* wl, int lane, bool bar_mid) {
    const int ksl = sw & 7, dir = (sw >> 3) & 1, hh = (sw >> 4) & 3, b = sw >> 6;
    const int fr = lane & 15, fq = lane >> 4, kdim = 16 * ksl + fr;
    const float* cw = p.conv_w + (size_t)layer * 5 * 1024 + 512 + hh * 128 + kdim;
    float cwt[5];
#pragma unroll
    for (int t = 0; t < 5; ++t) cwt[t] = cw[t * 1024];
    const bf16* Krow = (const bf16*)(p.ws + WS_KTM) + ((size_t)((b * 4 + hh) * 128 + kdim)) * SEQ;
    const bf16* Vrow = (const bf16*)(p.ws + WS_VTM) + ((size_t)((b * 4 + hh) * 128 + fr)) * SEQ;
    const float* Gp = (const float*)(p.ws + WS_G) + (size_t)b * SEQ * 16;
    const int gcol = dir * 4 + hh;
    bf16* Ct = (bf16*)p.out; float* Nst = (float*)(p.ws + WS_N); float* Mst = (float*)(p.ws + WS_MST);
    const f32x4 z4 = {0.f, 0.f, 0.f, 0.f};
    f32x4 C[8], CN = z4; float mrun = -1e30f;
#pragma unroll
    for (int nt = 0; nt < 8; ++nt) C[nt] = z4;
    const bf16x8 ones = {0x3F80, 0x3F80, 0x3F80, 0x3F80, 0x3F80, 0x3F80, 0x3F80, 0x3F80};
    ScanLd cur, nxt;
    scan_load(cur, Krow, Vrow, Gp, (dir ? 31 : 0) * 64, fq, lane, gcol);
    for (int cs = 0; cs < 32; ++cs) {
        if (bar_mid && cs == 11) __syncthreads();
        const int pc = dir ? 31 - cs : cs;
        bf16x8 vv[8][2];
#pragma unroll
        for (int ks = 0; ks < 2; ++ks)
#pragma unroll
            for (int nt = 0; nt < 8; ++nt) vv[nt][ks] = *(const bf16x8*)(Vrow + (size_t)nt * 16 * SEQ + pc * 64 + 32 * ks + 8 * fq);
        if (cs + 1 < 32) scan_load(nxt, Krow, Vrow, Gp, (dir ? 30 - cs : cs + 1) * 64, fq, lane, gcol); else nxt = cur;
        const float pre = wave_incl_scan_dpp(cur.lf); const float total = __int_as_float(__builtin_amdgcn_readlane(__float_as_int(pre), 63));
        const float g = dir ? (pre - cur.lf + cur.li) : (total - pre + cur.li);
        const float gmax = wave_max_dpp(g);
        const float mn = fmaxf(total + mrun, gmax); const float decay = __expf(total + mrun - mn); const float w = __expf(g - mn);
        const size_t sidx = (size_t)((b * 4 + hh) * 2 + dir) * 32 + pc;
        { bf16* Cd = Ct + sidx * 16384 + (size_t)fr * 128 + 16 * ksl + 4 * fq;
#pragma unroll
          for (int nt = 0; nt < 8; ++nt) { u32x2 w0; w0.x = pk2(C[nt][0], C[nt][1]); w0.y = pk2(C[nt][2], C[nt][3]); *(u32x2*)(Cd + nt * 16 * 128) = w0; }
          if (fr == 0) *(f32x4*)(Nst + sidx * 128 + 16 * ksl + 4 * fq) = CN;
          if (ksl == 0 && lane == 0) Mst[sidx] = mrun; }
        wl[lane] = w;
        asm volatile("s_waitcnt lgkmcnt(0)" ::: "memory");
        bf16x8 afr[2];
#pragma unroll
        for (int ks = 0; ks < 2; ++ks) {
            const f32x4 wa = *(const LAS f32x4*)(wl + 32 * ks + 8 * fq), wb = *(const LAS f32x4*)(wl + 32 * ks + 8 * fq + 4);
            float r[12]; r[0] = bflo(cur.kb[ks]); r[1] = bfhi(cur.kb[ks]);
#pragma unroll
            for (int q = 0; q < 4; ++q) { r[2 + 2 * q] = bflo(cur.kc[ks][q]); r[3 + 2 * q] = bfhi(cur.kc[ks][q]); }
            r[10] = bflo(cur.ka[ks]); r[11] = bfhi(cur.ka[ks]);
            float o[8];
#pragma unroll
            for (int j = 0; j < 8; ++j) { float a = 0.f;
#pragma unroll
                for (int t = 0; t < 5; ++t) a = fmaf(cwt[t], r[j + t], a);
                a = a * __builtin_amdgcn_rcpf(1.0f + __expf(-a)); o[j] = a * 0.08838834764831845f * (j < 4 ? wa[j] : wb[j - 4]); }
            u32x4 pw; pw.x = pk2(o[0], o[1]); pw.y = pk2(o[2], o[3]); pw.z = pk2(o[4], o[5]); pw.w = pk2(o[6], o[7]);
            afr[ks] = __builtin_bit_cast(bf16x8, pw);
        }
        asm volatile("" ::: "memory");
        CN = CN * decay;
#pragma unroll
        for (int nt = 0; nt < 8; ++nt) { C[nt] = C[nt] * decay; C[nt] = MFMA16(afr[0], vv[nt][0], C[nt]); C[nt] = MFMA16(afr[1], vv[nt][1], C[nt]); }
        CN = MFMA16(afr[0], ones, CN); CN = MFMA16(afr[1], ones, CN);
        mrun = mn; cur = nxt;
    }
}

__device__ __forceinline__ void tile_par(int T, int f, int r, int L0, int& R, int& Lb, int& dsh) {
    if (T < 10) { dsh = 4; R = r; Lb = L0 - 64 + 16 * T + 4 * f; }
    else if (T < 22) { dsh = 2; R = 4 * f + (r & 3); Lb = L0 - 16 + 4 * (T - 10); }
    else { const int xx = T - 22; dsh = 0; R = 4 * (xx & 3) + f; Lb = L0 - 4 + 4 * (xx >> 2); }
}
template <int LIM> __device__ __forceinline__ void attn_step(f32x4 (&O)[4], float& mrun, float& lsum, const bf16x8 (&qf)[2], const bf16x8 k00, const bf16x8 k01, const bf16x8 k10, const bf16x8 k11,
                                                             const u32x2 (&v0)[4], const u32x2 (&v1)[4], int D0, int D1, bool ok0, bool ok1) {
    const f32x4 z4 = {0.f, 0.f, 0.f, 0.f};
    f32x4 s0 = MFMA16(k00, qf[0], z4); s0 = MFMA16(k01, qf[1], s0);
    f32x4 s1 = MFMA16(k10, qf[0], z4); s1 = MFMA16(k11, qf[1], s1);
    bool va[4], vb[4];
#pragma unroll
    for (int j = 0; j < 4; ++j) { va[j] = ok0 && ((unsigned)(D0 + 16 * j) <= (unsigned)(2 * LIM)); vb[j] = ok1 && ((unsigned)(D1 + 16 * j) <= (unsigned)(2 * LIM));
        s0[j] = va[j] ? s0[j] : -1e30f; s1[j] = vb[j] ? s1[j] : -1e30f; }
    float tm = fmaxf(fmaxf(fmaxf(s0[0], s0[1]), fmaxf(s0[2], s0[3])), fmaxf(fmaxf(s1[0], s1[1]), fmaxf(s1[2], s1[3])));
    tm = fmaxf(tm, __shfl_xor(tm, 16)); tm = fmaxf(tm, __shfl_xor(tm, 32));
    const float mn = fmaxf(mrun, tm);
    if (__any(mn > mrun)) { const float sc = __builtin_amdgcn_exp2f(mrun - mn); lsum *= sc;
#pragma unroll
        for (int d = 0; d < 4; ++d) O[d] = O[d] * sc; }
    mrun = mn;
    float pv[8]; float ps = 0.f;
#pragma unroll
    for (int j = 0; j < 4; ++j) { pv[j] = va[j] ? __builtin_amdgcn_exp2f(s0[j] - mn) : 0.f; pv[4 + j] = vb[j] ? __builtin_amdgcn_exp2f(s1[j] - mn) : 0.f; ps += pv[j] + pv[4 + j]; }
    lsum += ps;
    u32x4 pw; pw.x = pk2(pv[0], pv[1]); pw.y = pk2(pv[2], pv[3]); pw.z = pk2(pv[4], pv[5]); pw.w = pk2(pv[6], pv[7]);
    const bf16x8 pb = __builtin_bit_cast(bf16x8, pw);
#pragma unroll
    for (int d = 0; d < 4; ++d) { u32x4 vw; vw.x = v0[d].x; vw.y = v0[d].y; vw.z = v1[d].x; vw.w = v1[d].y; O[d] = MFMA16(__builtin_bit_cast(bf16x8, vw), pb, O[d]); }
}
#define KLD(ptr, lo, hi) do { lo = *(const bf16x8*)(ptr); hi = *(const bf16x8*)((ptr) + 32); } while (0)
#define VLD(ptr, v) do { _Pragma("unroll") for (int d_ = 0; d_ < 4; ++d_) v[d_] = *(const u32x2*)((ptr) + d_ * 64); } while (0)
__device__ __forceinline__ void attn_pair(const Params& p, int b, int h, int p0, int r0, int lane) {
    const int fr = lane & 15, fq = lane >> 4, fK = fr >> 2, jK = fr & 3; const int L0 = p0 >> 4;
    const f32x4 z4 = {0.f, 0.f, 0.f, 0.f};
    bf16* Yrow[2]; bf16x8 qf[2][2]; f32x4 O[2][4]; float mrun[2], lsum[2];
    const bf16* Kb = (const bf16*)(p.ws + WS_AK) + (ptrdiff_t)b * SEQ * 512 + h * 64 + 8 * fq;
    const bf16* Vb = (const bf16*)(p.ws + WS_VT16) + (ptrdiff_t)(b * 8 + h) * 131072 + fr * 4;
#pragma unroll
    for (int u = 0; u < 2; ++u) { const int pq = p0 + 16 * fr + r0 + 4 * u; Yrow[u] = (bf16*)(p.ws + WS_Y) + ((size_t)(b * SEQ + pq)) * 1024 + 512 + h * 64;
        qf[u][0] = *(const bf16x8*)(Yrow[u] + 8 * fq); qf[u][1] = *(const bf16x8*)(Yrow[u] + 32 + 8 * fq); mrun[u] = -1e30f; lsum[u] = 0.f;
#pragma unroll
        for (int d = 0; d < 4; ++d) O[u][d] = z4; }
    {
        const bf16* kp = Kb + (ptrdiff_t)(16 * (L0 - 64 + 4 * fK + jK) + r0) * 512;
        const bf16* vp = Vb + (ptrdiff_t)(r0 * 32 + (L0 >> 2) - 16 + fq) * 256;
        for (int pp = 0; pp < 5; ++pp) { const int T0 = 2 * pp; const int lq = L0 - 64 + 16 * T0;
            if (lq + 31 < 0 || lq >= 128) continue;
            const int D0 = 16 * (-64 + 16 * T0 + 4 * fq - fr) + 1024; const bool ok0 = (unsigned)(lq + 4 * fq) < 128u, ok1 = (unsigned)(lq + 16 + 4 * fq) < 128u;
            const bf16* k0p = kp + (ptrdiff_t)T0 * 256 * 512; const bf16* v0p = vp + (ptrdiff_t)T0 * 4 * 256;
#pragma unroll
            for (int u = 0; u < 2; ++u) { bf16x8 k00, k01, k10, k11; u32x2 v0[4], v1[4];
                KLD(k0p + u * 4 * 512, k00, k01); VLD(v0p + u * 4 * 32 * 256, v0);
                if (pp < 4) { KLD(k0p + u * 4 * 512 + 256 * 512, k10, k11); VLD(v0p + u * 4 * 32 * 256 + 4 * 256, v1); }
                else { k10 = k00; k11 = k01;
#pragma unroll
                    for (int d_ = 0; d_ < 4; ++d_) v1[d_] = v0[d_]; }
                attn_step<1024>(O[u], mrun[u], lsum[u], qf[u], k00, k01, k10, k11, v0, v1, D0, D0 + 256, ok0, ok1 && (pp < 4)); }
        }
    }
    {
        const bf16* kp = Kb + (ptrdiff_t)(16 * (L0 - 16 + jK) + 4 * fK + (r0 & 3)) * 512;
        const bf16* vp = Vb + (ptrdiff_t)((4 * fq + (r0 & 3)) * 32 + (L0 >> 2) - 4) * 256;
        for (int pp = 0; pp < 6; ++pp) { const int T0 = 2 * pp; const int lb = L0 - 16 + 4 * T0;
            const bool ok0 = (unsigned)lb < 128u, ok1 = (unsigned)(lb + 4) < 128u; if (!ok0 && !ok1) continue;
            const int D0 = 16 * (-16 + 4 * T0 - fr) + 4 * fq - (r0 & ~3) + 256;
            const bf16* k0p = kp + (ptrdiff_t)T0 * 64 * 512; const bf16* v0p = vp + (ptrdiff_t)T0 * 256;
            { bf16x8 k00, k01, k10, k11; u32x2 v0[4], v1[4];
                KLD(k0p, k00, k01); KLD(k0p + 64 * 512, k10, k11); VLD(v0p, v0); VLD(v0p + 256, v1);
                attn_step<256>(O[0], mrun[0], lsum[0], qf[0], k00, k01, k10, k11, v0, v1, D0, D0 + 64, ok0, ok1);
                attn_step<256>(O[1], mrun[1], lsum[1], qf[1], k00, k01, k10, k11, v0, v1, D0 - 4, D0 + 60, ok0, ok1); }
        }
    }
#pragma unroll
    for (int u = 0; u < 2; ++u) { float l2 = lsum[u]; l2 += __shfl_xor(l2, 16); l2 += __shfl_xor(l2, 32); const int pq = p0 + 16 * fr + r0 + 4 * u; const size_t qrow = (size_t)(b * SEQ + pq);
        const float* ml = (const float*)(p.ws + WS_P1ML) + (qrow * 8 + h) * 2; const float m1 = ml[0], l1 = ml[1];
        const float m = fmaxf(mrun[u], m1); const float a2 = __builtin_amdgcn_exp2f(mrun[u] - m), a1 = __builtin_amdgcn_exp2f(m1 - m) * l1; const float rden = 1.0f / (l2 * a2 + a1);
        const bf16* o1p = (const bf16*)(p.ws + WS_P1O) + qrow * 512 + h * 64 + 4 * fq;
#pragma unroll
        for (int d = 0; d < 4; ++d) { const u32x2 ow = *(const u32x2*)(o1p + 16 * d); u32x2 w;
            w.x = pk2((O[u][d][0] * a2 + bflo(ow.x) * a1) * rden, (O[u][d][1] * a2 + bfhi(ow.x) * a1) * rden); w.y = pk2((O[u][d][2] * a2 + bflo(ow.y) * a1) * rden, (O[u][d][3] * a2 + bfhi(ow.y) * a1) * rden);
            *(u32x2*)(Yrow[u] + 16 * d + 4 * fq) = w; } }
}
__device__ __forceinline__ void attn_quad_d1(const Params& p, int b, int h, int L, int lane) {
    const int fr = lane & 15, fq = lane >> 4, fK = fr >> 2, jK = fr & 3;
    const f32x4 z4 = {0.f, 0.f, 0.f, 0.f};
    bf16x8 qf[4][2]; f32x4 O[4][4]; float mrun[4], lsum[4];
    const bf16* Kb = (const bf16*)(p.ws + WS_AK) + (ptrdiff_t)b * SEQ * 512 + h * 64 + 8 * fq;
    const bf16* Vb = (const bf16*)(p.ws + WS_VT16) + (ptrdiff_t)(b * 8 + h) * 131072 + fr * 4;
#pragma unroll
    for (int i = 0; i < 4; ++i) { const bf16* qrow = (const bf16*)(p.ws + WS_Y) + ((size_t)(b * SEQ + 16 * (L + i) + fr)) * 1024 + 512 + h * 64;
        qf[i][0] = *(const bf16x8*)(qrow + 8 * fq); qf[i][1] = *(const bf16x8*)(qrow + 32 + 8 * fq); mrun[i] = -1e30f; lsum[i] = 0.f;
#pragma unroll
        for (int d = 0; d < 4; ++d) O[i][d] = z4; }
    const bf16* kp = Kb + (ptrdiff_t)(16 * (L - 4 + jK) + fK) * 512;
    const bf16* vp = Vb + (ptrdiff_t)(fq * 32 + (L >> 2) - 1) * 256;
    for (int kb = 0; kb < 3; ++kb) { const int lb = L - 4 + 4 * kb; if ((unsigned)lb >= 128u) continue;
#pragma unroll
        for (int th = 0; th < 2; ++th) { const int t0 = 2 * th;
            const int D0 = 16 * (-4 + 4 * kb) + 4 * t0 + fq - fr + 64;
            const bf16* k0p = kp + (ptrdiff_t)(64 * kb + 4 * t0) * 512; const bf16* v0p = vp + (ptrdiff_t)(128 * t0 + kb) * 256;
            bf16x8 k00, k01, k10, k11; u32x2 v0[4], v1[4];
            KLD(k0p, k00, k01); KLD(k0p + 4 * 512, k10, k11); VLD(v0p, v0); VLD(v0p + 128 * 256, v1);
#pragma unroll
            for (int i = 0; i < 4; ++i) { attn_step<64>(O[i], mrun[i], lsum[i], qf[i], k00, k01, k10, k11, v0, v1, D0 - 16 * i, D0 - 16 * i + 4, true, true); if (i & 1) __builtin_amdgcn_sched_barrier(0); } }
    }
#pragma unroll
    for (int i = 0; i < 4; ++i) { float l = lsum[i]; l += __shfl_xor(l, 16); l += __shfl_xor(l, 32); const float rl = 1.0f / l; const size_t qrow = (size_t)(b * SEQ + 16 * (L + i) + fr);
        bf16* o1p = (bf16*)(p.ws + WS_P1O) + qrow * 512 + h * 64 + 4 * fq;
#pragma unroll
        for (int d = 0; d < 4; ++d) { u32x2 w; w.x = pk2(O[i][d][0] * rl, O[i][d][1] * rl); w.y = pk2(O[i][d][2] * rl, O[i][d][3] * rl); *(u32x2*)(o1p + 16 * d) = w; }
        if (fq == 0) { float* ml = (float*)(p.ws + WS_P1ML) + (qrow * 8 + h) * 2; ml[0] = mrun[i]; ml[1] = l; } }
}
constexpr int QS_OFF = 0, KS_OFF = 17408, PF_OFF = 34816, PB_OFF = 44032, FL_OFF = 53248, QPITCH = 272, PPITCH = 144;
__device__ __forceinline__ void mout_unit(const Params& p, int layer, int u, LAS unsigned char* lds, int tid, int wave, int lane) {
    const int b = u >> 7, hh = (u >> 5) & 3, pc = u & 31, tok0 = pc * 64;
    const int fr = lane & 15, fq = lane >> 4;
    LAS float* FL = (LAS float*)(lds + FL_OFF);
    const float* Gp = (const float*)(p.ws + WS_G) + (size_t)(b * SEQ + tok0) * 16;
    const float* Mst = (const float*)(p.ws + WS_MST); const float* Nst = (const float*)(p.ws + WS_N);
    const bf16* Ct = (const bf16*)p.out;
    const size_t sid0 = (size_t)((b * 4 + hh) * 2 + 0) * 32 + pc, sid1 = (size_t)((b * 4 + hh) * 2 + 1) * 32 + pc;
    bf16x8 vaf[2], caf[2][4];
    { const bf16* Vr = (const bf16*)(p.ws + WS_VTM) + ((size_t)((b * 4 + hh) * 128 + 16 * wave + fr)) * SEQ + tok0;
#pragma unroll
      for (int ks = 0; ks < 2; ++ks) vaf[ks] = *(const bf16x8*)(Vr + 32 * ks + 8 * fq);
#pragma unroll
      for (int d = 0; d < 2; ++d) { const bf16* Cr = Ct + (d ? sid1 : sid0) * 16384 + (size_t)(16 * wave + fr) * 128;
#pragma unroll
          for (int kk = 0; kk < 4; ++kk) caf[d][kk] = *(const bf16x8*)(Cr + 32 * kk + 8 * fq); } }
    if (wave < 2) {
        const int dir = wave; const float li = Gp[lane * 16 + dir * 4 + hh], lf = Gp[lane * 16 + 8 + dir * 4 + hh];
        const float pre = wave_incl_scan_dpp(lf); const float total = __int_as_float(__builtin_amdgcn_readlane(__float_as_int(pre), 63));
        const float bt = dir ? (total - pre + lf) : pre; const float uu = li - bt;
        float pm;
        if (dir == 0) pm = wave_incl_max_dpp(uu); else pm = __shfl(wave_incl_max_dpp(__shfl(uu, 63 - lane)), 63 - lane);
        const float mprev = Mst[dir ? sid1 : sid0]; const float a = bt + mprev; const float mt = fmaxf(a, bt + pm);
        FL[(0 + 2 * dir) * 64 + lane] = bt - mt; FL[(1 + 2 * dir) * 64 + lane] = uu; FL[(4 + dir) * 64 + lane] = __expf(a - mt); FL[(6 + dir) * 64 + lane] = __expf(-mt);
    }
    {
        const bf16* QKm = (const bf16*)(p.ws + WS_QKM); const float* cwl = p.conv_w + (size_t)layer * 5 * 1024;
#pragma unroll
        for (int it4 = 0; it4 < 4; ++it4) { const int it = tid + it4 * NTHR; const int mat = it >> 10, rem = it & 1023, tok = rem >> 4, dg = rem & 15; const int col = mat * 512 + hh * 128 + 8 * dg;
            float a8[8];
#pragma unroll
            for (int j = 0; j < 8; ++j) a8[j] = 0.f;
#pragma unroll
            for (int t = 0; t < 5; ++t) { const int tt = tok0 + tok + t - 2;
                if (tt >= 0 && tt < SEQ) { const u32x4 xx = *(const u32x4*)(QKm + (size_t)(b * SEQ + tt) * 1024 + col);
                    const f32x4 w0 = *(const f32x4*)(cwl + t * 1024 + col), w1 = *(const f32x4*)(cwl + t * 1024 + col + 4);
                    a8[0] = fmaf(w0[0], bflo(xx.x), a8[0]); a8[1] = fmaf(w0[1], bfhi(xx.x), a8[1]); a8[2] = fmaf(w0[2], bflo(xx.y), a8[2]); a8[3] = fmaf(w0[3], bfhi(xx.y), a8[3]);
                    a8[4] = fmaf(w1[0], bflo(xx.z), a8[4]); a8[5] = fmaf(w1[1], bfhi(xx.z), a8[5]); a8[6] = fmaf(w1[2], bflo(xx.w), a8[6]); a8[7] = fmaf(w1[3], bfhi(xx.w), a8[7]); } }
            const float sc = mat ? 0.08838834764831845f : 1.0f;
#pragma unroll
            for (int j = 0; j < 8; ++j) a8[j] = a8[j] * __builtin_amdgcn_rcpf(1.0f + __expf(-a8[j])) * sc;
            u32x4 w; w.x = pk2(a8[0], a8[1]); w.y = pk2(a8[2], a8[3]); w.z = pk2(a8[4], a8[5]); w.w = pk2(a8[6], a8[7]);
            *(LAS u32x4*)(lds + (mat ? KS_OFF : QS_OFF) + tok * QPITCH + dg * 16) = w; }
    }
    __syncthreads();
    if (wave < 2) {
        const float* np = Nst + (wave ? sid1 : sid0) * 128; float acc = 0.f;
#pragma unroll
        for (int dg = 0; dg < 16; ++dg) { const u32x4 xx = *(const LAS u32x4*)(lds + QS_OFF + lane * QPITCH + dg * 16); const f32x4 n0 = *(const f32x4*)(np + 8 * dg), n1 = *(const f32x4*)(np + 8 * dg + 4);
            acc += bflo(xx.x) * n0[0] + bfhi(xx.x) * n0[1] + bflo(xx.y) * n0[2] + bfhi(xx.y) * n0[3] + bflo(xx.z) * n1[0] + bfhi(xx.z) * n1[1] + bflo(xx.w) * n1[2] + bfhi(xx.w) * n1[3]; }
        FL[(16 + wave) * 64 + lane] = acc;
    }
    {
        const int st = wave >> 1, tt0 = 2 * (wave & 1); const f32x4 z4 = {0.f, 0.f, 0.f, 0.f};
        bf16x8 ka[4];
#pragma unroll
        for (int ks = 0; ks < 4; ++ks) ka[ks] = *(const LAS bf16x8*)(lds + KS_OFF + (16 * st + fr) * QPITCH + (32 * ks + 8 * fq) * 2);
#pragma unroll
        for (int q = 0; q < 2; ++q) { const int t = 16 * (tt0 + q) + fr; f32x4 s = z4;
#pragma unroll
            for (int ks = 0; ks < 4; ++ks) { const bf16x8 qb = *(const LAS bf16x8*)(lds + QS_OFF + t * QPITCH + (32 * ks + 8 * fq) * 2); s = MFMA16(ka[ks], qb, s); }
            const float cf = FL[0 * 64 + t], cb = FL[2 * 64 + t]; float pf[4], pb[4]; float rf = 0.f, rb = 0.f;
#pragma unroll
            for (int j = 0; j < 4; ++j) { const int si = 16 * st + 4 * fq + j; const float uf = FL[1 * 64 + si], ub = FL[3 * 64 + si];
                pf[j] = (si <= t) ? s[j] * __expf(cf + uf) : 0.f; pb[j] = (si >= t) ? s[j] * __expf(cb + ub) : 0.f; rf += pf[j]; rb += pb[j]; }
            u32x2 w; w.x = pk2(pf[0], pf[1]); w.y = pk2(pf[2], pf[3]); *(LAS u32x2*)(lds + PF_OFF + t * PPITCH + (16 * st + 4 * fq) * 2) = w;
            w.x = pk2(pb[0], pb[1]); w.y = pk2(pb[2], pb[3]); *(LAS u32x2*)(lds + PB_OFF + t * PPITCH + (16 * st + 4 * fq) * 2) = w;
            rf += __shfl_xor(rf, 16); rf += __shfl_xor(rf, 32); rb += __shfl_xor(rb, 16); rb += __shfl_xor(rb, 32);
            if (fq == 0) { FL[(8 + st) * 64 + t] = rf; FL[(12 + st) * 64 + t] = rb; } }
    }
    __syncthreads();
    f32x4 aI[2][4], aX[2][4];
    {
        const f32x4 z4 = {0.f, 0.f, 0.f, 0.f};
#pragma unroll
        for (int d = 0; d < 2; ++d)
#pragma unroll
            for (int tt = 0; tt < 4; ++tt) { aI[d][tt] = z4; aX[d][tt] = z4; }
#pragma unroll
        for (int ks = 0; ks < 2; ++ks) { const bf16x8 va = vaf[ks];
#pragma unroll
            for (int tt = 0; tt < 4; ++tt) { const bf16x8 pfb = *(const LAS bf16x8*)(lds + PF_OFF + (16 * tt + fr) * PPITCH + (32 * ks + 8 * fq) * 2);
                const bf16x8 pbb = *(const LAS bf16x8*)(lds + PB_OFF + (16 * tt + fr) * PPITCH + (32 * ks + 8 * fq) * 2);
                aI[0][tt] = MFMA16(va, pfb, aI[0][tt]); aI[1][tt] = MFMA16(va, pbb, aI[1][tt]); } }
#pragma unroll
        for (int d = 0; d < 2; ++d) {
#pragma unroll
            for (int kk = 0; kk < 4; ++kk) { const bf16x8 ca = caf[d][kk];
#pragma unroll
                for (int tt = 0; tt < 4; ++tt) { const bf16x8 qb = *(const LAS bf16x8*)(lds + QS_OFF + (16 * tt + fr) * QPITCH + (32 * kk + 8 * fq) * 2); aX[d][tt] = MFMA16(ca, qb, aX[d][tt]); } } }
    }
    f32x4 hs[4];
#pragma unroll
    for (int tt = 0; tt < 4; ++tt) { const int t = 16 * tt + fr; const f32x4 z4 = {0.f, 0.f, 0.f, 0.f}; hs[tt] = z4;
#pragma unroll
        for (int d = 0; d < 2; ++d) { const float in = FL[(4 + d) * 64 + t]; const float den = ((FL[(8 + 4 * d) * 64 + t] + FL[(9 + 4 * d) * 64 + t]) + (FL[(10 + 4 * d) * 64 + t] + FL[(11 + 4 * d) * 64 + t])) + in * FL[(16 + d) * 64 + t];
            const float rd = 1.0f / fmaxf(fabsf(den), FL[(6 + d) * 64 + t]); hs[tt] += (aI[d][tt] + aX[d][tt] * in) * rd; }
        float sq = (hs[tt][0] * hs[tt][0] + hs[tt][1] * hs[tt][1]) + (hs[tt][2] * hs[tt][2] + hs[tt][3] * hs[tt][3]);
        sq += __shfl_xor(sq, 16); sq += __shfl_xor(sq, 32);
        if (fq == 0) FL[(18 + wave) * 64 + t] = sq; }
    __syncthreads();
    {
        const f32x4 hg = *(const f32x4*)(p.head_norm_g + layer * 512 + hh * 128 + 16 * wave + 4 * fq);
#pragma unroll
        for (int tt = 0; tt < 4; ++tt) { const int t = 16 * tt + fr; const float ssq = ((FL[18 * 64 + t] + FL[19 * 64 + t]) + (FL[20 * 64 + t] + FL[21 * 64 + t])) + ((FL[22 * 64 + t] + FL[23 * 64 + t]) + (FL[24 * 64 + t] + FL[25 * 64 + t])); const float rsd = rsqrtf(ssq * (1.0f / 128.0f) + 1e-6f);
            bf16* yp = (bf16*)(p.ws + WS_Y) + (size_t)(b * SEQ + tok0 + t) * 1024 + hh * 128 + 16 * wave + 4 * fq;
            const u32x2 gt = *(const u32x2*)yp;
            u32x2 w; w.x = pk2(hs[tt][0] * rsd * hg[0] * bflo(gt.x), hs[tt][1] * rsd * hg[1] * bfhi(gt.x)); w.y = pk2(hs[tt][2] * rsd * hg[2] * bflo(gt.y), hs[tt][3] * rsd * hg[3] * bfhi(gt.y));
            *(u32x2*)yp = w; }
    }
    __syncthreads();
}

#define XB_TMO      128
#define XB_XCNT(j)  (256  + 64 * (j))
#define XB_XSUB(j)  (1280 + 64 * (j))
#define XB_XGEN(j)  (2304 + 64 * (j))
#define XB_TOP      3328
#define XB_TOPGEN   3392
#define XCD_BAR_WORDS 3456
#define XB_SPIN_CAP (1u << 18)

__device__ __forceinline__ unsigned xb_ld(unsigned* p)              { return __hip_atomic_load(p, __ATOMIC_RELAXED, __HIP_MEMORY_SCOPE_AGENT); }
__device__ __forceinline__ unsigned xb_add(unsigned* p, unsigned v) { return __hip_atomic_fetch_add(p, v, __ATOMIC_RELAXED, __HIP_MEMORY_SCOPE_AGENT); }
__device__ __forceinline__ unsigned xb_xcc_id() { return (unsigned)__builtin_amdgcn_s_getreg((3 << 11) | 20) & 0xFu; }
#define XB_SPIN(cond, bar) do { unsigned _sp = 0; while (cond) { __builtin_amdgcn_s_sleep(1); \
    if ((++_sp & 255u) == 0u) { if (xb_ld(&(bar)[XB_TMO])) break; if (_sp > XB_SPIN_CAP) { atomicAdd(&(bar)[XB_TMO], 1u); break; } } } } while (0)

struct XcdBarrier {
    unsigned* bar; unsigned x;
    volatile LAS unsigned* st;
};

__device__ __forceinline__ XcdBarrier xcd_barrier_post(unsigned* bar, volatile LAS unsigned* st) {
    XcdBarrier b; b.bar = bar; b.x = xb_xcc_id(); b.st = st;
    if (threadIdx.x == 0) (void)xb_add(&bar[XB_XCNT(b.x)], 1u);
    return b;
}
__device__ __forceinline__ void xcd_barrier_complete(unsigned* bar, unsigned x, unsigned& nloc, unsigned& nx) {
    const unsigned G = gridDim.x * gridDim.y * gridDim.z;
    unsigned sum, cnt, mine, sp = 0u;
    for (;;) {
        sum = 0u; cnt = 0u; mine = 0u;
#pragma unroll
        for (unsigned j = 0; j < 16; ++j) { const unsigned c = xb_ld(&bar[XB_XCNT(j)]); sum += c; cnt += (c > 0u) ? 1u : 0u; mine = (j == x) ? c : mine; }
        if (sum == G) break;
        __builtin_amdgcn_s_sleep(1);
        if ((++sp & 255u) == 0u) { if (xb_ld(&bar[XB_TMO])) break; if (sp > XB_SPIN_CAP) { atomicAdd(&bar[XB_TMO], 1u); break; } }
    }
    nloc = mine > 0u ? mine : 1u; nx = cnt > 0u ? cnt : 1u;
}

__device__ __forceinline__ void xcd_barrier(const XcdBarrier& b) {
    asm volatile("s_waitcnt vmcnt(0)" ::: "memory");
    __syncthreads();
    if (threadIdx.x == 0) {
        unsigned* bar = b.bar;
        __builtin_amdgcn_s_waitcnt(0);
        unsigned nloc = b.st[0], nx = b.st[1];
        if (nloc == 0u) { xcd_barrier_complete(bar, b.x, nloc, nx); b.st[0] = nloc; b.st[1] = nx; }
        const unsigned old = xb_add(&bar[XB_XSUB(b.x)], 1u);
        const unsigned gen = old / nloc;
        if (old + 1u == (gen + 1u) * nloc) {
            __builtin_amdgcn_fence(__ATOMIC_RELEASE, "agent");
            asm volatile("s_waitcnt vmcnt(0)" ::: "memory");
            const unsigned og = xb_add(&bar[XB_TOP], 1u);
            const unsigned tg = og / nx;
            if (og + 1u == (tg + 1u) * nx) xb_add(&bar[XB_TOPGEN], 1u);
            else XB_SPIN(xb_ld(&bar[XB_TOPGEN]) == tg, bar);
            __builtin_amdgcn_fence(__ATOMIC_ACQUIRE, "agent");
            xb_add(&bar[XB_XGEN(b.x)], 1u);
            asm volatile("s_waitcnt vmcnt(0)" ::: "memory");
        } else {
            XB_SPIN(xb_ld(&bar[XB_XGEN(b.x)]) == gen, bar);
            __builtin_amdgcn_fence(__ATOMIC_ACQUIRE, "agent");
            asm volatile("s_waitcnt vmcnt(0)" ::: "memory");
        }
    }
    __syncthreads();
}

__global__ void __launch_bounds__(NTHR, 2) fwd_megakernel(Params p) {
    extern __shared__ __attribute__((aligned(16))) unsigned char lds_raw[];
    LAS unsigned char* lds = (LAS unsigned char*)lds_raw;
    cg::grid_group grid = cg::this_grid();
#define GRID_SYNC_CG() do { asm volatile("s_waitcnt vmcnt(0) lgkmcnt(0)" ::: "memory"); grid.sync(); \
        __builtin_amdgcn_fence(__ATOMIC_ACQUIRE, "agent"); asm volatile("s_waitcnt vmcnt(0)" ::: "memory"); __syncthreads(); } while (0)
#define GRID_SYNC() do { XcdBarrier xb_; xb_.bar = (unsigned*)(p.ws + WS_CTL); xb_.x = xb_xcc_id(); xb_.st = (volatile LAS unsigned*)(lds + LDS_MISC); xcd_barrier(xb_); } while (0)
    const int tid = threadIdx.x, lane = tid & 63, wave = __builtin_amdgcn_readfirstlane(tid >> 6), G = gridDim.x, bid = blockIdx.x;
    const int vcu = (G % 8 == 0) ? (bid % 8) * (G / 8) + bid / 8 : bid;
    float* ss = (float*)(p.ws + WS_SSP);
    { volatile LAS unsigned* st0 = (volatile LAS unsigned*)(lds + LDS_MISC); if (threadIdx.x < 2) st0[threadIdx.x] = 0u; __syncthreads(); }
    (void)xcd_barrier_post((unsigned*)(p.ws + WS_CTL), (volatile LAS unsigned*)(lds + LDS_MISC));
    bf16* xb = (bf16*)(p.ws + WS_XB);

    const bool defer = (G == 256);
    p0_prologue(p, lds, wave, lane, G, defer ? -1 : 2 * I_L);
    if (G == 0x7fffffff) GRID_SYNC_CG();
    GRID_SYNC();

    for (int layer = 0; layer < 2; ++layer) {
#define RELANE() int tid = threadIdx.x; asm volatile("" : "+v"(tid)); const int lane = tid & 63, wave = __builtin_amdgcn_readfirstlane(tid >> 6)
        {
            pg8::Gemm g{xb, (const bf16*)(p.ws + WS_WIN) + (size_t)layer * NINP * DM, MROWS, NINP, DM};
            pg8::StaticOrder S; S.init(MROWS, NINP, G, bid);
            pg8::EpiIn E{ss + (size_t)(2 * layer) * MROWS * 16, p.ws, p.gate_i_b + layer * 8, p.gate_f_b + layer * 8};
            static_assert(pg8::EpiIn::O_ROPE == WS_ROPE && pg8::EpiIn::O_G == WS_G && pg8::EpiIn::O_QKM == WS_QKM && pg8::EpiIn::O_KTM == WS_KTM && pg8::EpiIn::O_VTM == WS_VTM && pg8::EpiIn::O_AK == WS_AK && pg8::EpiIn::O_VT16 == WS_VT16 && pg8::EpiIn::O_Y == WS_Y, "ws map");
            pg8::gemm_phase<pg8::EpiIn, pg8::StaticOrder, true, true>(lds, g, S, E);
            if (defer && bid >= 192) { RELANE(); LAS float* scr = (LAS float*)(lds + wave * 16384);
                for (int it = layer * I_L + I_IN + I_OUT + (bid - 192) * NWAVE + wave; it < (layer + 1) * I_L; it += 64 * NWAVE) convert_item(p, it, scr, lane); }
        }
        GRID_SYNC();
        {
            RELANE();
            volatile LAS unsigned* ctr = (volatile LAS unsigned*)(lds + LDS_MISC + 16);
            if (tid == 0) *ctr = 0u;
            const int nU = (512 - vcu + G - 1) / G;
            const bool fast = (G * 2 == 512);
            if (fast && wave < 2) {
                __builtin_amdgcn_s_setprio(3);
                scan_wave(p, layer, vcu * 2 + wave, (LAS float*)(lds + wave * 256), lane, true);
                __builtin_amdgcn_s_setprio(0);
            } else {
                const int w0 = fast ? 2 : 0, nw = fast ? 6 : NWAVE;
                for (int I = wave - w0; I < 4 * nU; I += nw) { const int au = vcu + G * (I >> 2); const int b = au >> 6, h = (au >> 3) & 7, p0 = (au & 7) * 256;
                    attn_quad_d1(p, b, h, (p0 >> 4) + 4 * (I & 3), lane); }
                asm volatile("s_waitcnt vmcnt(0)" ::: "memory");
                __syncthreads();
                if (!fast && wave < 2) for (int sw = vcu * 2 + wave; sw < 512; sw += G * 2) scan_wave(p, layer, sw, (LAS float*)(lds + wave * 256), lane, false);
            }
            {
                const int nQ = 8 * nU;
                for (;;) { unsigned Q = 0; if (lane == 0) Q = atomicAdd((unsigned*)(lds_raw + LDS_MISC + 16), 1u); Q = (unsigned)__builtin_amdgcn_readfirstlane((int)Q);
                    if ((int)Q >= nQ) break;
                    const int au = vcu + G * (int)(Q >> 3); const int b = au >> 6, h = (au >> 3) & 7, p0 = (au & 7) * 256; attn_pair(p, b, h, p0, (int)((Q & 3) + 8 * ((Q >> 2) & 1)), lane); }
            }
        }
        GRID_SYNC();
        { RELANE(); for (int u = vcu; u < 1024; u += G) mout_unit(p, layer, u, lds, tid, wave, lane); }
        GRID_SYNC();
        {
            pg8::Gemm g{(const bf16*)(p.ws + WS_Y), (const bf16*)(p.ws + WS_WOUT) + (size_t)layer * DM * DM, MROWS, DM, DM};
            pg8::StaticOrder S; S.init(MROWS, DM, G, bid);
            pg8::EpiRes E{xb, ss + (size_t)(2 * layer + 1) * MROWS * 16};
            pg8::gemm_phase<pg8::EpiRes, pg8::StaticOrder, true, true>(lds, g, S, E);
        }
        GRID_SYNC();
        {
            pg8::Gemm g{xb, (const bf16*)(p.ws + WS_WUP) + (size_t)layer * FF * DM, MROWS, FF, DM};
            pg8::StaticOrder S; S.init(MROWS, FF, G, bid);
            pg8::EpiUp E{ss + (size_t)(2 * layer + 1) * MROWS * 16, (bf16*)(p.ws + WS_U)};
            pg8::gemm_phase<pg8::EpiUp, pg8::StaticOrder, true, true>(lds, g, S, E);
        }
        GRID_SYNC();
        {
            pg8::Gemm g{(const bf16*)(p.ws + WS_U), (const bf16*)(p.ws + WS_WDN) + (size_t)layer * DM * FF, MROWS, DM, FF};
            pg8::StaticOrder S; S.init(MROWS, DM, G, bid);
            pg8::EpiRes E{xb, ss + (size_t)(2 * layer + 2) * MROWS * 16};
            pg8::gemm_phase<pg8::EpiRes, pg8::StaticOrder, true, true>(lds, g, S, E);
        }
        GRID_SYNC();
    }
    {
        RELANE();
        const int gw = bid * NWAVE + wave, NGW = G * NWAVE;
        for (int m = gw; m < MROWS; m += NGW) { const float rsd = rsqrtf(pg8::row_ss(ss + (size_t)4 * MROWS * 16, m) * (1.0f / 1024.0f) + 1e-6f);
            const u32x2* xr = (const u32x2*)(xb + (size_t)m * DM) + lane; f32x4* orow = (f32x4*)(p.out + (size_t)m * DM) + lane; const f32x4* gr = (const f32x4*)p.final_g + lane;
#pragma unroll
            for (int j = 0; j < 4; ++j) { const u32x2 w = xr[64 * j]; const f32x4 g4 = gr[64 * j]; f32x4 o; o[0] = bflo(w.x) * rsd * g4[0]; o[1] = bfhi(w.x) * rsd * g4[1]; o[2] = bflo(w.y) * rsd * g4[2]; o[3] = bfhi(w.y) * rsd * g4[3]; orow[64 * j] = o; } }
    }
}

extern "C" void kernel_launch(void* const* d_in, const int* in_sizes, int n_in, void* d_out, int out_size, void* d_ws, size_t ws_size, hipStream_t stream) {
    static int grid = 0;
    if (grid == 0) {
        int dev = 0, cus = 0, per_cu = 0;
        (void)hipGetDevice(&dev);
        (void)hipDeviceGetAttribute(&cus, hipDeviceAttributeMultiprocessorCount, dev);
        (void)hipFuncSetAttribute((const void*)fwd_megakernel, hipFuncAttributeMaxDynamicSharedMemorySize, LDS_BYTES);
        (void)hipOccupancyMaxActiveBlocksPerMultiprocessor(&per_cu, (const void*)fwd_megakernel, NTHR, LDS_BYTES);
        if (per_cu < 1) per_cu = 1;
        grid = cus * per_cu;
        if (ws_size < WS_END) { fprintf(stderr, "kernel_launch: workspace too small (%zu)\n", ws_size); grid = -1; }
    }
    if (grid < 0) return;
    Params p{};
    p.x = (const float*)d_in[0]; p.norm1_g = (const float*)d_in[1]; p.w_in = (const float*)d_in[2]; p.conv_w = (const float*)d_in[3];
    p.gate_i_b = (const float*)d_in[4]; p.gate_f_b = (const float*)d_in[5]; p.head_norm_g = (const float*)d_in[6]; p.w_out = (const float*)d_in[7];
    p.norm2_g = (const float*)d_in[8]; p.w_up = (const float*)d_in[9]; p.w_down = (const float*)d_in[10]; p.final_g = (const float*)d_in[11];
    p.out = (float*)d_out; p.ws = (unsigned char*)d_ws;
    (void)hipMemsetAsync((char*)d_ws + WS_CTL, 0, CTL_BYTES, stream);
    void* args[] = {&p};
    hipError_t e = hipLaunchCooperativeKernel((void*)fwd_megakernel, dim3(grid), dim3(NTHR), args, LDS_BYTES, stream);
    if (e != hipSuccess) fprintf(stderr, "cooperative launch failed: %s (grid %d)\n", hipGetErrorString(e), grid);
}
```

```cpp
#include <hip/hip_runtime.h>
#include <hip/hip_cooperative_groups.h>
#include <cstdio>
#include <cstdint>
#include <cmath>
namespace cg = cooperative_groups;
namespace pg8 {
#define PG8_LAS __attribute__((address_space(3)))
typedef unsigned short bf16_t;
typedef short bf16x8 __attribute__((ext_vector_type(8)));
typedef float f32x4 __attribute__((ext_vector_type(4)));
typedef unsigned u32x4 __attribute__((ext_vector_type(4)));
constexpr int BM = 256, BK = 64, HALF = 128, HTB = HALF * BK * 2  , STAGE_BYTES = 8 * HTB, NXCD = 8, WGM = 4;

__host__ __device__ __forceinline__ int lds_byte(int r, int c) { const int st = (r >> 4) * 2 + (c >> 5), rr = r & 15, cc = c & 31, ob = rr * 64 + cc * 2; return st * 1024 + (ob ^ (((ob >> 9) & 1) << 5)); }
__host__ __device__ __forceinline__ void stage_rc(int b, int& R, int& C) { const int st = b / 1024, sb = b % 1024, swz = sb ^ (((sb >> 9) & 1) << 5); R = (st >> 1) * 16 + swz / 64; C = (st & 1) * 32 + (swz % 64) / 2; }
__host__ __device__ __forceinline__ int perm32(int rho) { const int n = rho >> 4, i = rho & 15; return 8 * (i >> 2) + 4 * n + (i & 3); }

struct Unit { int pm, pn; };
struct Gemm { const bf16_t* A; const bf16_t* Bt; int M, N, K; };

struct StaticOrder {
    int nM, nN, nwg, G, c;
    __host__ __device__ void init(int M, int N, int G_, int c_) { nM = M / BM; nN = N / BM; nwg = nM * nN; G = G_; c = c_; }
    __host__ __device__ bool next(int i, Unit& u) const {
        const long L = (long)i * G + c; if (L >= nwg) return false;
        int wgid = (int)L; { const int q = nwg / NXCD, r = nwg % NXCD, xcd = wgid % NXCD, off = wgid / NXCD; wgid = (xcd < r ? xcd * (q + 1) : r * (q + 1) + (xcd - r) * q) + off; }
        const int nig = WGM * nN, gid = wgid / nig, fm = gid * WGM, gsz = (nM - fm) < WGM ? (nM - fm) : WGM;
        u.pm = fm + ((wgid % nig) % gsz); u.pn = (wgid % nig) / gsz; return true;
    }
    __device__ __forceinline__ void a_ready(const Unit&) const {}
    __device__ __forceinline__ void done(const Unit&) const {}
};

typedef float f32x2c_t __attribute__((ext_vector_type(2))); typedef __bf16 bf16x2c_t __attribute__((ext_vector_type(2)));
__device__ __forceinline__ unsigned cvt_pk_bf16(float lo, float hi) { f32x2c_t v = {lo, hi}; bf16x2c_t b = __builtin_convertvector(v, bf16x2c_t); return __builtin_bit_cast(unsigned, b); }
typedef float f32x2 __attribute__((ext_vector_type(2)));
__device__ __forceinline__ unsigned short bf16_1(float v) { return (unsigned short)(cvt_pk_bf16(v, v) & 0xffffu); }
__device__ __forceinline__ float row_ss(const float* ssp, int row) { const f32x4* q = (const f32x4*)(ssp + (size_t)row * 16); const f32x4 a = q[0], b = q[1], c = q[2], d = q[3];
    return (((a[0] + a[1]) + (a[2] + a[3])) + ((b[0] + b[1]) + (b[2] + b[3]))) + (((c[0] + c[1]) + (c[2] + c[3])) + ((d[0] + d[1]) + (d[2] + d[3]))); }
__device__ __forceinline__ float row_ss_q(const float* ssp, int row, int fq) { const f32x4 a = *(const f32x4*)(ssp + (size_t)row * 16 + 4 * fq); float t = (a[0] + a[1]) + (a[2] + a[3]);
    t += __shfl_xor(t, 16); t += __shfl_xor(t, 32); return t; }
struct EpiIn {
    static constexpr bool PERM = true, AFTER_DRAIN = false;
    const float* ss; unsigned char* ws; const float* gib; const float* gfb;
    static constexpr size_t O_ROPE = 512 * 1024, O_G = 3u << 20, O_QKM = 120u << 20, O_KTM = 152u << 20, O_VTM = 168u << 20, O_AK = 184u << 20, O_VT16 = 200u << 20, O_Y = 216u << 20;
    __device__ __forceinline__ void operator()(const f32x4 (&acc)[2][2][4][2], const Unit& u, int wr, int wc, int fr_, int fq_) const {
        int fr = fr_, fq = fq_; asm volatile("" : "+v"(fr), "+v"(fq));
        const int pn = u.pn;
        const int rbase = u.pm * BM + wr * 64 + fr;
        float rsv[2][4];
#pragma unroll
        for (int ai = 0; ai < 2; ++ai)
#pragma unroll
            for (int m = 0; m < 4; ++m) rsv[ai][m] = row_ss_q(ss, rbase + ai * HALF + m * 16, fq);
#pragma unroll
        for (int ai = 0; ai < 2; ++ai)
#pragma unroll
            for (int m = 0; m < 4; ++m) rsv[ai][m] = rsqrtf(rsv[ai][m] * (1.0f / 1024.0f) + 1e-6f);
        if (pn < 4) {
            bf16_t* QKm = (bf16_t*)(ws + O_QKM);
#pragma unroll
            for (int ai = 0; ai < 2; ++ai)
#pragma unroll
                for (int m = 0; m < 4; ++m) { const int row = rbase + ai * HALF + m * 16; const float r = rsv[ai][m]; bf16_t* rowp = QKm + (size_t)row * 1024 + pn * 256 + wc * 32 + 8 * fq;
#pragma unroll
                    for (int bj = 0; bj < 2; ++bj) { const f32x4 v0 = acc[ai][bj][m][0] * r, v1 = acc[ai][bj][m][1] * r; u32x4 w;
                        w.x = cvt_pk_bf16(v0[0], v0[1]); w.y = cvt_pk_bf16(v0[2], v0[3]); w.z = cvt_pk_bf16(v1[0], v1[1]); w.w = cvt_pk_bf16(v1[2], v1[3]);
                        *(u32x4*)(rowp + bj * HALF) = w; }
                    asm volatile("" ::: "memory"); }
        }
        if ((pn >= 2 && pn < 6)) {
            const int row0 = u.pm * BM; const int b = row0 >> 11;
            unsigned char* ub = ws + ((pn < 4) ? O_KTM : O_VTM) + ((size_t)(((b * 4 + 2 * (pn & 1)) * 128 + wc * 32) * 2048 + (row0 & 2047) + wr * 64)) * 2;
            const unsigned voff = (unsigned)((8 * fq) * 2048 + fr) * 2u;
#pragma unroll
            for (int ai = 0; ai < 2; ++ai)
#pragma unroll
                for (int m = 0; m < 4; m += 2) { const float r0 = rsv[ai][m], r1 = rsv[ai][m + 1];
#pragma unroll
                    for (int bj = 0; bj < 2; ++bj)
#pragma unroll
                        for (int n = 0; n < 2; ++n)
#pragma unroll
                            for (int j = 0; j < 4; ++j) { const unsigned w = cvt_pk_bf16(acc[ai][bj][m][n][j] * r0, acc[ai][bj][m + 1][n][j] * r1);
                                unsigned char* q = ub + (size_t)(((bj * 128 + 4 * n + j) * 2048 + ai * HALF + m * 16) * 2) + voff;
                                *(bf16_t*)q = (bf16_t)(w & 0xffffu); *(bf16_t*)(q + 32) = (bf16_t)(w >> 16); }
                    asm volatile("" ::: "memory"); }
        } else if (pn == 6 || pn == 7) {
            bf16_t* Y = (bf16_t*)(ws + O_Y);
#pragma unroll
            for (int ai = 0; ai < 2; ++ai)
#pragma unroll
                for (int m = 0; m < 4; ++m) { const int row = rbase + ai * HALF + m * 16; const float r = rsv[ai][m]; bf16_t* rowp = Y + (size_t)row * 1024 + (pn - 6) * 256 + wc * 32 + 8 * fq;
#pragma unroll
                    for (int bj = 0; bj < 2; ++bj) { f32x4 v0 = acc[ai][bj][m][0] * r, v1 = acc[ai][bj][m][1] * r;
#pragma unroll
                        for (int j = 0; j < 4; ++j) { v0[j] = __builtin_amdgcn_rcpf(1.0f + __expf(-v0[j])); v1[j] = __builtin_amdgcn_rcpf(1.0f + __expf(-v1[j])); }
                        u32x4 w; w.x = cvt_pk_bf16(v0[0], v0[1]); w.y = cvt_pk_bf16(v0[2], v0[3]); w.z = cvt_pk_bf16(v1[0], v1[1]); w.w = cvt_pk_bf16(v1[2], v1[3]);
                        *(u32x4*)(rowp + bj * HALF) = w; }
                    asm volatile("" ::: "memory"); }
        } else if (pn >= 8 && pn < 12) {
            const bool isk = pn >= 10; const int head = 4 * (pn & 1) + wc; const float qs = isk ? 1.0f : 0.125f * 1.4426950408889634f;
            const float* ropeC = (const float*)(ws + O_ROPE) + 8 * fq; const float* ropeS = ropeC + 2048 * 32;
            f32x4 tb[2][4];
            { const int pos = rbase & 2047; tb[0][0] = *(const f32x4*)(ropeC + pos * 32); tb[0][1] = *(const f32x4*)(ropeC + pos * 32 + 4); tb[0][2] = *(const f32x4*)(ropeS + pos * 32); tb[0][3] = *(const f32x4*)(ropeS + pos * 32 + 4); }
#pragma unroll
            for (int it = 0; it < 8; ++it) { const int ai = it >> 2, m = it & 3; const int row = rbase + ai * HALF + m * 16; const float r = rsv[ai][m] * qs;
                if (it < 7) { const int pos2 = (rbase + ((it + 1) >> 2) * HALF + ((it + 1) & 3) * 16) & 2047;
                    tb[(it + 1) & 1][0] = *(const f32x4*)(ropeC + pos2 * 32); tb[(it + 1) & 1][1] = *(const f32x4*)(ropeC + pos2 * 32 + 4); tb[(it + 1) & 1][2] = *(const f32x4*)(ropeS + pos2 * 32); tb[(it + 1) & 1][3] = *(const f32x4*)(ropeS + pos2 * 32 + 4); }
                const f32x4 c0 = tb[it & 1][0], c1 = tb[it & 1][1], s0 = tb[it & 1][2], s1 = tb[it & 1][3];
                const f32x4 a0 = acc[ai][0][m][0] * r, a1 = acc[ai][0][m][1] * r, b0 = acc[ai][1][m][0] * r, b1 = acc[ai][1][m][1] * r;
                const f32x4 o10 = a0 * c0 - b0 * s0, o11 = a1 * c1 - b1 * s1, o20 = a0 * s0 + b0 * c0, o21 = a1 * s1 + b1 * c1;
                bf16_t* dst = isk ? ((bf16_t*)(ws + O_AK) + (size_t)row * 512 + head * 64 + 8 * fq) : ((bf16_t*)(ws + O_Y) + (size_t)row * 1024 + 512 + head * 64 + 8 * fq);
                u32x4 w; w.x = cvt_pk_bf16(o10[0], o10[1]); w.y = cvt_pk_bf16(o10[2], o10[3]); w.z = cvt_pk_bf16(o11[0], o11[1]); w.w = cvt_pk_bf16(o11[2], o11[3]);
                *(u32x4*)(dst) = w;
                w.x = cvt_pk_bf16(o20[0], o20[1]); w.y = cvt_pk_bf16(o20[2], o20[3]); w.z = cvt_pk_bf16(o21[0], o21[1]); w.w = cvt_pk_bf16(o21[2], o21[3]);
                *(u32x4*)(dst + 32) = w;
                asm volatile("" ::: "memory"); }
        } else if (pn == 12 || pn == 13) {
            const int row0 = u.pm * BM; const int b = row0 >> 11;
            typedef unsigned u32x2v __attribute__((ext_vector_type(2)));
            unsigned char* ub = ws + O_VT16 + ((size_t)((((b * 8 + 4 * (pn - 12) + (wc >> 1)) * 16 * 32 + ((row0 & 2047) >> 6) + wr) * 256) + (wc & 1) * 128)) * 2;
            const unsigned voff = (unsigned)(fr * 32 * 256 + 8 * fq * 4) * 2u;
#pragma unroll
            for (int ai = 0; ai < 2; ++ai) { const float r0 = rsv[ai][0], r1 = rsv[ai][1], r2 = rsv[ai][2], r3 = rsv[ai][3];
#pragma unroll
                for (int bj = 0; bj < 2; ++bj)
#pragma unroll
                    for (int n = 0; n < 2; ++n)
#pragma unroll
                        for (int j = 0; j < 4; ++j) { u32x2v w; w.x = cvt_pk_bf16(acc[ai][bj][0][n][j] * r0, acc[ai][bj][1][n][j] * r1); w.y = cvt_pk_bf16(acc[ai][bj][2][n][j] * r2, acc[ai][bj][3][n][j] * r3);
                            *(u32x2v*)(ub + (size_t)((bj * 262144 + 2 * ai * 256 + (4 * n + j) * 4) * 2) + voff) = w; }
                asm volatile("" ::: "memory"); }
        } else if (pn == 14) {
            if (wc == 0 && fq < 2) {
                float* G = (float*)(ws + O_G);
#pragma unroll
                for (int ai = 0; ai < 2; ++ai)
#pragma unroll
                    for (int m = 0; m < 4; ++m) { const int row = rbase + ai * HALF + m * 16; const float r = rsv[ai][m];
#pragma unroll
                        for (int n = 0; n < 2; ++n) { f32x4 v = acc[ai][0][m][n] * r; f32x4 o;
#pragma unroll
                            for (int j = 0; j < 4; ++j) { const int c8 = 4 * n + j;
                                if (fq == 0) o[j] = v[j] + gib[c8];
                                else { const float x = v[j] + gfb[c8]; o[j] = fminf(x, 0.0f) - __logf(1.0f + __expf(-fabsf(x))); } }
                            *(f32x4*)(G + (size_t)row * 16 + 8 * fq + 4 * n) = o; }
                        asm volatile("" ::: "memory"); }
            }
        }
    }
};
struct EpiRes {
    static constexpr bool PERM = true, AFTER_DRAIN = false;
    bf16_t* xb; float* ssn;
    __device__ __forceinline__ void operator()(const f32x4 (&acc)[2][2][4][2], const Unit& u, int wr, int wc, int fr, int fq) const {
        const int col0 = u.pn * BM + wc * 32 + 8 * fq;
#pragma unroll
        for (int ai = 0; ai < 2; ++ai)
#pragma unroll
            for (int m = 0; m < 4; ++m) { const int row = u.pm * BM + ai * HALF + wr * 64 + m * 16 + fr; bf16_t* rp = xb + (size_t)row * 1024 + col0; float sq = 0.f;
#pragma unroll
                for (int bj = 0; bj < 2; ++bj) { const u32x4 b = *(const u32x4*)(rp + bj * HALF);
                    const f32x4 v0 = acc[ai][bj][m][0], v1 = acc[ai][bj][m][1];
                    const float o0 = __uint_as_float(b.x << 16) + v0[0], o1 = __uint_as_float(b.x & 0xffff0000u) + v0[1], o2 = __uint_as_float(b.y << 16) + v0[2], o3 = __uint_as_float(b.y & 0xffff0000u) + v0[3];
                    const float o4 = __uint_as_float(b.z << 16) + v1[0], o5 = __uint_as_float(b.z & 0xffff0000u) + v1[1], o6 = __uint_as_float(b.w << 16) + v1[2], o7 = __uint_as_float(b.w & 0xffff0000u) + v1[3];
                    u32x4 w; w.x = cvt_pk_bf16(o0, o1); w.y = cvt_pk_bf16(o2, o3); w.z = cvt_pk_bf16(o4, o5); w.w = cvt_pk_bf16(o6, o7);
                    *(u32x4*)(rp + bj * HALF) = w;
                    sq += ((o0 * o0 + o1 * o1) + (o2 * o2 + o3 * o3)) + ((o4 * o4 + o5 * o5) + (o6 * o6 + o7 * o7)); }
                sq += __shfl_xor(sq, 16); sq += __shfl_xor(sq, 32);
                if (fq == 0) ssn[(size_t)row * 16 + u.pn * 4 + wc] = sq; }
    }
};
struct EpiUp {
    static constexpr bool PERM = true, AFTER_DRAIN = false;
    const float* ss; bf16_t* U;
    __device__ __forceinline__ void operator()(const f32x4 (&acc)[2][2][4][2], const Unit& u, int wr, int wc, int fr, int fq) const {
        const int rbase = u.pm * BM + wr * 64 + fr;
        float rsv[2][4];
#pragma unroll
        for (int ai = 0; ai < 2; ++ai)
#pragma unroll
            for (int m = 0; m < 4; ++m) rsv[ai][m] = row_ss_q(ss, rbase + ai * HALF + m * 16, fq);
#pragma unroll
        for (int ai = 0; ai < 2; ++ai)
#pragma unroll
            for (int m = 0; m < 4; ++m) { const int row = rbase + ai * HALF + m * 16; const float r = rsqrtf(rsv[ai][m] * (1.0f / 1024.0f) + 1e-6f);
                bf16_t* rowp = U + (size_t)row * 4096 + u.pn * BM + wc * 32 + 8 * fq;
#pragma unroll
                for (int bj = 0; bj < 2; ++bj) { f32x4 v0 = acc[ai][bj][m][0] * r, v1 = acc[ai][bj][m][1] * r;
#pragma unroll
                    for (int j = 0; j < 4; ++j) { v0[j] = fmaxf(v0[j], 0.f); v0[j] *= v0[j]; v1[j] = fmaxf(v1[j], 0.f); v1[j] *= v1[j]; }
                    u32x4 w; w.x = cvt_pk_bf16(v0[0], v0[1]); w.y = cvt_pk_bf16(v0[2], v0[3]); w.z = cvt_pk_bf16(v1[0], v1[1]); w.w = cvt_pk_bf16(v1[2], v1[3]);
                    *(u32x4*)(rowp + bj * HALF) = w; } }
    }
};
template <class Epi, class Sched, bool ALIGN_EPI = false, bool SP2 = false>
__device__ __forceinline__ void gemm_phase(PG8_LAS unsigned char* lds, const Gemm g, const Sched& S, const Epi& E) {
    int tid_ = threadIdx.x; asm volatile("" : "+v"(tid_));
    const int tid = tid_, wid = __builtin_amdgcn_readfirstlane(tid >> 6), lane = tid & 63, wr = wid >> 2, wc = wid & 3, fr = lane & 15, fq = lane >> 4;
    const int K = g.K, nt = K / BK;
    unsigned voffA[2], voffB[2];
#pragma unroll
    for (int i = 0; i < 2; ++i) { int R, C; stage_rc(tid * 16 + i * 8192, R, C); const int Rb = Epi::PERM ? ((R & ~31) + perm32(R & 31)) : R;
        voffA[i] = (unsigned)(R * K + C) * 2u; voffB[i] = (unsigned)(Rb * K + C) * 2u; }
    const size_t kstep = (size_t)(BK * 2);
    const size_t hstep = (size_t)HALF * K * 2;
    const size_t tstep = 2 * hstep;
    const unsigned ldsw = (unsigned)wid * 1024u;
    const int aoff = lds_byte(wr * 64 + fr, fq * 8), boff = lds_byte(wc * 32 + fr, fq * 8);
#define PG8_SA(b, h) (((b) * 2 + (h)) * HTB)
#define PG8_SB(b, h) ((4 + (b) * 2 + (h)) * HTB)
#define PG8_STAGE(bufoff, gbase, voff) do { _Pragma("unroll") for (int _i = 0; _i < 2; ++_i) \
        __builtin_amdgcn_global_load_lds((const unsigned*)((const char*)(gbase) + (voff)[_i]), (PG8_LAS unsigned*)(lds + (bufoff) + ldsw + _i * 8192), 16, 0, 0); } while (0)
#define PG8_LDA(dst, b, h) do { _Pragma("unroll") for (int m = 0; m < 4; ++m) _Pragma("unroll") for (int k = 0; k < 2; ++k) dst[m][k] = *(const PG8_LAS bf16x8*)(lds + PG8_SA(b, h) + aoff + m * 2048 + k * 1024); } while (0)
#define PG8_LDB(dst, b, h) do { _Pragma("unroll") for (int n = 0; n < 2; ++n) _Pragma("unroll") for (int k = 0; k < 2; ++k) dst[n][k] = *(const PG8_LAS bf16x8*)(lds + PG8_SB(b, h) + boff + n * 2048 + k * 1024); } while (0)
#define PG8_MMA(ai, bj, At, Bt) do { __builtin_amdgcn_s_setprio(1); _Pragma("unroll") for (int m = 0; m < 4; ++m) _Pragma("unroll") for (int n = 0; n < 2; ++n) _Pragma("unroll") for (int k = 0; k < 2; ++k) \
        acc[ai][bj][m][n] = __builtin_amdgcn_mfma_f32_16x16x32_bf16(Bt[n][k], At[m][k], acc[ai][bj][m][n], 0, 0, 0); __builtin_amdgcn_s_setprio(0); } while (0)
#define PG8_WAIT_V(n) asm volatile("s_waitcnt vmcnt(" #n ")" ::: "memory")
#define PG8_WAIT_L(n) asm volatile("s_waitcnt lgkmcnt(" #n ")" ::: "memory")
#define PG8_BAR __builtin_amdgcn_s_barrier()
#define PG8_SCHED __builtin_amdgcn_sched_barrier(0)
    Unit cur, nxt; int ui = 0;
    if (!S.next(0, cur)) return;
    f32x4 acc[2][2][4][2];
#pragma unroll
    for (int a = 0; a < 2; ++a)
#pragma unroll
        for (int b = 0; b < 2; ++b)
#pragma unroll
            for (int m = 0; m < 4; ++m)
#pragma unroll
                for (int n = 0; n < 2; ++n) acc[a][b][m][n] = (f32x4){0.f, 0.f, 0.f, 0.f};
    bf16x8 At[4][2], B0[2][2], B1[2][2];
    const char* cA = (const char*)g.A + (size_t)cur.pm * tstep; const char* cB = (const char*)g.Bt + (size_t)cur.pn * tstep;
    S.a_ready(cur);
    if constexpr (SP2) {
        PG8_STAGE(PG8_SB(0, 0), cB, voffB); PG8_STAGE(PG8_SB(0, 1), cB + hstep, voffB); PG8_STAGE(PG8_SA(0, 0), cA, voffA); PG8_STAGE(PG8_SA(0, 1), cA + hstep, voffA);
        if (wr == 1) PG8_BAR;
        PG8_WAIT_V(2); PG8_BAR;
        PG8_STAGE(PG8_SB(1, 0), cB + kstep, voffB); PG8_STAGE(PG8_SA(1, 0), cA + kstep, voffA); PG8_STAGE(PG8_SB(1, 1), cB + hstep + kstep, voffB);
        PG8_WAIT_V(6); PG8_BAR;
    } else {
        PG8_STAGE(PG8_SB(0, 0), cB, voffB); PG8_STAGE(PG8_SA(0, 0), cA, voffA); PG8_STAGE(PG8_SB(0, 1), cB + hstep, voffB); PG8_STAGE(PG8_SA(0, 1), cA + hstep, voffA);
        if (wr == 1) PG8_BAR;
        PG8_WAIT_V(4); PG8_BAR;
        PG8_STAGE(PG8_SB(1, 0), cB + kstep, voffB); PG8_STAGE(PG8_SA(1, 0), cA + kstep, voffA); PG8_STAGE(PG8_SB(1, 1), cB + hstep + kstep, voffB);
        PG8_WAIT_V(6); PG8_BAR;
    }
    for (;;) {
        const bool has_next = S.next(ui + 1, nxt);
        const char* nA = has_next ? (const char*)g.A + (size_t)nxt.pm * tstep : cA; const char* nB = has_next ? (const char*)g.Bt + (size_t)nxt.pn * tstep : cB;
        for (int t = 0; t < nt; t += 2) {
            const bool last = (t == nt - 2);
            const char* a1 = cA + (size_t)(t + 1) * kstep;
            const char* a2 = last ? nA : cA + (size_t)(t + 2) * kstep; const char* b2 = last ? nB : cB + (size_t)(t + 2) * kstep;
            const char* a3 = a2 + kstep; const char* b3 = b2 + kstep;
            if (last && has_next) S.a_ready(nxt);
            if constexpr (SP2) {
            PG8_LDB(B0, 0, 0); PG8_LDB(B1, 0, 1); PG8_SCHED; PG8_LDA(At, 0, 0); PG8_STAGE(PG8_SA(1, 1), a1 + hstep, voffA);
            PG8_WAIT_V(8); PG8_WAIT_L(0); PG8_BAR; PG8_MMA(0, 0, At, B0); PG8_MMA(0, 1, At, B1); PG8_BAR; PG8_SCHED;
            PG8_LDA(At, 0, 1); PG8_STAGE(PG8_SB(0, 0), b2, voffB); PG8_STAGE(PG8_SB(0, 1), b2 + hstep, voffB); PG8_STAGE(PG8_SA(0, 0), a2, voffA);
            PG8_WAIT_V(8); PG8_WAIT_L(0); PG8_BAR; PG8_MMA(1, 0, At, B0); PG8_MMA(1, 1, At, B1); PG8_BAR; PG8_SCHED;
            PG8_LDB(B0, 1, 0); PG8_LDB(B1, 1, 1); PG8_SCHED; PG8_LDA(At, 1, 0); PG8_STAGE(PG8_SA(0, 1), a2 + hstep, voffA);
            PG8_WAIT_V(8); PG8_WAIT_L(0); PG8_BAR; PG8_MMA(0, 0, At, B0); PG8_MMA(0, 1, At, B1); PG8_BAR; PG8_SCHED;
            PG8_LDA(At, 1, 1); PG8_STAGE(PG8_SB(1, 0), b3, voffB); PG8_STAGE(PG8_SB(1, 1), b3 + hstep, voffB); PG8_STAGE(PG8_SA(1, 0), a3, voffA);
            PG8_WAIT_V(8); PG8_WAIT_L(0); PG8_BAR; PG8_MMA(1, 0, At, B0); PG8_MMA(1, 1, At, B1); PG8_BAR; PG8_SCHED;
            } else {
            PG8_LDB(B0, 0, 0); PG8_SCHED; PG8_LDA(At, 0, 0); PG8_STAGE(PG8_SA(1, 1), a1 + hstep, voffA);
            PG8_WAIT_L(8); PG8_BAR; PG8_WAIT_L(0); PG8_MMA(0, 0, At, B0); PG8_BAR; PG8_SCHED;
            PG8_LDB(B1, 0, 1); PG8_STAGE(PG8_SB(0, 0), b2, voffB);
            PG8_BAR; PG8_WAIT_L(0); PG8_MMA(0, 1, At, B1); PG8_BAR;
            PG8_LDA(At, 0, 1); PG8_STAGE(PG8_SA(0, 0), a2, voffA);
            PG8_BAR; PG8_WAIT_L(0); PG8_MMA(1, 0, At, B0); PG8_BAR; PG8_SCHED;
            PG8_STAGE(PG8_SB(0, 1), b2 + hstep, voffB);
            PG8_WAIT_V(6); PG8_BAR; PG8_MMA(1, 1, At, B1); PG8_BAR;
            PG8_LDB(B0, 1, 0); PG8_SCHED; PG8_LDA(At, 1, 0); PG8_STAGE(PG8_SA(0, 1), a2 + hstep, voffA);
            PG8_WAIT_L(8); PG8_BAR; PG8_WAIT_L(0); PG8_MMA(0, 0, At, B0); PG8_BAR; PG8_SCHED;
            PG8_LDB(B1, 1, 1); PG8_STAGE(PG8_SB(1, 0), b3, voffB);
            PG8_BAR; PG8_WAIT_L(0); PG8_MMA(0, 1, At, B1); PG8_BAR;
            PG8_LDA(At, 1, 1); PG8_STAGE(PG8_SA(1, 0), a3, voffA);
            PG8_BAR; PG8_WAIT_L(0); PG8_MMA(1, 0, At, B0); PG8_BAR; PG8_SCHED;
            PG8_STAGE(PG8_SB(1, 1), b3 + hstep, voffB);
            PG8_WAIT_V(6); PG8_BAR; PG8_MMA(1, 1, At, B1); PG8_BAR;
            }
        }
        if constexpr (ALIGN_EPI) { if (wr == 0) PG8_BAR; }
        if constexpr (!Epi::AFTER_DRAIN) { E(acc, cur, wr, wc, fr, fq); S.done(cur); }
        if (!has_next) break;
#pragma unroll
        for (int a = 0; a < 2; ++a)
#pragma unroll
            for (int b = 0; b < 2; ++b)
#pragma unroll
                for (int m = 0; m < 4; ++m)
#pragma unroll
                    for (int n = 0; n < 2; ++n) acc[a][b][m][n] = (f32x4){0.f, 0.f, 0.f, 0.f};
        cur = nxt; cA = nA; cB = nB; ++ui;
        if constexpr (ALIGN_EPI) { if (wr == 1) PG8_BAR; }
    }
    PG8_WAIT_V(0);
    if constexpr (!ALIGN_EPI) { if (wr == 0) PG8_BAR; }
    PG8_BAR;
    if constexpr (Epi::AFTER_DRAIN) { E.fused(acc, cur, wr, wc, fr, fq, lds, wid, lane); S.done(cur); }
#undef PG8_SA
#undef PG8_SB
#undef PG8_STAGE
#undef PG8_LDA
#undef PG8_LDB
#undef PG8_MMA
#undef PG8_WAIT_V
#undef PG8_WAIT_L
#undef PG8_BAR
#undef PG8_SCHED
}
}
#define LAS __attribute__((address_space(3)))
typedef unsigned short bf16;
typedef short bf16x8 __attribute__((ext_vector_type(8)));
typedef float f32x4 __attribute__((ext_vector_type(4)));
typedef unsigned u32x4 __attribute__((ext_vector_type(4)));
typedef unsigned u32x2 __attribute__((ext_vector_type(2)));
constexpr int SEQ = 2048, DM = 1024, MROWS = 16384, FF = 4096, NINP = 3840, NINL = 3600, NTHR = 512, NWAVE = 8;
constexpr size_t MiB = 1u << 20;
constexpr size_t WS_SS = 0, WS_ROPE = 512 * 1024, WS_N = 1 * MiB, WS_MST = 2 * MiB, WS_G = 3 * MiB;
constexpr size_t WS_WIN = 4 * MiB, WS_WOUT = 19 * MiB, WS_WUP = 23 * MiB, WS_WDN = 39 * MiB;
constexpr size_t WS_XB = 56 * MiB;
constexpr size_t WS_SSP = 88 * MiB;
constexpr size_t WS_P1O = 93 * MiB, WS_P1ML = 109 * MiB;
constexpr size_t WS_U = 120 * MiB;
constexpr size_t WS_QKM = 120 * MiB, WS_KTM = 152 * MiB, WS_VTM = 168 * MiB, WS_AK = 184 * MiB, WS_VT16 = 200 * MiB, WS_Y = 216 * MiB, WS_END = 248 * MiB;
constexpr size_t WS_CTL = 2 * MiB + 256 * 1024, CTL_BYTES = 16384;
constexpr int LDS_BYTES = 147456, LDS_MISC = 131072 + 320;

struct Params {
    const float *x, *norm1_g, *w_in, *conv_w, *gate_i_b, *gate_f_b, *head_norm_g, *w_out, *norm2_g, *w_up, *w_down, *final_g;
    float* out; unsigned char* ws;
};

__device__ __forceinline__ unsigned pk2(float lo, float hi) { return pg8::cvt_pk_bf16(lo, hi); }
__device__ __forceinline__ float bflo(unsigned w) { return __uint_as_float(w << 16); }
__device__ __forceinline__ float bfhi(unsigned w) { return __uint_as_float(w & 0xffff0000u); }
__device__ __forceinline__ float wave_sum(float v) {
#pragma unroll
    for (int o = 1; o < 64; o <<= 1) v += __shfl_xor(v, o);
    return v;
}
__device__ __forceinline__ float wave_max(float v) {
#pragma unroll
    for (int o = 1; o < 64; o <<= 1) v = fmaxf(v, __shfl_xor(v, o));
    return v;
}
__device__ __forceinline__ float wave_incl_scan(float v, int lane) {
#pragma unroll
    for (int o = 1; o < 64; o <<= 1) { const float t = __shfl_up(v, o); if (lane >= o) v += t; }
    return v;
}

#define DPP_STEP_ADD(v, ctrl, rm) do { const int t_ = __builtin_amdgcn_update_dpp(0, __float_as_int(v), (ctrl), (rm), 0xf, false); v += __int_as_float(t_); } while (0)
#define DPP_STEP_MAX(v, ctrl, rm) do { const int t_ = __builtin_amdgcn_update_dpp((int)0xff800000, __float_as_int(v), (ctrl), (rm), 0xf, false); v = fmaxf(v, __int_as_float(t_)); } while (0)
__device__ __forceinline__ float wave_incl_scan_dpp(float v) {
    DPP_STEP_ADD(v, 0x111, 0xf); DPP_STEP_ADD(v, 0x112, 0xf); DPP_STEP_ADD(v, 0x114, 0xf); DPP_STEP_ADD(v, 0x118, 0xf); DPP_STEP_ADD(v, 0x142, 0xa); DPP_STEP_ADD(v, 0x143, 0xc);
    return v;
}
__device__ __forceinline__ float wave_incl_max_dpp(float v) {
    DPP_STEP_MAX(v, 0x111, 0xf); DPP_STEP_MAX(v, 0x112, 0xf); DPP_STEP_MAX(v, 0x114, 0xf); DPP_STEP_MAX(v, 0x118, 0xf); DPP_STEP_MAX(v, 0x142, 0xa); DPP_STEP_MAX(v, 0x143, 0xc);
    return v;
}
__device__ __forceinline__ float wave_max_dpp(float v) {
    DPP_STEP_MAX(v, 0x111, 0xf); DPP_STEP_MAX(v, 0x112, 0xf); DPP_STEP_MAX(v, 0x114, 0xf); DPP_STEP_MAX(v, 0x118, 0xf); DPP_STEP_MAX(v, 0x142, 0xa); DPP_STEP_MAX(v, 0x143, 0xc);
    return __int_as_float(__builtin_amdgcn_readlane(__float_as_int(v), 63));
}
#define MFMA16(a, b, c) __builtin_amdgcn_mfma_f32_16x16x32_bf16((a), (b), (c), 0, 0, 0)

__device__ __forceinline__ int win_src_col(int nb, int& nvalid) {
    nvalid = 32;
    if (nb < 2048) return nb;
    if (nb < 3072) { int xx = nb - 2048; const int isk = xx >> 9; xx &= 511; const int T = xx >> 8, bj = (xx >> 7) & 1, hl = (xx >> 5) & 3; return 2064 + isk * 512 + 64 * (4 * T + hl) + 32 * bj; }
    if (nb < 3584) return 3088 + (nb - 3072);
    if (nb == 3584) { nvalid = 16; return 2048; }
    nvalid = 0; return 0;
}
__device__ __forceinline__ void transpose_item(const float* W, int K, int Nsrc, int src_col, int nvalid, const float* g, bf16* WT, int dst_row, int k0, LAS float* scr, int lane) {
    const int c = lane & 31;
    float wv[32];
#pragma unroll
    for (int i = 0; i < 32; ++i) { const int kk = 2 * i + (lane >> 5); wv[i] = (c < nvalid) ? W[(size_t)(k0 + kk) * Nsrc + src_col + c] : 0.f; }
    if (g) {
#pragma unroll
        for (int i = 0; i < 32; ++i) wv[i] *= g[k0 + 2 * i + (lane >> 5)]; }
#pragma unroll
    for (int i = 0; i < 32; ++i) scr[(2 * i + (lane >> 5)) * 33 + c] = wv[i];
    asm volatile("s_waitcnt lgkmcnt(0)" ::: "memory");
    const int ch = lane & 7;
#pragma unroll
    for (int j = 0; j < 4; ++j) { const int n = (lane >> 3) + 8 * j; const LAS float* s = scr + (8 * ch) * 33 + n;
        u32x4 o; o.x = pk2(s[0 * 33], s[1 * 33]); o.y = pk2(s[2 * 33], s[3 * 33]); o.z = pk2(s[4 * 33], s[5 * 33]); o.w = pk2(s[6 * 33], s[7 * 33]);
        *(u32x4*)(WT + (size_t)(dst_row + n) * K + k0 + 8 * ch) = o; }
    asm volatile("s_waitcnt lgkmcnt(0)" ::: "memory");
}
constexpr int I_IN = 16 * (NINP / 32), I_OUT = 16 * 32, I_UP = 16 * 128, I_DN = 64 * 32, I_L = I_IN + I_OUT + I_UP + I_DN;
__device__ __forceinline__ void convert_item(const Params& p, int it, LAS float* scr, int lane) {
    const int l = it / I_L; int r = it % I_L;
    if (r < I_IN) { const int nblk = NINP / 32, kb = r / nblk, nb = (r % nblk) * 32; int nv; const int sc = win_src_col(nb, nv);
        transpose_item(p.w_in + (size_t)l * DM * NINL, DM, NINL, sc, nv, p.norm1_g + l * DM, (bf16*)(p.ws + WS_WIN) + (size_t)l * NINP * DM, nb, kb * 64, scr, lane); return; }
    r -= I_IN;
    if (r < I_OUT) { const int kb = r / 32, nb = (r % 32) * 32;
        transpose_item(p.w_out + (size_t)l * DM * DM, DM, DM, nb, 32, nullptr, (bf16*)(p.ws + WS_WOUT) + (size_t)l * DM * DM, nb, kb * 64, scr, lane); return; }
    r -= I_OUT;
    if (r < I_UP) { const int kb = r / 128, nb = (r % 128) * 32;
        transpose_item(p.w_up + (size_t)l * DM * FF, DM, FF, nb, 32, p.norm2_g + l * DM, (bf16*)(p.ws + WS_WUP) + (size_t)l * FF * DM, nb, kb * 64, scr, lane); return; }
    r -= I_UP;
    { const int kb = r / 32, nb = (r % 32) * 32;
        transpose_item(p.w_down + (size_t)l * FF * DM, FF, DM, nb, 32, nullptr, (bf16*)(p.ws + WS_WDN) + (size_t)l * DM * FF, nb, kb * 64, scr, lane); }
}
__device__ __forceinline__ void p0_prologue(const Params& p, LAS unsigned char* lds, int wave, int lane, int G, int n_items) {
    LAS float* scr = (LAS float*)(lds + wave * 16384);
    const int gw = blockIdx.x * NWAVE + wave, NGW = G * NWAVE;
    if (n_items < 0) { constexpr int I_A = I_IN + I_OUT;
        for (int j = gw; j < 2 * I_A; j += NGW) convert_item(p, (j / I_A) * I_L + (j % I_A), scr, lane); }
    else for (int it = gw; it < n_items; it += NGW) convert_item(p, it, scr, lane);
    float* ss = (float*)(p.ws + WS_SSP); bf16* xb = (bf16*)(p.ws + WS_XB);
    for (int m0 = gw; m0 < MROWS; m0 += 2 * NGW) {
        f32x4 v[2][4];
#pragma unroll
        for (int q = 0; q < 2; ++q) { const int m = (m0 + q * NGW < MROWS) ? m0 + q * NGW : m0; const f32x4* xr = (const f32x4*)(p.x + (size_t)m * DM) + lane;
#pragma unroll
            for (int j = 0; j < 4; ++j) v[q][j] = xr[64 * j]; }
#pragma unroll
        for (int q = 0; q < 2; ++q) { const int m = m0 + q * NGW; if (m < MROWS) { float s = 0.f; u32x2* o8 = (u32x2*)(xb + (size_t)m * DM) + lane;
#pragma unroll
            for (int j = 0; j < 4; ++j) { const f32x4 t = v[q][j]; s += (t[0] * t[0] + t[1] * t[1]) + (t[2] * t[2] + t[3] * t[3]); u32x2 w; w.x = pk2(t[0], t[1]); w.y = pk2(t[2], t[3]); o8[64 * j] = w; }
            s = wave_sum(s); if (lane < 16) ss[(size_t)m * 16 + lane] = (lane == 0) ? s : 0.f; } }
    }
    const int gt = blockIdx.x * NTHR + threadIdx.x, NGT = G * NTHR;
    float* rc = (float*)(p.ws + WS_ROPE); float* rsn = rc + SEQ * 32;
    for (int i = gt; i < SEQ * 32; i += NGT) { const int pos = i >> 5, fi = i & 31;
        const float inv = exp2f(-(float)fi * (13.287712379549449f / 32.0f)); const float ang = (float)pos * inv;
        const float n = rintf(ang * 0.15915494309189535f); float rr = fmaf(-n, 6.2831854820251465f, ang); rr = fmaf(-n, -1.7484555e-7f, rr);
        rc[i] = __cosf(rr); rsn[i] = __sinf(rr); }
}

struct ScanLd { u32x4 kc[2]; unsigned kb[2], ka[2]; float li, lf; };
__device__ __forceinline__ void scan_load(ScanLd& L, const bf16* Krow, const bf16* Vrow, const float* Gp, int tok0, int fq, int lane, int gcol) {
    L.li = Gp[(size_t)(tok0 + lane) * 16 + gcol]; L.lf = Gp[(size_t)(tok0 + lane) * 16 + 8 + gcol];
#pragma unroll
    for (int ks = 0; ks < 2; ++ks) { const int base = tok0 + 32 * ks + 8 * fq;
        L.kc[ks] = __builtin_nontemporal_load((const u32x4*)(Krow + base));
        L.kb[ks] = (base >= 2) ? *(const unsigned*)(Krow + base - 2) : 0u;
        L.ka[ks] = (base + 8 < SEQ) ? *(const unsigned*)(Krow + base + 8) : 0u; }
}
__device__ __forceinline__ void scan_wave(const Params& p, int layer, int sw, LAS float* wl, int lane, bool bar_mid) {
    const int ksl = sw & 7, dir = (sw >> 3) & 1, hh = (sw >> 4) & 3, b = sw >> 6;
    const int fr = lane & 15, fq = lane >> 4, kdim = 16 * ksl + fr;
    const float* cw = p.conv_w + (size_t)layer * 5 * 1024 + 512 + hh * 128 + kdim;
    float cwt[5];
#pragma unroll
    for (int t = 0; t < 5; ++t) cwt[t] = cw[t * 1024];
    const bf16* Krow = (const bf16*)(p.ws + WS_KTM) + ((size_t)((b * 4 + hh) * 128 + kdim)) * SEQ;
    const bf16* Vrow = (const bf16*)(p.ws + WS_VTM) + ((size_t)((b * 4 + hh) * 128 + fr)) * SEQ;
    const float* Gp = (const float*)(p.ws + WS_G) + (size_t)b * SEQ * 16;
    const int gcol = dir * 4 + hh;
    bf16* Ct = (bf16*)p.out; float* Nst = (float*)(p.ws + WS_N); float* Mst = (float*)(p.ws + WS_MST);
    const f32x4 z4 = {0.f, 0.f, 0.f, 0.f};
    f32x4 C[8], CN = z4; float mrun = -1e30f;
#pragma unroll
    for (int nt = 0; nt < 8; ++nt) C[nt] = z4;
    const bf16x8 ones = {0x3F80, 0x3F80, 0x3F80, 0x3F80, 0x3F80, 0x3F80, 0x3F80, 0x3F80};
    ScanLd cur, nxt;
    scan_load(cur, Krow, Vrow, Gp, (dir ? 31 : 0) * 64, fq, lane, gcol);
    for (int cs = 0; cs < 32; ++cs) {
        if (bar_mid && cs == 11) __syncthreads();
        const int pc = dir ? 31 - cs : cs;
        bf16x8 vv[8][2];
#pragma unroll
        for (int ks = 0; ks < 2; ++ks)
#pragma unroll
            for (int nt = 0; nt < 8; ++nt) vv[nt][ks] = *(const bf16x8*)(Vrow + (size_t)nt * 16 * SEQ + pc * 64 + 32 * ks + 8 * fq);
        if (cs + 1 < 32) scan_load(nxt, Krow, Vrow, Gp, (dir ? 30 - cs : cs + 1) * 64, fq, lane, gcol); else nxt = cur;
        const float pre = wave_incl_scan_dpp(cur.lf); const float total = __int_as_float(__builtin_amdgcn_readlane(__float_as_int(pre), 63));
        const float g = dir ? (pre - cur.lf + cur.li) : (total - pre + cur.li);
        const float gmax = wave_max_dpp(g);
        const float mn = fmaxf(total + mrun, gmax); const float decay = __expf(total + mrun - mn); const float w = __expf(g - mn);
        const size_t sidx = (size_t)((b * 4 + hh) * 2 + dir) * 32 + pc;
        { bf16* Cd = Ct + sidx * 16384 + (size_t)fr * 128 + 16 * ksl + 4 * fq;
#pragma unroll
          for (int nt = 0; nt < 8; ++nt) { u32x2 w0; w0.x = pk2(C[nt][0], C[nt][1]); w0.y = pk2(C[nt][2], C[nt][3]); *(u32x2*)(Cd + nt * 16 * 128) = w0; }
          if (fr == 0) *(f32x4*)(Nst + sidx * 128 + 16 * ksl + 4 * fq) = CN;
          if (ksl == 0 && lane == 0) Mst[sidx] = mrun; }
        wl[lane] = w;
        asm volatile("s_waitcnt lgkmcnt(0)" ::: "memory");
        bf16x8 afr[2];
#pragma unroll
        for (int ks = 0; ks < 2; ++ks) {
            const f32x4 wa = *(const LAS f32x4*)(wl + 32 * ks + 8 * fq), wb = *(const LAS f32x4*)(wl + 32 * ks + 8 * fq + 4);
            float r[12]; r[0] = bflo(cur.kb[ks]); r[1] = bfhi(cur.kb[ks]);
#pragma unroll
            for (int q = 0; q < 4; ++q) { r[2 + 2 * q] = bflo(cur.kc[ks][q]); r[3 + 2 * q] = bfhi(cur.kc[ks][q]); }
            r[10] = bflo(cur.ka[ks]); r[11] = bfhi(cur.ka[ks]);
            float o[8];
#pragma unroll
            for (int j = 0; j < 8; ++j) { float a = 0.f;
#pragma unroll
                for (int t = 0; t < 5; ++t) a = fmaf(cwt[t], r[j + t], a);
                a = a * __builtin_amdgcn_rcpf(1.0f + __expf(-a)); o[j] = a * 0.08838834764831845f * (j < 4 ? wa[j] : wb[j - 4]); }
            u32x4 pw; pw.x = pk2(o[0], o[1]); pw.y = pk2(o[2], o[3]); pw.z = pk2(o[4], o[5]); pw.w = pk2(o[6], o[7]);
            afr[ks] = __builtin_bit_cast(bf16x8, pw);
        }
        asm volatile("" ::: "memory");
        CN = CN * decay;
#pragma unroll
        for (int nt = 0; nt < 8; ++nt) { C[nt] = C[nt] * decay; C[nt] = MFMA16(afr[0], vv[nt][0], C[nt]); C[nt] = MFMA16(afr[1], vv[nt][1], C[nt]); }
        CN = MFMA16(afr[0], ones, CN); CN = MFMA16(afr[1], ones, CN);
        mrun = mn; cur = nxt;
    }
}

__device__ __forceinline__ void tile_par(int T, int f, int r, int L0, int& R, int& Lb, int& dsh) {
    if (T < 10) { dsh = 4; R = r; Lb = L0 - 64 + 16 * T + 4 * f; }
    else if (T < 22) { dsh = 2; R = 4 * f + (r & 3); Lb = L0 - 16 + 4 * (T - 10); }
    else { const int xx = T - 22; dsh = 0; R = 4 * (xx & 3) + f; Lb = L0 - 4 + 4 * (xx >> 2); }
}
template <int LIM> __device__ __forceinline__ void attn_step(f32x4 (&O)[4], float& mrun, float& lsum, const bf16x8 (&qf)[2], const bf16x8 k00, const bf16x8 k01, const bf16x8 k10, const bf16x8 k11,
                                                             const u32x2 (&v0)[4], const u32x2 (&v1)[4], int D0, int D1, bool ok0, bool ok1) {
    const f32x4 z4 = {0.f, 0.f, 0.f, 0.f};
    f32x4 s0 = MFMA16(k00, qf[0], z4); s0 = MFMA16(k01, qf[1], s0);
    f32x4 s1 = MFMA16(k10, qf[0], z4); s1 = MFMA16(k11, qf[1], s1);
    bool va[4], vb[4];
#pragma unroll
    for (int j = 0; j < 4; ++j) { va[j] = ok0 && ((unsigned)(D0 + 16 * j) <= (unsigned)(2 * LIM)); vb[j] = ok1 && ((unsigned)(D1 + 16 * j) <= (unsigned)(2 * LIM));
        s0[j] = va[j] ? s0[j] : -1e30f; s1[j] = vb[j] ? s1[j] : -1e30f; }
    float tm = fmaxf(fmaxf(fmaxf(s0[0], s0[1]), fmaxf(s0[2], s0[3])), fmaxf(fmaxf(s1[0], s1[1]), fmaxf(s1[2], s1[3])));
    tm = fmaxf(tm, __shfl_xor(tm, 16)); tm = fmaxf(tm, __shfl_xor(tm, 32));
    const float mn = fmaxf(mrun, tm);
    if (__any(mn > mrun)) { const float sc = __builtin_amdgcn_exp2f(mrun - mn); lsum *= sc;
#pragma unroll
        for (int d = 0; d < 4; ++d) O[d] = O[d] * sc; }
    mrun = mn;
    float pv[8]; float ps = 0.f;
#pragma unroll
    for (int j = 0; j < 4; ++j) { pv[j] = va[j] ? __builtin_amdgcn_exp2f(s0[j] - mn) : 0.f; pv[4 + j] = vb[j] ? __builtin_amdgcn_exp2f(s1[j] - mn) : 0.f; ps += pv[j] + pv[4 + j]; }
    lsum += ps;
    u32x4 pw; pw.x = pk2(pv[0], pv[1]); pw.y = pk2(pv[2], pv[3]); pw.z = pk2(pv[4], pv[5]); pw.w = pk2(pv[6], pv[7]);
    const bf16x8 pb = __builtin_bit_cast(bf16x8, pw);
#pragma unroll
    for (int d = 0; d < 4; ++d) { u32x4 vw; vw.x = v0[d].x; vw.y = v0[d].y; vw.z = v1[d].x; vw.w = v1[d].y; O[d] = MFMA16(__builtin_bit_cast(bf16x8, vw), pb, O[d]); }
}
#define KLD(ptr, lo, hi) do { lo = *(const bf16x8*)(ptr); hi = *(const bf16x8*)((ptr) + 32); } while (0)
#define VLD(ptr, v) do { _Pragma("unroll") for (int d_ = 0; d_ < 4; ++d_) v[d_] = *(const u32x2*)((ptr) + d_ * 64); } while (0)
__device__ __forceinline__ void attn_pair(const Params& p, int b, int h, int p0, int r0, int lane) {
    const int fr = lane & 15, fq = lane >> 4, fK = fr >> 2, jK = fr & 3; const int L0 = p0 >> 4;
    const f32x4 z4 = {0.f, 0.f, 0.f, 0.f};
    bf16* Yrow[2]; bf16x8 qf[2][2]; f32x4 O[2][4]; float mrun[2], lsum[2];
    const bf16* Kb = (const bf16*)(p.ws + WS_AK) + (ptrdiff_t)b * SEQ * 512 + h * 64 + 8 * fq;
    const bf16* Vb = (const bf16*)(p.ws + WS_VT16) + (ptrdiff_t)(b * 8 + h) * 131072 + fr * 4;
#pragma unroll
    for (int u = 0; u < 2; ++u) { const int pq = p0 + 16 * fr + r0 + 4 * u; Yrow[u] = (bf16*)(p.ws + WS_Y) + ((size_t)(b * SEQ + pq)) * 1024 + 512 + h * 64;
        qf[u][0] = *(const bf16x8*)(Yrow[u] + 8 * fq); qf[u][1] = *(const bf16x8*)(Yrow[u] + 32 + 8 * fq); mrun[u] = -1e30f; lsum[u] = 0.f;
#pragma unroll
        for (int d = 0; d < 4; ++d) O[u][d] = z4; }
    {
        const bf16* kp = Kb + (ptrdiff_t)(16 * (L0 - 64 + 4 * fK + jK) + r0) * 512;
        const bf16* vp = Vb + (ptrdiff_t)(r0 * 32 + (L0 >> 2) - 16 + fq) * 256;
        for (int pp = 0; pp < 5; ++pp) { const int T0 = 2 * pp; const int lq = L0 - 64 + 16 * T0;
            if (lq + 31 < 0 || lq >= 128) continue;
            const int D0 = 16 * (-64 + 16 * T0 + 4 * fq - fr) + 1024; const bool ok0 = (unsigned)(lq + 4 * fq) < 128u, ok1 = (unsigned)(lq + 16 + 4 * fq) < 128u;
            const bf16* k0p = kp + (ptrdiff_t)T0 * 256 * 512; const bf16* v0p = vp + (ptrdiff_t)T0 * 4 * 256;
#pragma unroll
            for (int u = 0; u < 2; ++u) { bf16x8 k00, k01, k10, k11; u32x2 v0[4], v1[4];
                KLD(k0p + u * 4 * 512, k00, k01); VLD(v0p + u * 4 * 32 * 256, v0);
                if (pp < 4) { KLD(k0p + u * 4 * 512 + 256 * 512, k10, k11); VLD(v0p + u * 4 * 32 * 256 + 4 * 256, v1); }
                else { k10 = k00; k11 = k01;
#pragma unroll
                    for (int d_ = 0; d_ < 4; ++d_) v1[d_] = v0[d_]; }
                attn_step<1024>(O[u], mrun[u], lsum[u], qf[u], k00, k01, k10, k11, v0, v1, D0, D0 + 256, ok0, ok1 && (pp < 4)); }
        }
    }
    {
        const bf16* kp = Kb + (ptrdiff_t)(16 * (L0 - 16 + jK) + 4 * fK + (r0 & 3)) * 512;
        const bf16* vp = Vb + (ptrdiff_t)((4 * fq + (r0 & 3)) * 32 + (L0 >> 2) - 4) * 256;
        for (int pp = 0; pp < 6; ++pp) { const int T0 = 2 * pp; const int lb = L0 - 16 + 4 * T0;
            const bool ok0 = (unsigned)lb < 128u, ok1 = (unsigned)(lb + 4) < 128u; if (!ok0 && !ok1) continue;
            const int D0 = 16 * (-16 + 4 * T0 - fr) + 4 * fq - (r0 & ~3) + 256;
            const bf16* k0p = kp + (ptrdiff_t)T0 * 64 * 512; const bf16* v0p = vp + (ptrdiff_t)T0 * 256;
            { bf16x8 k00, k01, k10, k11; u32x2 v0[4], v1[4];
                KLD(k0p, k00, k01); KLD(k0p + 64 * 512, k10, k11); VLD(v0p, v0); VLD(v0p + 256, v1);
                attn_step<256>(O[0], mrun[0], lsum[0], qf[0], k00, k01, k10, k11, v0, v1, D0, D0 + 64, ok0, ok1);
                attn_step<256>(O[1], mrun[1], lsum[1], qf[1], k00, k01, k10, k11, v0, v1, D0 - 4, D0 + 60, ok0, ok1); }
        }
    }
#pragma unroll
    for (int u = 0; u < 2; ++u) { float l2 = lsum[u]; l2 += __shfl_xor(l2, 16); l2 += __shfl_xor(l2, 32); const int pq = p0 + 16 * fr + r0 + 4 * u; const size_t qrow = (size_t)(b * SEQ + pq);
        const float* ml = (const float*)(p.ws + WS_P1ML) + (qrow * 8 + h) * 2; const float m1 = ml[0], l1 = ml[1];
        const float m = fmaxf(mrun[u], m1); const float a2 = __builtin_amdgcn_exp2f(mrun[u] - m), a1 = __builtin_amdgcn_exp2f(m1 - m) * l1; const float rden = 1.0f / (l2 * a2 + a1);
        const bf16* o1p = (const bf16*)(p.ws + WS_P1O) + qrow * 512 + h * 64 + 4 * fq;
#pragma unroll
        for (int d = 0; d < 4; ++d) { const u32x2 ow = *(const u32x2*)(o1p + 16 * d); u32x2 w;
            w.x = pk2((O[u][d][0] * a2 + bflo(ow.x) * a1) * rden, (O[u][d][1] * a2 + bfhi(ow.x) * a1) * rden); w.y = pk2((O[u][d][2] * a2 + bflo(ow.y) * a1) * rden, (O[u][d][3] * a2 + bfhi(ow.y) * a1) * rden);
            *(u32x2*)(Yrow[u] + 16 * d + 4 * fq) = w; } }
}
__device__ __forceinline__ void attn_quad_d1(const Params& p, int b, int h, int L, int lane) {
    const int fr = lane & 15, fq = lane >> 4, fK = fr >> 2, jK = fr & 3;
    const f32x4 z4 = {0.f, 0.f, 0.f, 0.f};
    bf16x8 qf[4][2]; f32x4 O[4][4]; float mrun[4], lsum[4];
    const bf16* Kb = (const bf16*)(p.ws + WS_AK) + (ptrdiff_t)b * SEQ * 512 + h * 64 + 8 * fq;
    const bf16* Vb = (const bf16*)(p.ws + WS_VT16) + (ptrdiff_t)(b * 8 + h) * 131072 + fr * 4;
#pragma unroll
    for (int i = 0; i < 4; ++i) { const bf16* qrow = (const bf16*)(p.ws + WS_Y) + ((size_t)(b * SEQ + 16 * (L + i) + fr)) * 1024 + 512 + h * 64;
        qf[i][0] = *(const bf16x8*)(qrow + 8 * fq); qf[i][1] = *(const bf16x8*)(qrow + 32 + 8 * fq); mrun[i] = -1e30f; lsum[i] = 0.f;
#pragma unroll
        for (int d = 0; d < 4; ++d) O[i][d] = z4; }
    const bf16* kp = Kb + (ptrdiff_t)(16 * (L - 4 + jK) + fK) * 512;
    const bf16* vp = Vb + (ptrdiff_t)(fq * 32 + (L >> 2) - 1) * 256;
    for (int kb = 0; kb < 3; ++kb) { const int lb = L - 4 + 4 * kb; if ((unsigned)lb >= 128u) continue;
#pragma unroll
        for (int th = 0; th < 2; ++th) { const int t0 = 2 * th;
            const int D0 = 16 * (-4 + 4 * kb) + 4 * t0 + fq - fr + 64;
            const bf16* k0p = kp + (ptrdiff_t)(64 * kb + 4 * t0) * 512; const bf16* v0p = vp + (ptrdiff_t)(128 * t0 + kb) * 256;
            bf16x8 k00, k01, k10, k11; u32x2 v0[4], v1[4];
            KLD(k0p, k00, k01); KLD(k0p + 4 * 512, k10, k11); VLD(v0p, v0); VLD(v0p + 128 * 256, v1);
#pragma unroll
            for (int i = 0; i < 4; ++i) { attn_step<64>(O[i], mrun[i], lsum[i], qf[i], k00, k01, k10, k11, v0, v1, D0 - 16 * i, D0 - 16 * i + 4, true, true); if (i & 1) __builtin_amdgcn_sched_barrier(0); } }
    }
#pragma unroll
    for (int i = 0; i < 4; ++i) { float l = lsum[i]; l += __shfl_xor(l, 16); l += __shfl_xor(l, 32); const float rl = 1.0f / l; const size_t qrow = (size_t)(b * SEQ + 16 * (L + i) + fr);
        bf16* o1p = (bf16*)(p.ws + WS_P1O) + qrow * 512 + h * 64 + 4 * fq;
#pragma unroll
        for (int d = 0; d < 4; ++d) { u32x2 w; w.x = pk2(O[i][d][0] * rl, O[i][d][1] * rl); w.y = pk2(O[i][d][2] * rl, O[i][d][3] * rl); *(u32x2*)(o1p + 16 * d) = w; }
        if (fq == 0) { float* ml = (float*)(p.ws + WS_P1ML) + (qrow * 8 + h) * 2; ml[0] = mrun[i]; ml[1] = l; } }
}
constexpr int QS_OFF = 0, KS_OFF = 17408, PF_OFF = 34816, PB_OFF = 44032, FL_OFF = 53248, QPITCH = 272, PPITCH = 144;
__device__ __forceinline__ void mout_unit(const Params& p, int layer, int u, LAS unsigned char* lds, int tid, int wave, int lane) {
    const int b = u >> 7, hh = (u >> 5) & 3, pc = u & 31, tok0 = pc * 64;
    const int fr = lane & 15, fq = lane >> 4;
    LAS float* FL = (LAS float*)(lds + FL_OFF);
    const float* Gp = (const float*)(p.ws + WS_G) + (size_t)(b * SEQ + tok0) * 16;
    const float* Mst = (const float*)(p.ws + WS_MST); const float* Nst = (const float*)(p.ws + WS_N);
    const bf16* Ct = (const bf16*)p.out;
    const size_t sid0 = (size_t)((b * 4 + hh) * 2 + 0) * 32 + pc, sid1 = (size_t)((b * 4 + hh) * 2 + 1) * 32 + pc;
    bf16x8 vaf[2], caf[2][4];
    { const bf16* Vr = (const bf16*)(p.ws + WS_VTM) + ((size_t)((b * 4 + hh) * 128 + 16 * wave + fr)) * SEQ + tok0;
#pragma unroll
      for (int ks = 0; ks < 2; ++ks) vaf[ks] = __builtin_nontemporal_load((const bf16x8*)(Vr + 32 * ks + 8 * fq));
#pragma unroll
      for (int d = 0; d < 2; ++d) { const bf16* Cr = Ct + (d ? sid1 : sid0) * 16384 + (size_t)(16 * wave + fr) * 128;
#pragma unroll
          for (int kk = 0; kk < 4; ++kk) caf[d][kk] = __builtin_nontemporal_load((const bf16x8*)(Cr + 32 * kk + 8 * fq)); } }
    if (wave < 2) {
        const int dir = wave; const float li = Gp[lane * 16 + dir * 4 + hh], lf = Gp[lane * 16 + 8 + dir * 4 + hh];
        const float pre = wave_incl_scan_dpp(lf); const float total = __int_as_float(__builtin_amdgcn_readlane(__float_as_int(pre), 63));
        const float bt = dir ? (total - pre + lf) : pre; const float uu = li - bt;
        float pm;
        if (dir == 0) pm = wave_incl_max_dpp(uu); else pm = __shfl(wave_incl_max_dpp(__shfl(uu, 63 - lane)), 63 - lane);
        const float mprev = Mst[dir ? sid1 : sid0]; const float a = bt + mprev; const float mt = fmaxf(a, bt + pm);
        FL[(0 + 2 * dir) * 64 + lane] = bt - mt; FL[(1 + 2 * dir) * 64 + lane] = uu; FL[(4 + dir) * 64 + lane] = __expf(a - mt); FL[(6 + dir) * 64 + lane] = __expf(-mt);
    }
    {
        const bf16* QKm = (const bf16*)(p.ws + WS_QKM); const float* cwl = p.conv_w + (size_t)layer * 5 * 1024;
#pragma unroll
        for (int it4 = 0; it4 < 4; ++it4) { const int it = tid + it4 * NTHR; const int mat = it >> 10, rem = it & 1023, tok = rem >> 4, dg = rem & 15; const int col = mat * 512 + hh * 128 + 8 * dg;
            float a8[8];
#pragma unroll
            for (int j = 0; j < 8; ++j) a8[j] = 0.f;
#pragma unroll
            for (int t = 0; t < 5; ++t) { const int tt = tok0 + tok + t - 2;
                if (tt >= 0 && tt < SEQ) { const u32x4 xx = *(const u32x4*)(QKm + (size_t)(b * SEQ + tt) * 1024 + col);
                    const f32x4 w0 = *(const f32x4*)(cwl + t * 1024 + col), w1 = *(const f32x4*)(cwl + t * 1024 + col + 4);
                    a8[0] = fmaf(w0[0], bflo(xx.x), a8[0]); a8[1] = fmaf(w0[1], bfhi(xx.x), a8[1]); a8[2] = fmaf(w0[2], bflo(xx.y), a8[2]); a8[3] = fmaf(w0[3], bfhi(xx.y), a8[3]);
                    a8[4] = fmaf(w1[0], bflo(xx.z), a8[4]); a8[5] = fmaf(w1[1], bfhi(xx.z), a8[5]); a8[6] = fmaf(w1[2], bflo(xx.w), a8[6]); a8[7] = fmaf(w1[3], bfhi(xx.w), a8[7]); } }
            const float sc = mat ? 0.08838834764831845f : 1.0f;
#pragma unroll
            for (int j = 0; j < 8; ++j) a8[j] = a8[j] * __builtin_amdgcn_rcpf(1.0f + __expf(-a8[j])) * sc;
            u32x4 w; w.x = pk2(a8[0], a8[1]); w.y = pk2(a8[2], a8[3]); w.z = pk2(a8[4], a8[5]); w.w = pk2(a8[6], a8[7]);
            *(LAS u32x4*)(lds + (mat ? KS_OFF : QS_OFF) + tok * QPITCH + dg * 16) = w; }
    }
    __syncthreads();
    if (wave < 2) {
        const float* np = Nst + (wave ? sid1 : sid0) * 128; float acc = 0.f;
#pragma unroll
        for (int dg = 0; dg < 16; ++dg) { const u32x4 xx = *(const LAS u32x4*)(lds + QS_OFF + lane * QPITCH + dg * 16); const f32x4 n0 = *(const f32x4*)(np + 8 * dg), n1 = *(const f32x4*)(np + 8 * dg + 4);
            acc += bflo(xx.x) * n0[0] + bfhi(xx.x) * n0[1] + bflo(xx.y) * n0[2] + bfhi(xx.y) * n0[3] + bflo(xx.z) * n1[0] + bfhi(xx.z) * n1[1] + bflo(xx.w) * n1[2] + bfhi(xx.w) * n1[3]; }
        FL[(16 + wave) * 64 + lane] = acc;
    }
    {
        const int st = wave >> 1, tt0 = 2 * (wave & 1); const f32x4 z4 = {0.f, 0.f, 0.f, 0.f};
        bf16x8 ka[4];
#pragma unroll
        for (int ks = 0; ks < 4; ++ks) ka[ks] = *(const LAS bf16x8*)(lds + KS_OFF + (16 * st + fr) * QPITCH + (32 * ks + 8 * fq) * 2);
#pragma unroll
        for (int q = 0; q < 2; ++q) { const int t = 16 * (tt0 + q) + fr; f32x4 s = z4;
#pragma unroll
            for (int ks = 0; ks < 4; ++ks) { const bf16x8 qb = *(const LAS bf16x8*)(lds + QS_OFF + t * QPITCH + (32 * ks + 8 * fq) * 2); s = MFMA16(ka[ks], qb, s); }
            const float cf = FL[0 * 64 + t], cb = FL[2 * 64 + t]; float pf[4], pb[4]; float rf = 0.f, rb = 0.f;
#pragma unroll
            for (int j = 0; j < 4; ++j) { const int si = 16 * st + 4 * fq + j; const float uf = FL[1 * 64 + si], ub = FL[3 * 64 + si];
                pf[j] = (si <= t) ? s[j] * __expf(cf + uf) : 0.f; pb[j] = (si >= t) ? s[j] * __expf(cb + ub) : 0.f; rf += pf[j]; rb += pb[j]; }
            u32x2 w; w.x = pk2(pf[0], pf[1]); w.y = pk2(pf[2], pf[3]); *(LAS u32x2*)(lds + PF_OFF + t * PPITCH + (16 * st + 4 * fq) * 2) = w;
            w.x = pk2(pb[0], pb[1]); w.y = pk2(pb[2], pb[3]); *(LAS u32x2*)(lds + PB_OFF + t * PPITCH + (16 * st + 4 * fq) * 2) = w;
            rf += __shfl_xor(rf, 16); rf += __shfl_xor(rf, 32); rb += __shfl_xor(rb, 16); rb += __shfl_xor(rb, 32);
            if (fq == 0) { FL[(8 + st) * 64 + t] = rf; FL[(12 + st) * 64 + t] = rb; } }
    }
    __syncthreads();
    f32x4 aI[2][4], aX[2][4];
    {
        const f32x4 z4 = {0.f, 0.f, 0.f, 0.f};
#pragma unroll
        for (int d = 0; d < 2; ++d)
#pragma unroll
            for (int tt = 0; tt < 4; ++tt) { aI[d][tt] = z4; aX[d][tt] = z4; }
#pragma unroll
        for (int ks = 0; ks < 2; ++ks) { const bf16x8 va = vaf[ks];
#pragma unroll
            for (int tt = 0; tt < 4; ++tt) { const bf16x8 pfb = *(const LAS bf16x8*)(lds + PF_OFF + (16 * tt + fr) * PPITCH + (32 * ks + 8 * fq) * 2);
                const bf16x8 pbb = *(const LAS bf16x8*)(lds + PB_OFF + (16 * tt + fr) * PPITCH + (32 * ks + 8 * fq) * 2);
                aI[0][tt] = MFMA16(va, pfb, aI[0][tt]); aI[1][tt] = MFMA16(va, pbb, aI[1][tt]); } }
#pragma unroll
        for (int d = 0; d < 2; ++d) {
#pragma unroll
            for (int kk = 0; kk < 4; ++kk) { const bf16x8 ca = caf[d][kk];
#pragma unroll
                for (int tt = 0; tt < 4; ++tt) { const bf16x8 qb = *(const LAS bf16x8*)(lds + QS_OFF + (16 * tt + fr) * QPITCH + (32 * kk + 8 * fq) * 2); aX[d][tt] = MFMA16(ca, qb, aX[d][tt]); } } }
    }
    f32x4 hs[4];
#pragma unroll
    for (int tt = 0; tt < 4; ++tt) { const int t = 16 * tt + fr; const f32x4 z4 = {0.f, 0.f, 0.f, 0.f}; hs[tt] = z4;
#pragma unroll
        for (int d = 0; d < 2; ++d) { const float in = FL[(4 + d) * 64 + t]; const float den = ((FL[(8 + 4 * d) * 64 + t] + FL[(9 + 4 * d) * 64 + t]) + (FL[(10 + 4 * d) * 64 + t] + FL[(11 + 4 * d) * 64 + t])) + in * FL[(16 + d) * 64 + t];
            const float rd = 1.0f / fmaxf(fabsf(den), FL[(6 + d) * 64 + t]); hs[tt] += (aI[d][tt] + aX[d][tt] * in) * rd; }
        float sq = (hs[tt][0] * hs[tt][0] + hs[tt][1] * hs[tt][1]) + (hs[tt][2] * hs[tt][2] + hs[tt][3] * hs[tt][3]);
        sq += __shfl_xor(sq, 16); sq += __shfl_xor(sq, 32);
        if (fq == 0) FL[(18 + wave) * 64 + t] = sq; }
    __syncthreads();
    {
        const f32x4 hg = *(const f32x4*)(p.head_norm_g + layer * 512 + hh * 128 + 16 * wave + 4 * fq);
#pragma unroll
        for (int tt = 0; tt < 4; ++tt) { const int t = 16 * tt + fr; const float ssq = ((FL[18 * 64 + t] + FL[19 * 64 + t]) + (FL[20 * 64 + t] + FL[21 * 64 + t])) + ((FL[22 * 64 + t] + FL[23 * 64 + t]) + (FL[24 * 64 + t] + FL[25 * 64 + t])); const float rsd = rsqrtf(ssq * (1.0f / 128.0f) + 1e-6f);
            bf16* yp = (bf16*)(p.ws + WS_Y) + (size_t)(b * SEQ + tok0 + t) * 1024 + hh * 128 + 16 * wave + 4 * fq;
            const u32x2 gt = *(const u32x2*)yp;
            u32x2 w; w.x = pk2(hs[tt][0] * rsd * hg[0] * bflo(gt.x), hs[tt][1] * rsd * hg[1] * bfhi(gt.x)); w.y = pk2(hs[tt][2] * rsd * hg[2] * bflo(gt.y), hs[tt][3] * rsd * hg[3] * bfhi(gt.y));
            *(u32x2*)yp = w; }
    }
    __syncthreads();
}

#define XB_TMO      128
#define XB_XCNT(j)  (256  + 64 * (j))
#define XB_XSUB(j)  (1280 + 64 * (j))
#define XB_XGEN(j)  (2304 + 64 * (j))
#define XB_TOP      3328
#define XB_TOPGEN   3392
#define XCD_BAR_WORDS 3456
#define XB_SPIN_CAP (1u << 18)

__device__ __forceinline__ unsigned xb_ld(unsigned* p)              { return __hip_atomic_load(p, __ATOMIC_RELAXED, __HIP_MEMORY_SCOPE_AGENT); }
__device__ __forceinline__ unsigned xb_add(unsigned* p, unsigned v) { return __hip_atomic_fetch_add(p, v, __ATOMIC_RELAXED, __HIP_MEMORY_SCOPE_AGENT); }
__device__ __forceinline__ unsigned xb_xcc_id() { return (unsigned)__builtin_amdgcn_s_getreg((3 << 11) | 20) & 0xFu; }
#define XB_SPIN(cond, bar) do { unsigned _sp = 0; while (cond) { __builtin_amdgcn_s_sleep(1); \
    if ((++_sp & 255u) == 0u) { if (xb_ld(&(bar)[XB_TMO])) break; if (_sp > XB_SPIN_CAP) { atomicAdd(&(bar)[XB_TMO], 1u); break; } } } } while (0)

struct XcdBarrier {
    unsigned* bar; unsigned x;
    volatile LAS unsigned* st;
};

__device__ __forceinline__ XcdBarrier xcd_barrier_post(unsigned* bar, volatile LAS unsigned* st) {
    XcdBarrier b; b.bar = bar; b.x = xb_xcc_id(); b.st = st;
    if (threadIdx.x == 0) (void)xb_add(&bar[XB_XCNT(b.x)], 1u);
    return b;
}
__device__ __forceinline__ void xcd_barrier_complete(unsigned* bar, unsigned x, unsigned& nloc, unsigned& nx) {
    const unsigned G = gridDim.x * gridDim.y * gridDim.z;
    unsigned sum, cnt, mine, sp = 0u;
    for (;;) {
        sum = 0u; cnt = 0u; mine = 0u;
#pragma unroll
        for (unsigned j = 0; j < 16; ++j) { const unsigned c = xb_ld(&bar[XB_XCNT(j)]); sum += c; cnt += (c > 0u) ? 1u : 0u; mine = (j == x) ? c : mine; }
        if (sum == G) break;
        __builtin_amdgcn_s_sleep(1);
        if ((++sp & 255u) == 0u) { if (xb_ld(&bar[XB_TMO])) break; if (sp > XB_SPIN_CAP) { atomicAdd(&bar[XB_TMO], 1u); break; } }
    }
    nloc = mine > 0u ? mine : 1u; nx = cnt > 0u ? cnt : 1u;
}

__device__ __forceinline__ void xcd_barrier(const XcdBarrier& b) {
    asm volatile("s_waitcnt vmcnt(0)" ::: "memory");
    __syncthreads();
    if (threadIdx.x == 0) {
        unsigned* bar = b.bar;
        __builtin_amdgcn_s_waitcnt(0);
        unsigned nloc = b.st[0], nx = b.st[1];
        if (nloc == 0u) { xcd_barrier_complete(bar, b.x, nloc, nx); b.st[0] = nloc; b.st[1] = nx; }
        const unsigned old = xb_add(&bar[XB_XSUB(b.x)], 1u);
        const unsigned gen = old / nloc;
        if (old + 1u == (gen + 1u) * nloc) {
            __builtin_amdgcn_fence(__ATOMIC_RELEASE, "agent");
            asm volatile("s_waitcnt vmcnt(0)" ::: "memory");
            const unsigned og = xb_add(&bar[XB_TOP], 1u);
            const unsigned tg = og / nx;
            if (og + 1u == (tg + 1u) * nx) xb_add(&bar[XB_TOPGEN], 1u);
            else XB_SPIN(xb_ld(&bar[XB_TOPGEN]) == tg, bar);
            __builtin_amdgcn_fence(__ATOMIC_ACQUIRE, "agent");
            xb_add(&bar[XB_XGEN(b.x)], 1u);
            asm volatile("s_waitcnt vmcnt(0)" ::: "memory");
        } else {
            XB_SPIN(xb_ld(&bar[XB_XGEN(b.x)]) == gen, bar);
            __builtin_amdgcn_fence(__ATOMIC_ACQUIRE, "agent");
            asm volatile("s_waitcnt vmcnt(0)" ::: "memory");
        }
    }
    __syncthreads();
}

__global__ void __launch_bounds__(NTHR, 2) fwd_megakernel(Params p) {
    extern __shared__ __attribute__((aligned(16))) unsigned char lds_raw[];
    LAS unsigned char* lds = (LAS unsigned char*)lds_raw;
    cg::grid_group grid = cg::this_grid();
#define GRID_SYNC_CG() do { asm volatile("s_waitcnt vmcnt(0) lgkmcnt(0)" ::: "memory"); grid.sync(); \
        __builtin_amdgcn_fence(__ATOMIC_ACQUIRE, "agent"); asm volatile("s_waitcnt vmcnt(0)" ::: "memory"); __syncthreads(); } while (0)
#define GRID_SYNC() do { XcdBarrier xb_; xb_.bar = (unsigned*)(p.ws + WS_CTL); xb_.x = xb_xcc_id(); xb_.st = (volatile LAS unsigned*)(lds + LDS_MISC); xcd_barrier(xb_); } while (0)
    const int tid = threadIdx.x, lane = tid & 63, wave = __builtin_amdgcn_readfirstlane(tid >> 6), G = gridDim.x, bid = blockIdx.x;
    const int vcu = (G % 8 == 0) ? (bid % 8) * (G / 8) + bid / 8 : bid;
    float* ss = (float*)(p.ws + WS_SSP);
    { volatile LAS unsigned* st0 = (volatile LAS unsigned*)(lds + LDS_MISC); if (threadIdx.x < 2) st0[threadIdx.x] = 0u; __syncthreads(); }
    (void)xcd_barrier_post((unsigned*)(p.ws + WS_CTL), (volatile LAS unsigned*)(lds + LDS_MISC));
    bf16* xb = (bf16*)(p.ws + WS_XB);

    const bool defer = (G == 256);
    p0_prologue(p, lds, wave, lane, G, defer ? -1 : 2 * I_L);
    if (G == 0x7fffffff) GRID_SYNC_CG();
    GRID_SYNC();

    for (int layer = 0; layer < 2; ++layer) {
#define RELANE() int tid = threadIdx.x; asm volatile("" : "+v"(tid)); const int lane = tid & 63, wave = __builtin_amdgcn_readfirstlane(tid >> 6)
        {
            pg8::Gemm g{xb, (const bf16*)(p.ws + WS_WIN) + (size_t)layer * NINP * DM, MROWS, NINP, DM};
            pg8::StaticOrder S; S.init(MROWS, NINP, G, bid);
            pg8::EpiIn E{ss + (size_t)(2 * layer) * MROWS * 16, p.ws, p.gate_i_b + layer * 8, p.gate_f_b + layer * 8};
            static_assert(pg8::EpiIn::O_ROPE == WS_ROPE && pg8::EpiIn::O_G == WS_G && pg8::EpiIn::O_QKM == WS_QKM && pg8::EpiIn::O_KTM == WS_KTM && pg8::EpiIn::O_VTM == WS_VTM && pg8::EpiIn::O_AK == WS_AK && pg8::EpiIn::O_VT16 == WS_VT16 && pg8::EpiIn::O_Y == WS_Y, "ws map");
            pg8::gemm_phase<pg8::EpiIn, pg8::StaticOrder, true, true>(lds, g, S, E);
            if (defer && bid >= 192) { RELANE(); LAS float* scr = (LAS float*)(lds + wave * 16384);
                for (int it = layer * I_L + I_IN + I_OUT + (bid - 192) * NWAVE + wave; it < (layer + 1) * I_L; it += 64 * NWAVE) convert_item(p, it, scr, lane); }
        }
        GRID_SYNC();
        {
            RELANE();
            volatile LAS unsigned* ctr = (volatile LAS unsigned*)(lds + LDS_MISC + 16);
            if (tid == 0) *ctr = 0u;
            const int nU = (512 - vcu + G - 1) / G;
            const bool fast = (G * 2 == 512);
            if (fast && wave < 2) {
                __builtin_amdgcn_s_setprio(3);
                scan_wave(p, layer, vcu * 2 + wave, (LAS float*)(lds + wave * 256), lane, true);
                __builtin_amdgcn_s_setprio(0);
            } else {
                const int w0 = fast ? 2 : 0, nw = fast ? 6 : NWAVE;
                for (int I = wave - w0; I < 4 * nU; I += nw) { const int au = vcu + G * (I >> 2); const int b = au >> 6, h = (au >> 3) & 7, p0 = (au & 7) * 256;
                    attn_quad_d1(p, b, h, (p0 >> 4) + 4 * (I & 3), lane); }
                asm volatile("s_waitcnt vmcnt(0)" ::: "memory");
                __syncthreads();
                if (!fast && wave < 2) for (int sw = vcu * 2 + wave; sw < 512; sw += G * 2) scan_wave(p, layer, sw, (LAS float*)(lds + wave * 256), lane, false);
            }
            {
                const int nQ = 8 * nU;
                for (;;) { unsigned Q = 0; if (lane == 0) Q = atomicAdd((unsigned*)(lds_raw + LDS_MISC + 16), 1u); Q = (unsigned)__builtin_amdgcn_readfirstlane((int)Q);
                    if ((int)Q >= nQ) break;
                    const int au = vcu + G * (int)(Q >> 3); const int b = au >> 6, h = (au >> 3) & 7, p0 = (au & 7) * 256; attn_pair(p, b, h, p0, (int)((Q & 3) + 8 * ((Q >> 2) & 1)), lane); }
            }
        }
        GRID_SYNC();
        { RELANE(); for (int u = vcu; u < 1024; u += G) mout_unit(p, layer, u, lds, tid, wave, lane); }
        GRID_SYNC();
        {
            pg8::Gemm g{(const bf16*)(p.ws + WS_Y), (const bf16*)(p.ws + WS_WOUT) + (size_t)layer * DM * DM, MROWS, DM, DM};
            pg8::StaticOrder S; S.init(MROWS, DM, G, bid);
            pg8::EpiRes E{xb, ss + (size_t)(2 * layer + 1) * MROWS * 16};
            pg8::gemm_phase<pg8::EpiRes, pg8::StaticOrder, true, true>(lds, g, S, E);
        }
        GRID_SYNC();
        {
            pg8::Gemm g{xb, (const bf16*)(p.ws + WS_WUP) + (size_t)layer * FF * DM, MROWS, FF, DM};
            pg8::StaticOrder S; S.init(MROWS, FF, G, bid);
            pg8::EpiUp E{ss + (size_t)(2 * layer + 1) * MROWS * 16, (bf16*)(p.ws + WS_U)};
            pg8::gemm_phase<pg8::EpiUp, pg8::StaticOrder, true, true>(lds, g, S, E);
        }
        GRID_SYNC();
        {
            pg8::Gemm g{(const bf16*)(p.ws + WS_U), (const bf16*)(p.ws + WS_WDN) + (size_t)layer * DM * FF, MROWS, DM, FF};
            pg8::StaticOrder S; S.init(MROWS, DM, G, bid);
            pg8::EpiRes E{xb, ss + (size_t)(2 * layer + 2) * MROWS * 16};
            pg8::gemm_phase<pg8::EpiRes, pg8::StaticOrder, true, true>(lds, g, S, E);
        }
        GRID_SYNC();
    }
    {
        RELANE();
        const int gw = bid * NWAVE + wave, NGW = G * NWAVE;
        for (int m = gw; m < MROWS; m += NGW) { const float rsd = rsqrtf(pg8::row_ss(ss + (size_t)4 * MROWS * 16, m) * (1.0f / 1024.0f) + 1e-6f);
            const u32x2* xr = (const u32x2*)(xb + (size_t)m * DM) + lane; f32x4* orow = (f32x4*)(p.out + (size_t)m * DM) + lane; const f32x4* gr = (const f32x4*)p.final_g + lane;
#pragma unroll
            for (int j = 0; j < 4; ++j) { const u32x2 w = __builtin_nontemporal_load(xr + 64 * j); const f32x4 g4 = gr[64 * j]; f32x4 o; o[0] = bflo(w.x) * rsd * g4[0]; o[1] = bfhi(w.x) * rsd * g4[1]; o[2] = bflo(w.y) * rsd * g4[2]; o[3] = bfhi(w.y) * rsd * g4[3]; __builtin_nontemporal_store(o, orow + 64 * j); } }
    }
}

extern "C" void kernel_launch(void* const* d_in, const int* in_sizes, int n_in, void* d_out, int out_size, void* d_ws, size_t ws_size, hipStream_t stream) {
    static int grid = 0;
    if (grid == 0) {
        int dev = 0, cus = 0, per_cu = 0;
        (void)hipGetDevice(&dev);
        (void)hipDeviceGetAttribute(&cus, hipDeviceAttributeMultiprocessorCount, dev);
        (void)hipFuncSetAttribute((const void*)fwd_megakernel, hipFuncAttributeMaxDynamicSharedMemorySize, LDS_BYTES);
        (void)hipOccupancyMaxActiveBlocksPerMultiprocessor(&per_cu, (const void*)fwd_megakernel, NTHR, LDS_BYTES);
        if (per_cu < 1) per_cu = 1;
        grid = cus * per_cu;
        if (ws_size < WS_END) { fprintf(stderr, "kernel_launch: workspace too small (%zu)\n", ws_size); grid = -1; }
    }
    if (grid < 0) return;
    Params p{};
    p.x = (const float*)d_in[0]; p.norm1_g = (const float*)d_in[1]; p.w_in = (const float*)d_in[2]; p.conv_w = (const float*)d_in[3];
    p.gate_i_b = (const float*)d_in[4]; p.gate_f_b = (const float*)d_in[5]; p.head_norm_g = (const float*)d_in[6]; p.w_out = (const float*)d_in[7];
    p.norm2_g = (const float*)d_in[8]; p.w_up = (const float*)d_in[9]; p.w_down = (const float*)d_in[10]; p.final_g = (const float*)d_in[11];
    p.out = (float*)d_out; p.ws = (unsigned char*)d_ws;
    (void)hipMemsetAsync((char*)d_ws + WS_CTL, 0, CTL_BYTES, stream);
    void* args[] = {&p};
    hipError_t e = hipLaunchCooperativeKernel((void*)fwd_megakernel, dim3(grid), dim3(NTHR), args, LDS_BYTES, stream);
    if (e != hipSuccess) fprintf(stderr, "cooperative launch failed: %s (grid %d)\n", hipGetErrorString(e), grid);
}
```

```cpp
#include <hip/hip_runtime.h>
#include <hip/hip_cooperative_groups.h>
#include <cstdio>
#include <cstdint>
#include <cmath>
namespace cg = cooperative_groups;
namespace pg8 {
#define PG8_LAS __attribute__((address_space(3)))
typedef unsigned short bf16_t;
typedef short bf16x8 __attribute__((ext_vector_type(8)));
typedef float f32x4 __attribute__((ext_vector_type(4)));
typedef unsigned u32x4 __attribute__((ext_vector_type(4)));
constexpr int BM = 256, BK = 64, HALF = 128, HTB = HALF * BK * 2  , STAGE_BYTES = 8 * HTB, NXCD = 8, WGM = 4;

__host__ __device__ __forceinline__ int lds_byte(int r, int c) { const int st = (r >> 4) * 2 + (c >> 5), rr = r & 15, cc = c & 31, ob = rr * 64 + cc * 2; return st * 1024 + (ob ^ (((ob >> 9) & 1) << 5)); }
__host__ __device__ __forceinline__ void stage_rc(int b, int& R, int& C) { const int st = b / 1024, sb = b % 1024, swz = sb ^ (((sb >> 9) & 1) << 5); R = (st >> 1) * 16 + swz / 64; C = (st & 1) * 32 + (swz % 64) / 2; }
__host__ __device__ __forceinline__ int perm32(int rho) { const int n = rho >> 4, i = rho & 15; return 8 * (i >> 2) + 4 * n + (i & 3); }

struct Unit { int pm, pn; };
struct Gemm { const bf16_t* A; const bf16_t* Bt; int M, N, K; };

struct StaticOrder {
    int nM, nN, nwg, G, c;
    __host__ __device__ void init(int M, int N, int G_, int c_) { nM = M / BM; nN = N / BM; nwg = nM * nN; G = G_; c = c_; }
    __host__ __device__ bool next(int i, Unit& u) const {
        const long L = (long)i * G + c; if (L >= nwg) return false;
        int wgid = (int)L; { const int q = nwg / NXCD, r = nwg % NXCD, xcd = wgid % NXCD, off = wgid / NXCD; wgid = (xcd < r ? xcd * (q + 1) : r * (q + 1) + (xcd - r) * q) + off; }
        const int nig = WGM * nN, gid = wgid / nig, fm = gid * WGM, gsz = (nM - fm) < WGM ? (nM - fm) : WGM;
        u.pm = fm + ((wgid % nig) % gsz); u.pn = (wgid % nig) / gsz; return true;
    }
    __device__ __forceinline__ void a_ready(const Unit&) const {}
    __device__ __forceinline__ void done(const Unit&) const {}
};

typedef float f32x2c_t __attribute__((ext_vector_type(2))); typedef __bf16 bf16x2c_t __attribute__((ext_vector_type(2)));
__device__ __forceinline__ unsigned cvt_pk_bf16(float lo, float hi) { f32x2c_t v = {lo, hi}; bf16x2c_t b = __builtin_convertvector(v, bf16x2c_t); return __builtin_bit_cast(unsigned, b); }
typedef float f32x2 __attribute__((ext_vector_type(2)));
__device__ __forceinline__ unsigned short bf16_1(float v) { return (unsigned short)(cvt_pk_bf16(v, v) & 0xffffu); }
__device__ __forceinline__ float row_ss(const float* ssp, int row) { const f32x4* q = (const f32x4*)(ssp + (size_t)row * 16); const f32x4 a = q[0], b = q[1], c = q[2], d = q[3];
    return (((a[0] + a[1]) + (a[2] + a[3])) + ((b[0] + b[1]) + (b[2] + b[3]))) + (((c[0] + c[1]) + (c[2] + c[3])) + ((d[0] + d[1]) + (d[2] + d[3]))); }
__device__ __forceinline__ float row_ss_q(const float* ssp, int row, int fq) { const f32x4 a = *(const f32x4*)(ssp + (size_t)row * 16 + 4 * fq); float t = (a[0] + a[1]) + (a[2] + a[3]);
    t += __shfl_xor(t, 16); t += __shfl_xor(t, 32); return t; }
struct EpiIn {
    static constexpr bool PERM = true, AFTER_DRAIN = false;
    const float* ss; unsigned char* ws; const float* gib; const float* gfb;
    static constexpr size_t O_ROPE = 512 * 1024, O_G = 3u << 20, O_QKM = 120u << 20, O_KTM = 152u << 20, O_VTM = 168u << 20, O_AK = 184u << 20, O_VT16 = 200u << 20, O_Y = 216u << 20;
    __device__ __forceinline__ void operator()(const f32x4 (&acc)[2][2][4][2], const Unit& u, int wr, int wc, int fr_, int fq_) const {
        int fr = fr_, fq = fq_; asm volatile("" : "+v"(fr), "+v"(fq));
        const int pn = u.pn;
        const int rbase = u.pm * BM + wr * 64 + fr;
        float rsv[2][4];
#pragma unroll
        for (int ai = 0; ai < 2; ++ai)
#pragma unroll
            for (int m = 0; m < 4; ++m) rsv[ai][m] = row_ss_q(ss, rbase + ai * HALF + m * 16, fq);
#pragma unroll
        for (int ai = 0; ai < 2; ++ai)
#pragma unroll
            for (int m = 0; m < 4; ++m) rsv[ai][m] = rsqrtf(rsv[ai][m] * (1.0f / 1024.0f) + 1e-6f);
        if (pn < 4) {
            bf16_t* QKm = (bf16_t*)(ws + O_QKM);
#pragma unroll
            for (int ai = 0; ai < 2; ++ai)
#pragma unroll
                for (int m = 0; m < 4; ++m) { const int row = rbase + ai * HALF + m * 16; const float r = rsv[ai][m]; bf16_t* rowp = QKm + (size_t)row * 1024 + pn * 256 + wc * 32 + 8 * fq;
#pragma unroll
                    for (int bj = 0; bj < 2; ++bj) { const f32x4 v0 = acc[ai][bj][m][0] * r, v1 = acc[ai][bj][m][1] * r; u32x4 w;
                        w.x = cvt_pk_bf16(v0[0], v0[1]); w.y = cvt_pk_bf16(v0[2], v0[3]); w.z = cvt_pk_bf16(v1[0], v1[1]); w.w = cvt_pk_bf16(v1[2], v1[3]);
                        *(u32x4*)(rowp + bj * HALF) = w; }
                    asm volatile("" ::: "memory"); }
        }
        if ((pn >= 2 && pn < 6)) {
            const int row0 = u.pm * BM; const int b = row0 >> 11;
            unsigned char* ub = ws + ((pn < 4) ? O_KTM : O_VTM) + ((size_t)(((b * 4 + 2 * (pn & 1)) * 128 + wc * 32) * 2048 + (row0 & 2047) + wr * 64)) * 2;
            const unsigned voff = (unsigned)((8 * fq) * 2048 + fr) * 2u;
#pragma unroll
            for (int ai = 0; ai < 2; ++ai)
#pragma unroll
                for (int m = 0; m < 4; m += 2) { const float r0 = rsv[ai][m], r1 = rsv[ai][m + 1];
#pragma unroll
                    for (int bj = 0; bj < 2; ++bj)
#pragma unroll
                        for (int n = 0; n < 2; ++n)
#pragma unroll
                            for (int j = 0; j < 4; ++j) { const unsigned w = cvt_pk_bf16(acc[ai][bj][m][n][j] * r0, acc[ai][bj][m + 1][n][j] * r1);
                                unsigned char* q = ub + (size_t)(((bj * 128 + 4 * n + j) * 2048 + ai * HALF + m * 16) * 2) + voff;
                                *(bf16_t*)q = (bf16_t)(w & 0xffffu); *(bf16_t*)(q + 32) = (bf16_t)(w >> 16); }
                    asm volatile("" ::: "memory"); }
        } else if (pn == 6 || pn == 7) {
            bf16_t* Y = (bf16_t*)(ws + O_Y);
#pragma unroll
            for (int ai = 0; ai < 2; ++ai)
#pragma unroll
                for (int m = 0; m < 4; ++m) { const int row = rbase + ai * HALF + m * 16; const float r = rsv[ai][m]; bf16_t* rowp = Y + (size_t)row * 1024 + (pn - 6) * 256 + wc * 32 + 8 * fq;
#pragma unroll
                    for (int bj = 0; bj < 2; ++bj) { f32x4 v0 = acc[ai][bj][m][0] * r, v1 = acc[ai][bj][m][1] * r;
#pragma unroll
                        for (int j = 0; j < 4; ++j) { v0[j] = __builtin_amdgcn_rcpf(1.0f + __expf(-v0[j])); v1[j] = __builtin_amdgcn_rcpf(1.0f + __expf(-v1[j])); }
                        u32x4 w; w.x = cvt_pk_bf16(v0[0], v0[1]); w.y = cvt_pk_bf16(v0[2], v0[3]); w.z = cvt_pk_bf16(v1[0], v1[1]); w.w = cvt_pk_bf16(v1[2], v1[3]);
                        *(u32x4*)(rowp + bj * HALF) = w; }
                    asm volatile("" ::: "memory"); }
        } else if (pn >= 8 && pn < 12) {
            const bool isk = pn >= 10; const int head = 4 * (pn & 1) + wc; const float qs = isk ? 1.0f : 0.125f * 1.4426950408889634f;
            const float* ropeC = (const float*)(ws + O_ROPE) + 8 * fq; const float* ropeS = ropeC + 2048 * 32;
            f32x4 tb[2][4];
            { const int pos = rbase & 2047; tb[0][0] = *(const f32x4*)(ropeC + pos * 32); tb[0][1] = *(const f32x4*)(ropeC + pos * 32 + 4); tb[0][2] = *(const f32x4*)(ropeS + pos * 32); tb[0][3] = *(const f32x4*)(ropeS + pos * 32 + 4); }
#pragma unroll
            for (int it = 0; it < 8; ++it) { const int ai = it >> 2, m = it & 3; const int row = rbase + ai * HALF + m * 16; const float r = rsv[ai][m] * qs;
                if (it < 7) { const int pos2 = (rbase + ((it + 1) >> 2) * HALF + ((it + 1) & 3) * 16) & 2047;
                    tb[(it + 1) & 1][0] = *(const f32x4*)(ropeC + pos2 * 32); tb[(it + 1) & 1][1] = *(const f32x4*)(ropeC + pos2 * 32 + 4); tb[(it + 1) & 1][2] = *(const f32x4*)(ropeS + pos2 * 32); tb[(it + 1) & 1][3] = *(const f32x4*)(ropeS + pos2 * 32 + 4); }
                const f32x4 c0 = tb[it & 1][0], c1 = tb[it & 1][1], s0 = tb[it & 1][2], s1 = tb[it & 1][3];
                const f32x4 a0 = acc[ai][0][m][0] * r, a1 = acc[ai][0][m][1] * r, b0 = acc[ai][1][m][0] * r, b1 = acc[ai][1][m][1] * r;
                const f32x4 o10 = a0 * c0 - b0 * s0, o11 = a1 * c1 - b1 * s1, o20 = a0 * s0 + b0 * c0, o21 = a1 * s1 + b1 * c1;
                bf16_t* dst = isk ? ((bf16_t*)(ws + O_AK) + (size_t)row * 512 + head * 64 + 8 * fq) : ((bf16_t*)(ws + O_Y) + (size_t)row * 1024 + 512 + head * 64 + 8 * fq);
                u32x4 w; w.x = cvt_pk_bf16(o10[0], o10[1]); w.y = cvt_pk_bf16(o10[2], o10[3]); w.z = cvt_pk_bf16(o11[0], o11[1]); w.w = cvt_pk_bf16(o11[2], o11[3]);
                *(u32x4*)(dst) = w;
                w.x = cvt_pk_bf16(o20[0], o20[1]); w.y = cvt_pk_bf16(o20[2], o20[3]); w.z = cvt_pk_bf16(o21[0], o21[1]); w.w = cvt_pk_bf16(o21[2], o21[3]);
                *(u32x4*)(dst + 32) = w;
                asm volatile("" ::: "memory"); }
        } else if (pn == 12 || pn == 13) {
            const int row0 = u.pm * BM; const int b = row0 >> 11;
            typedef unsigned u32x2v __attribute__((ext_vector_type(2)));
            unsigned char* ub = ws + O_VT16 + ((size_t)((((b * 8 + 4 * (pn - 12) + (wc >> 1)) * 16 * 32 + ((row0 & 2047) >> 6) + wr) * 256) + (wc & 1) * 128)) * 2;
            const unsigned voff = (unsigned)(fr * 32 * 256 + 8 * fq * 4) * 2u;
#pragma unroll
            for (int ai = 0; ai < 2; ++ai) { const float r0 = rsv[ai][0], r1 = rsv[ai][1], r2 = rsv[ai][2], r3 = rsv[ai][3];
#pragma unroll
                for (int bj = 0; bj < 2; ++bj)
#pragma unroll
                    for (int n = 0; n < 2; ++n)
#pragma unroll
                        for (int j = 0; j < 4; ++j) { u32x2v w; w.x = cvt_pk_bf16(acc[ai][bj][0][n][j] * r0, acc[ai][bj][1][n][j] * r1); w.y = cvt_pk_bf16(acc[ai][bj][2][n][j] * r2, acc[ai][bj][3][n][j] * r3);
                            *(u32x2v*)(ub + (size_t)((bj * 262144 + 2 * ai * 256 + (4 * n + j) * 4) * 2) + voff) = w; }
                asm volatile("" ::: "memory"); }
        } else if (pn == 14) {
            if (wc == 0 && fq < 2) {
                float* G = (float*)(ws + O_G);
#pragma unroll
                for (int ai = 0; ai < 2; ++ai)
#pragma unroll
                    for (int m = 0; m < 4; ++m) { const int row = rbase + ai * HALF + m * 16; const float r = rsv[ai][m];
#pragma unroll
                        for (int n = 0; n < 2; ++n) { f32x4 v = acc[ai][0][m][n] * r; f32x4 o;
#pragma unroll
                            for (int j = 0; j < 4; ++j) { const int c8 = 4 * n + j;
                                if (fq == 0) o[j] = v[j] + gib[c8];
                                else { const float x = v[j] + gfb[c8]; o[j] = fminf(x, 0.0f) - __logf(1.0f + __expf(-fabsf(x))); } }
                            *(f32x4*)(G + (size_t)row * 16 + 8 * fq + 4 * n) = o; }
                        asm volatile("" ::: "memory"); }
            }
        }
    }
};
struct EpiRes {
    static constexpr bool PERM = true, AFTER_DRAIN = false;
    bf16_t* xb; float* ssn;
    __device__ __forceinline__ void operator()(const f32x4 (&acc)[2][2][4][2], const Unit& u, int wr, int wc, int fr, int fq) const {
        const int col0 = u.pn * BM + wc * 32 + 8 * fq;
#pragma unroll
        for (int ai = 0; ai < 2; ++ai)
#pragma unroll
            for (int m = 0; m < 4; ++m) { const int row = u.pm * BM + ai * HALF + wr * 64 + m * 16 + fr; bf16_t* rp = xb + (size_t)row * 1024 + col0; float sq = 0.f;
#pragma unroll
                for (int bj = 0; bj < 2; ++bj) { const u32x4 b = *(const u32x4*)(rp + bj * HALF);
                    const f32x4 v0 = acc[ai][bj][m][0], v1 = acc[ai][bj][m][1];
                    const float o0 = __uint_as_float(b.x << 16) + v0[0], o1 = __uint_as_float(b.x & 0xffff0000u) + v0[1], o2 = __uint_as_float(b.y << 16) + v0[2], o3 = __uint_as_float(b.y & 0xffff0000u) + v0[3];
                    const float o4 = __uint_as_float(b.z << 16) + v1[0], o5 = __uint_as_float(b.z & 0xffff0000u) + v1[1], o6 = __uint_as_float(b.w << 16) + v1[2], o7 = __uint_as_float(b.w & 0xffff0000u) + v1[3];
                    u32x4 w; w.x = cvt_pk_bf16(o0, o1); w.y = cvt_pk_bf16(o2, o3); w.z = cvt_pk_bf16(o4, o5); w.w = cvt_pk_bf16(o6, o7);
                    *(u32x4*)(rp + bj * HALF) = w;
                    sq += ((o0 * o0 + o1 * o1) + (o2 * o2 + o3 * o3)) + ((o4 * o4 + o5 * o5) + (o6 * o6 + o7 * o7)); }
                sq += __shfl_xor(sq, 16); sq += __shfl_xor(sq, 32);
                if (fq == 0) ssn[(size_t)row * 16 + u.pn * 4 + wc] = sq; }
    }
};
struct EpiUp {
    static constexpr bool PERM = true, AFTER_DRAIN = false;
    const float* ss; bf16_t* U;
    __device__ __forceinline__ void operator()(const f32x4 (&acc)[2][2][4][2], const Unit& u, int wr, int wc, int fr, int fq) const {
        const int rbase = u.pm * BM + wr * 64 + fr;
        float rsv[2][4];
#pragma unroll
        for (int ai = 0; ai < 2; ++ai)
#pragma unroll
            for (int m = 0; m < 4; ++m) rsv[ai][m] = row_ss_q(ss, rbase + ai * HALF + m * 16, fq);
#pragma unroll
        for (int ai = 0; ai < 2; ++ai)
#pragma unroll
            for (int m = 0; m < 4; ++m) { const int row = rbase + ai * HALF + m * 16; const float r = rsqrtf(rsv[ai][m] * (1.0f / 1024.0f) + 1e-6f);
                bf16_t* rowp = U + (size_t)row * 4096 + u.pn * BM + wc * 32 + 8 * fq;
#pragma unroll
                for (int bj = 0; bj < 2; ++bj) { f32x4 v0 = acc[ai][bj][m][0] * r, v1 = acc[ai][bj][m][1] * r;
#pragma unroll
                    for (int j = 0; j < 4; ++j) { v0[j] = fmaxf(v0[j], 0.f); v0[j] *= v0[j]; v1[j] = fmaxf(v1[j], 0.f); v1[j] *= v1[j]; }
                    u32x4 w; w.x = cvt_pk_bf16(v0[0], v0[1]); w.y = cvt_pk_bf16(v0[2], v0[3]); w.z = cvt_pk_bf16(v1[0], v1[1]); w.w = cvt_pk_bf16(v1[2], v1[3]);
                    *(u32x4*)(rowp + bj * HALF) = w; } }
    }
};
template <class Epi, class Sched, bool ALIGN_EPI = false, bool SP2 = false>
__device__ __forceinline__ void gemm_phase(PG8_LAS unsigned char* lds, const Gemm g, const Sched& S, const Epi& E) {
    int tid_ = threadIdx.x; asm volatile("" : "+v"(tid_));
    const int tid = tid_, wid = __builtin_amdgcn_readfirstlane(tid >> 6), lane = tid & 63, wr = wid >> 2, wc = wid & 3, fr = lane & 15, fq = lane >> 4;
    const int K = g.K, nt = K / BK;
    unsigned voffA[2], voffB[2];
#pragma unroll
    for (int i = 0; i < 2; ++i) { int R, C; stage_rc(tid * 16 + i * 8192, R, C); const int Rb = Epi::PERM ? ((R & ~31) + perm32(R & 31)) : R;
        voffA[i] = (unsigned)(R * K + C) * 2u; voffB[i] = (unsigned)(Rb * K + C) * 2u; }
    const size_t kstep = (size_t)(BK * 2);
    const size_t hstep = (size_t)HALF * K * 2;
    const size_t tstep = 2 * hstep;
    const unsigned ldsw = (unsigned)wid * 1024u;
    const int aoff = lds_byte(wr * 64 + fr, fq * 8), boff = lds_byte(wc * 32 + fr, fq * 8);
#define PG8_SA(b, h) (((b) * 2 + (h)) * HTB)
#define PG8_SB(b, h) ((4 + (b) * 2 + (h)) * HTB)
#define PG8_STAGE(bufoff, gbase, voff) do { _Pragma("unroll") for (int _i = 0; _i < 2; ++_i) \
        __builtin_amdgcn_global_load_lds((const unsigned*)((const char*)(gbase) + (voff)[_i]), (PG8_LAS unsigned*)(lds + (bufoff) + ldsw + _i * 8192), 16, 0, 0); } while (0)
#define PG8_LDA(dst, b, h) do { _Pragma("unroll") for (int m = 0; m < 4; ++m) _Pragma("unroll") for (int k = 0; k < 2; ++k) dst[m][k] = *(const PG8_LAS bf16x8*)(lds + PG8_SA(b, h) + aoff + m * 2048 + k * 1024); } while (0)
#define PG8_LDB(dst, b, h) do { _Pragma("unroll") for (int n = 0; n < 2; ++n) _Pragma("unroll") for (int k = 0; k < 2; ++k) dst[n][k] = *(const PG8_LAS bf16x8*)(lds + PG8_SB(b, h) + boff + n * 2048 + k * 1024); } while (0)
#define PG8_MMA(ai, bj, At, Bt) do { __builtin_amdgcn_s_setprio(1); _Pragma("unroll") for (int m = 0; m < 4; ++m) _Pragma("unroll") for (int n = 0; n < 2; ++n) _Pragma("unroll") for (int k = 0; k < 2; ++k) \
        acc[ai][bj][m][n] = __builtin_amdgcn_mfma_f32_16x16x32_bf16(Bt[n][k], At[m][k], acc[ai][bj][m][n], 0, 0, 0); __builtin_amdgcn_s_setprio(0); } while (0)
#define PG8_WAIT_V(n) asm volatile("s_waitcnt vmcnt(" #n ")" ::: "memory")
#define PG8_WAIT_L(n) asm volatile("s_waitcnt lgkmcnt(" #n ")" ::: "memory")
#define PG8_BAR __builtin_amdgcn_s_barrier()
#define PG8_SCHED __builtin_amdgcn_sched_barrier(0)
    Unit cur, nxt; int ui = 0;
    if (!S.next(0, cur)) return;
    f32x4 acc[2][2][4][2];
#pragma unroll
    for (int a = 0; a < 2; ++a)
#pragma unroll
        for (int b = 0; b < 2; ++b)
#pragma unroll
            for (int m = 0; m < 4; ++m)
#pragma unroll
                for (int n = 0; n < 2; ++n) acc[a][b][m][n] = (f32x4){0.f, 0.f, 0.f, 0.f};
    bf16x8 At[4][2], B0[2][2], B1[2][2];
    const char* cA = (const char*)g.A + (size_t)cur.pm * tstep; const char* cB = (const char*)g.Bt + (size_t)cur.pn * tstep;
    S.a_ready(cur);
    if constexpr (SP2) {
        PG8_STAGE(PG8_SB(0, 0), cB, voffB); PG8_STAGE(PG8_SB(0, 1), cB + hstep, voffB); PG8_STAGE(PG8_SA(0, 0), cA, voffA); PG8_STAGE(PG8_SA(0, 1), cA + hstep, voffA);
        if (wr == 1) PG8_BAR;
        PG8_WAIT_V(2); PG8_BAR;
        PG8_STAGE(PG8_SB(1, 0), cB + kstep, voffB); PG8_STAGE(PG8_SA(1, 0), cA + kstep, voffA); PG8_STAGE(PG8_SB(1, 1), cB + hstep + kstep, voffB);
        PG8_WAIT_V(6); PG8_BAR;
    } else {
        PG8_STAGE(PG8_SB(0, 0), cB, voffB); PG8_STAGE(PG8_SA(0, 0), cA, voffA); PG8_STAGE(PG8_SB(0, 1), cB + hstep, voffB); PG8_STAGE(PG8_SA(0, 1), cA + hstep, voffA);
        if (wr == 1) PG8_BAR;
        PG8_WAIT_V(4); PG8_BAR;
        PG8_STAGE(PG8_SB(1, 0), cB + kstep, voffB); PG8_STAGE(PG8_SA(1, 0), cA + kstep, voffA); PG8_STAGE(PG8_SB(1, 1), cB + hstep + kstep, voffB);
        PG8_WAIT_V(6); PG8_BAR;
    }
    for (;;) {
        const bool has_next = S.next(ui + 1, nxt);
        const char* nA = has_next ? (const char*)g.A + (size_t)nxt.pm * tstep : cA; const char* nB = has_next ? (const char*)g.Bt + (size_t)nxt.pn * tstep : cB;
        for (int t = 0; t < nt; t += 2) {
            const bool last = (t == nt - 2);
            const char* a1 = cA + (size_t)(t + 1) * kstep;
            const char* a2 = last ? nA : cA + (size_t)(t + 2) * kstep; const char* b2 = last ? nB : cB + (size_t)(t + 2) * kstep;
            const char* a3 = a2 + kstep; const char* b3 = b2 + kstep;
            if (last && has_next) S.a_ready(nxt);
            if constexpr (SP2) {
            PG8_LDB(B0, 0, 0); PG8_LDB(B1, 0, 1); PG8_SCHED; PG8_LDA(At, 0, 0); PG8_STAGE(PG8_SA(1, 1), a1 + hstep, voffA);
            PG8_WAIT_V(8); PG8_WAIT_L(0); PG8_BAR; PG8_MMA(0, 0, At, B0); PG8_MMA(0, 1, At, B1); PG8_BAR; PG8_SCHED;
            PG8_LDA(At, 0, 1); PG8_STAGE(PG8_SB(0, 0), b2, voffB); PG8_STAGE(PG8_SB(0, 1), b2 + hstep, voffB); PG8_STAGE(PG8_SA(0, 0), a2, voffA);
            PG8_WAIT_V(8); PG8_WAIT_L(0); PG8_BAR; PG8_MMA(1, 0, At, B0); PG8_MMA(1, 1, At, B1); PG8_BAR; PG8_SCHED;
            PG8_LDB(B0, 1, 0); PG8_LDB(B1, 1, 1); PG8_SCHED; PG8_LDA(At, 1, 0); PG8_STAGE(PG8_SA(0, 1), a2 + hstep, voffA);
            PG8_WAIT_V(8); PG8_WAIT_L(0); PG8_BAR; PG8_MMA(0, 0, At, B0); PG8_MMA(0, 1, At, B1); PG8_BAR; PG8_SCHED;
            PG8_LDA(At, 1, 1); PG8_STAGE(PG8_SB(1, 0), b3, voffB); PG8_STAGE(PG8_SB(1, 1), b3 + hstep, voffB); PG8_STAGE(PG8_SA(1, 0), a3, voffA);
            PG8_WAIT_V(8); PG8_WAIT_L(0); PG8_BAR; PG8_MMA(1, 0, At, B0); PG8_MMA(1, 1, At, B1); PG8_BAR; PG8_SCHED;
            } else {
            PG8_LDB(B0, 0, 0); PG8_SCHED; PG8_LDA(At, 0, 0); PG8_STAGE(PG8_SA(1, 1), a1 + hstep, voffA);
            PG8_WAIT_L(8); PG8_BAR; PG8_WAIT_L(0); PG8_MMA(0, 0, At, B0); PG8_BAR; PG8_SCHED;
            PG8_LDB(B1, 0, 1); PG8_STAGE(PG8_SB(0, 0), b2, voffB);
            PG8_BAR; PG8_WAIT_L(0); PG8_MMA(0, 1, At, B1); PG8_BAR;
            PG8_LDA(At, 0, 1); PG8_STAGE(PG8_SA(0, 0), a2, voffA);
            PG8_BAR; PG8_WAIT_L(0); PG8_MMA(1, 0, At, B0); PG8_BAR; PG8_SCHED;
            PG8_STAGE(PG8_SB(0, 1), b2 + hstep, voffB);
            PG8_WAIT_V(6); PG8_BAR; PG8_MMA(1, 1, At, B1); PG8_BAR;
            PG8_LDB(B0, 1, 0); PG8_SCHED; PG8_LDA(At, 1, 0); PG8_STAGE(PG8_SA(0, 1), a2 + hstep, voffA);
            PG8_WAIT_L(8); PG8_BAR; PG8_WAIT_L(0); PG8_MMA(0, 0, At, B0); PG8_BAR; PG8_SCHED;
            PG8_LDB(B1, 1, 1); PG8_STAGE(PG8_SB(1, 0), b3, voffB);
            PG8_BAR; PG8_WAIT_L(0); PG8_MMA(0, 1, At, B1); PG8_BAR;
            PG8_LDA(At, 1, 1); PG8_STAGE(PG8_SA(1, 0), a3, voffA);
            PG8_BAR; PG8_WAIT_L(0); PG8_MMA(1, 0, At, B0); PG8_BAR; PG8_SCHED;
            PG8_STAGE(PG8_SB(1, 1), b3 + hstep, voffB);
            PG8_WAIT_V(6); PG8_BAR; PG8_MMA(1, 1, At, B1); PG8_BAR;
            }
        }
        if constexpr (ALIGN_EPI) { if (wr == 0) PG8_BAR; }
        if constexpr (!Epi::AFTER_DRAIN) { E(acc, cur, wr, wc, fr, fq); S.done(cur); }
        if (!has_next) break;
#pragma unroll
        for (int a = 0; a < 2; ++a)
#pragma unroll
            for (int b = 0; b < 2; ++b)
#pragma unroll
                for (int m = 0; m < 4; ++m)
#pragma unroll
                    for (int n = 0; n < 2; ++n) acc[a][b][m][n] = (f32x4){0.f, 0.f, 0.f, 0.f};
        cur = nxt; cA = nA; cB = nB; ++ui;
        if constexpr (ALIGN_EPI) { if (wr == 1) PG8_BAR; }
    }
    PG8_WAIT_V(0);
    if constexpr (!ALIGN_EPI) { if (wr == 0) PG8_BAR; }
    PG8_BAR;
    if constexpr (Epi::AFTER_DRAIN) { E.fused(acc, cur, wr, wc, fr, fq, lds, wid, lane); S.done(cur); }
#undef PG8_SA
#undef PG8_SB
#undef PG8_STAGE
#undef PG8_LDA
#undef PG8_LDB
#undef PG8_MMA
#undef PG8_WAIT_V
#undef PG8_WAIT_L
#undef PG8_BAR
#undef PG8_SCHED
}
}
#define LAS __attribute__((address_space(3)))
typedef unsigned short bf16;
typedef short bf16x8 __attribute__((ext_vector_type(8)));
typedef float f32x4 __attribute__((ext_vector_type(4)));
typedef unsigned u32x4 __attribute__((ext_vector_type(4)));
typedef unsigned u32x2 __attribute__((ext_vector_type(2)));
constexpr int SEQ = 2048, DM = 1024, MROWS = 16384, FF = 4096, NINP = 3840, NINL = 3600, NTHR = 512, NWAVE = 8;
constexpr size_t MiB = 1u << 20;
constexpr size_t WS_SS = 0, WS_ROPE = 512 * 1024, WS_N = 1 * MiB, WS_MST = 2 * MiB, WS_G = 3 * MiB;
constexpr size_t WS_WIN = 4 * MiB, WS_WOUT = 19 * MiB, WS_WUP = 23 * MiB, WS_WDN = 39 * MiB;
constexpr size_t WS_XB = 56 * MiB;
constexpr size_t WS_SSP = 88 * MiB;
constexpr size_t WS_P1O = 93 * MiB, WS_P1ML = 109 * MiB;
constexpr size_t WS_U = 120 * MiB;
constexpr size_t WS_QKM = 120 * MiB, WS_KTM = 152 * MiB, WS_VTM = 168 * MiB, WS_AK = 184 * MiB, WS_VT16 = 200 * MiB, WS_Y = 216 * MiB, WS_END = 248 * MiB;
constexpr size_t WS_CTL = 2 * MiB + 256 * 1024, CTL_BYTES = 16384;
constexpr int LDS_BYTES = 147456, LDS_MISC = 131072 + 320;

struct Params {
    const float *x, *norm1_g, *w_in, *conv_w, *gate_i_b, *gate_f_b, *head_norm_g, *w_out, *norm2_g, *w_up, *w_down, *final_g;
    float* out; unsigned char* ws;
};

__device__ __forceinline__ unsigned pk2(float lo, float hi) { return pg8::cvt_pk_bf16(lo, hi); }
__device__ __forceinline__ float bflo(unsigned w) { return __uint_as_float(w << 16); }
__device__ __forceinline__ float bfhi(unsigned w) { return __uint_as_float(w & 0xffff0000u); }
__device__ __forceinline__ float wave_sum(float v) {
#pragma unroll
    for (int o = 1; o < 64; o <<= 1) v += __shfl_xor(v, o);
    return v;
}
__device__ __forceinline__ float wave_max(float v) {
#pragma unroll
    for (int o = 1; o < 64; o <<= 1) v = fmaxf(v, __shfl_xor(v, o));
    return v;
}
__device__ __forceinline__ float wave_incl_scan(float v, int lane) {
#pragma unroll
    for (int o = 1; o < 64; o <<= 1) { const float t = __shfl_up(v, o); if (lane >= o) v += t; }
    return v;
}

#define DPP_STEP_ADD(v, ctrl, rm) do { const int t_ = __builtin_amdgcn_update_dpp(0, __float_as_int(v), (ctrl), (rm), 0xf, false); v += __int_as_float(t_); } while (0)
#define DPP_STEP_MAX(v, ctrl, rm) do { const int t_ = __builtin_amdgcn_update_dpp((int)0xff800000, __float_as_int(v), (ctrl), (rm), 0xf, false); v = fmaxf(v, __int_as_float(t_)); } while (0)
__device__ __forceinline__ float wave_incl_scan_dpp(float v) {
    DPP_STEP_ADD(v, 0x111, 0xf); DPP_STEP_ADD(v, 0x112, 0xf); DPP_STEP_ADD(v, 0x114, 0xf); DPP_STEP_ADD(v, 0x118, 0xf); DPP_STEP_ADD(v, 0x142, 0xa); DPP_STEP_ADD(v, 0x143, 0xc);
    return v;
}
__device__ __forceinline__ float wave_incl_max_dpp(float v) {
    DPP_STEP_MAX(v, 0x111, 0xf); DPP_STEP_MAX(v, 0x112, 0xf); DPP_STEP_MAX(v, 0x114, 0xf); DPP_STEP_MAX(v, 0x118, 0xf); DPP_STEP_MAX(v, 0x142, 0xa); DPP_STEP_MAX(v, 0x143, 0xc);
    return v;
}
__device__ __forceinline__ float wave_max_dpp(float v) {
    DPP_STEP_MAX(v, 0x111, 0xf); DPP_STEP_MAX(v, 0x112, 0xf); DPP_STEP_MAX(v, 0x114, 0xf); DPP_STEP_MAX(v, 0x118, 0xf); DPP_STEP_MAX(v, 0x142, 0xa); DPP_STEP_MAX(v, 0x143, 0xc);
    return __int_as_float(__builtin_amdgcn_readlane(__float_as_int(v), 63));
}
#define MFMA16(a, b, c) __builtin_amdgcn_mfma_f32_16x16x32_bf16((a), (b), (c), 0, 0, 0)

__device__ __forceinline__ int win_src_col(int nb, int& nvalid) {
    nvalid = 32;
    if (nb < 2048) return nb;
    if (nb < 3072) { int xx = nb - 2048; const int isk = xx >> 9; xx &= 511; const int T = xx >> 8, bj = (xx >> 7) & 1, hl = (xx >> 5) & 3; return 2064 + isk * 512 + 64 * (4 * T + hl) + 32 * bj; }
    if (nb < 3584) return 3088 + (nb - 3072);
    if (nb == 3584) { nvalid = 16; return 2048; }
    nvalid = 0; return 0;
}
__device__ __forceinline__ void transpose_item(const float* W, int K, int Nsrc, int src_col, int nvalid, const float* g, bf16* WT, int dst_row, int k0, LAS float* scr, int lane) {
    const int c = lane & 31;
    float wv[32];
#pragma unroll
    for (int i = 0; i < 32; ++i) { const int kk = 2 * i + (lane >> 5); wv[i] = (c < nvalid) ? __builtin_nontemporal_load(W + (size_t)(k0 + kk) * Nsrc + src_col + c) : 0.f; }
    if (g) {
#pragma unroll
        for (int i = 0; i < 32; ++i) wv[i] *= g[k0 + 2 * i + (lane >> 5)]; }
#pragma unroll
    for (int i = 0; i < 32; ++i) scr[(2 * i + (lane >> 5)) * 33 + c] = wv[i];
    asm volatile("s_waitcnt lgkmcnt(0)" ::: "memory");
    const int ch = lane & 7;
#pragma unroll
    for (int j = 0; j < 4; ++j) { const int n = (lane >> 3) + 8 * j; const LAS float* s = scr + (8 * ch) * 33 + n;
        u32x4 o; o.x = pk2(s[0 * 33], s[1 * 33]); o.y = pk2(s[2 * 33], s[3 * 33]); o.z = pk2(s[4 * 33], s[5 * 33]); o.w = pk2(s[6 * 33], s[7 * 33]);
        *(u32x4*)(WT + (size_t)(dst_row + n) * K + k0 + 8 * ch) = o; }
    asm volatile("s_waitcnt lgkmcnt(0)" ::: "memory");
}
constexpr int I_IN = 16 * (NINP / 32), I_OUT = 16 * 32, I_UP = 16 * 128, I_DN = 64 * 32, I_L = I_IN + I_OUT + I_UP + I_DN;
__device__ __forceinline__ void convert_item(const Params& p, int it, LAS float* scr, int lane) {
    const int l = it / I_L; int r = it % I_L;
    if (r < I_IN) { const int nblk = NINP / 32, kb = r / nblk, nb = (r % nblk) * 32; int nv; const int sc = win_src_col(nb, nv);
        transpose_item(p.w_in + (size_t)l * DM * NINL, DM, NINL, sc, nv, p.norm1_g + l * DM, (bf16*)(p.ws + WS_WIN) + (size_t)l * NINP * DM, nb, kb * 64, scr, lane); return; }
    r -= I_IN;
    if (r < I_OUT) { const int kb = r / 32, nb = (r % 32) * 32;
        transpose_item(p.w_out + (size_t)l * DM * DM, DM, DM, nb, 32, nullptr, (bf16*)(p.ws + WS_WOUT) + (size_t)l * DM * DM, nb, kb * 64, scr, lane); return; }
    r -= I_OUT;
    if (r < I_UP) { const int kb = r / 128, nb = (r % 128) * 32;
        transpose_item(p.w_up + (size_t)l * DM * FF, DM, FF, nb, 32, p.norm2_g + l * DM, (bf16*)(p.ws + WS_WUP) + (size_t)l * FF * DM, nb, kb * 64, scr, lane); return; }
    r -= I_UP;
    { const int kb = r / 32, nb = (r % 32) * 32;
        transpose_item(p.w_down + (size_t)l * FF * DM, FF, DM, nb, 32, nullptr, (bf16*)(p.ws + WS_WDN) + (size_t)l * DM * FF, nb, kb * 64, scr, lane); }
}
__device__ __forceinline__ void p0_prologue(const Params& p, LAS unsigned char* lds, int wave, int lane, int G, int n_items) {
    LAS float* scr = (LAS float*)(lds + wave * 16384);
    const int gw = blockIdx.x * NWAVE + wave, NGW = G * NWAVE;
    if (n_items < 0) { constexpr int I_A = I_IN + I_OUT;
        for (int j = gw; j < 2 * I_A; j += NGW) convert_item(p, (j / I_A) * I_L + (j % I_A), scr, lane); }
    else for (int it = gw; it < n_items; it += NGW) convert_item(p, it, scr, lane);
    float* ss = (float*)(p.ws + WS_SSP); bf16* xb = (bf16*)(p.ws + WS_XB);
    for (int m0 = gw; m0 < MROWS; m0 += 2 * NGW) {
        f32x4 v[2][4];
#pragma unroll
        for (int q = 0; q < 2; ++q) { const int m = (m0 + q * NGW < MROWS) ? m0 + q * NGW : m0; const f32x4* xr = (const f32x4*)(p.x + (size_t)m * DM) + lane;
#pragma unroll
            for (int j = 0; j < 4; ++j) v[q][j] = __builtin_nontemporal_load(xr + 64 * j); }
#pragma unroll
        for (int q = 0; q < 2; ++q) { const int m = m0 + q * NGW; if (m < MROWS) { float s = 0.f; u32x2* o8 = (u32x2*)(xb + (size_t)m * DM) + lane;
#pragma unroll
            for (int j = 0; j < 4; ++j) { const f32x4 t = v[q][j]; s += (t[0] * t[0] + t[1] * t[1]) + (t[2] * t[2] + t[3] * t[3]); u32x2 w; w.x = pk2(t[0], t[1]); w.y = pk2(t[2], t[3]); o8[64 * j] = w; }
            s = wave_sum(s); if (lane < 16) ss[(size_t)m * 16 + lane] = (lane == 0) ? s : 0.f; } }
    }
    const int gt = blockIdx.x * NTHR + threadIdx.x, NGT = G * NTHR;
    float* rc = (float*)(p.ws + WS_ROPE); float* rsn = rc + SEQ * 32;
    for (int i = gt; i < SEQ * 32; i += NGT) { const int pos = i >> 5, fi = i & 31;
        const float inv = exp2f(-(float)fi * (13.287712379549449f / 32.0f)); const float ang = (float)pos * inv;
        const float n = rintf(ang * 0.15915494309189535f); float rr = fmaf(-n, 6.2831854820251465f, ang); rr = fmaf(-n, -1.7484555e-7f, rr);
        rc[i] = __cosf(rr); rsn[i] = __sinf(rr); }
}

struct ScanLd { u32x4 kc[2]; unsigned kb[2], ka[2]; float li, lf; };
__device__ __forceinline__ void scan_load(ScanLd& L, const bf16* Krow, const bf16* Vrow, const float* Gp, int tok0, int fq, int lane, int gcol) {
    L.li = Gp[(size_t)(tok0 + lane) * 16 + gcol]; L.lf = Gp[(size_t)(tok0 + lane) * 16 + 8 + gcol];
#pragma unroll
    for (int ks = 0; ks < 2; ++ks) { const int base = tok0 + 32 * ks + 8 * fq;
        L.kc[ks] = __builtin_nontemporal_load((const u32x4*)(Krow + base));
        L.kb[ks] = (base >= 2) ? *(const unsigned*)(Krow + base - 2) : 0u;
        L.ka[ks] = (base + 8 < SEQ) ? *(const unsigned*)(Krow + base + 8) : 0u; }
}
__device__ __forceinline__ void scan_wave(const Params& p, int layer, int sw, LAS float* wl, int lane, bool bar_mid) {
    const int ksl = sw & 7, dir = (sw >> 3) & 1, hh = (sw >> 4) & 3, b = sw >> 6;
    const int fr = lane & 15, fq = lane >> 4, kdim = 16 * ksl + fr;
    const float* cw = p.conv_w + (size_t)layer * 5 * 1024 + 512 + hh * 128 + kdim;
    float cwt[5];
#pragma unroll
    for (int t = 0; t < 5; ++t) cwt[t] = cw[t * 1024];
    const bf16* Krow = (const bf16*)(p.ws + WS_KTM) + ((size_t)((b * 4 + hh) * 128 + kdim)) * SEQ;
    const bf16* Vrow = (const bf16*)(p.ws + WS_VTM) + ((size_t)((b * 4 + hh) * 128 + fr)) * SEQ;
    const float* Gp = (const float*)(p.ws + WS_G) + (size_t)b * SEQ * 16;
    const int gcol = dir * 4 + hh;
    bf16* Ct = (bf16*)p.out; float* Nst = (float*)(p.ws + WS_N); float* Mst = (float*)(p.ws + WS_MST);
    const f32x4 z4 = {0.f, 0.f, 0.f, 0.f};
    f32x4 C[8], CN = z4; float mrun = -1e30f;
#pragma unroll
    for (int nt = 0; nt < 8; ++nt) C[nt] = z4;
    const bf16x8 ones = {0x3F80, 0x3F80, 0x3F80, 0x3F80, 0x3F80, 0x3F80, 0x3F80, 0x3F80};
    ScanLd cur, nxt;
    scan_load(cur, Krow, Vrow, Gp, (dir ? 31 : 0) * 64, fq, lane, gcol);
    for (int cs = 0; cs < 32; ++cs) {
        if (bar_mid && cs == 11) __syncthreads();
        const int pc = dir ? 31 - cs : cs;
        bf16x8 vv[8][2];
#pragma unroll
        for (int ks = 0; ks < 2; ++ks)
#pragma unroll
            for (int nt = 0; nt < 8; ++nt) vv[nt][ks] = *(const bf16x8*)(Vrow + (size_t)nt * 16 * SEQ + pc * 64 + 32 * ks + 8 * fq);
        if (cs + 1 < 32) scan_load(nxt, Krow, Vrow, Gp, (dir ? 30 - cs : cs + 1) * 64, fq, lane, gcol); else nxt = cur;
        const float pre = wave_incl_scan_dpp(cur.lf); const float total = __int_as_float(__builtin_amdgcn_readlane(__float_as_int(pre), 63));
        const float g = dir ? (pre - cur.lf + cur.li) : (total - pre + cur.li);
        const float gmax = wave_max_dpp(g);
        const float mn = fmaxf(total + mrun, gmax); const float decay = __expf(total + mrun - mn); const float w = __expf(g - mn);
        const size_t sidx = (size_t)((b * 4 + hh) * 2 + dir) * 32 + pc;
        { bf16* Cd = Ct + sidx * 16384 + (size_t)fr * 128 + 16 * ksl + 4 * fq;
#pragma unroll
          for (int nt = 0; nt < 8; ++nt) { u32x2 w0; w0.x = pk2(C[nt][0], C[nt][1]); w0.y = pk2(C[nt][2], C[nt][3]); *(u32x2*)(Cd + nt * 16 * 128) = w0; }
          if (fr == 0) *(f32x4*)(Nst + sidx * 128 + 16 * ksl + 4 * fq) = CN;
          if (ksl == 0 && lane == 0) Mst[sidx] = mrun; }
        wl[lane] = w;
        asm volatile("s_waitcnt lgkmcnt(0)" ::: "memory");
        bf16x8 afr[2];
#pragma unroll
        for (int ks = 0; ks < 2; ++ks) {
            const f32x4 wa = *(const LAS f32x4*)(wl + 32 * ks + 8 * fq), wb = *(const LAS f32x4*)(wl + 32 * ks + 8 * fq + 4);
            float r[12]; r[0] = bflo(cur.kb[ks]); r[1] = bfhi(cur.kb[ks]);
#pragma unroll
            for (int q = 0; q < 4; ++q) { r[2 + 2 * q] = bflo(cur.kc[ks][q]); r[3 + 2 * q] = bfhi(cur.kc[ks][q]); }
            r[10] = bflo(cur.ka[ks]); r[11] = bfhi(cur.ka[ks]);
            float o[8];
#pragma unroll
            for (int j = 0; j < 8; ++j) { float a = 0.f;
#pragma unroll
                for (int t = 0; t < 5; ++t) a = fmaf(cwt[t], r[j + t], a);
                a = a * __builtin_amdgcn_rcpf(1.0f + __expf(-a)); o[j] = a * 0.08838834764831845f * (j < 4 ? wa[j] : wb[j - 4]); }
            u32x4 pw; pw.x = pk2(o[0], o[1]); pw.y = pk2(o[2], o[3]); pw.z = pk2(o[4], o[5]); pw.w = pk2(o[6], o[7]);
            afr[ks] = __builtin_bit_cast(bf16x8, pw);
        }
        asm volatile("" ::: "memory");
        CN = CN * decay;
#pragma unroll
        for (int nt = 0; nt < 8; ++nt) { C[nt] = C[nt] * decay; C[nt] = MFMA16(afr[0], vv[nt][0], C[nt]); C[nt] = MFMA16(afr[1], vv[nt][1], C[nt]); }
        CN = MFMA16(afr[0], ones, CN); CN = MFMA16(afr[1], ones, CN);
        mrun = mn; cur = nxt;
    }
}

__device__ __forceinline__ void tile_par(int T, int f, int r, int L0, int& R, int& Lb, int& dsh) {
    if (T < 10) { dsh = 4; R = r; Lb = L0 - 64 + 16 * T + 4 * f; }
    else if (T < 22) { dsh = 2; R = 4 * f + (r & 3); Lb = L0 - 16 + 4 * (T - 10); }
    else { const int xx = T - 22; dsh = 0; R = 4 * (xx & 3) + f; Lb = L0 - 4 + 4 * (xx >> 2); }
}
template <int LIM> __device__ __forceinline__ void attn_step(f32x4 (&O)[4], float& mrun, float& lsum, const bf16x8 (&qf)[2], const bf16x8 k00, const bf16x8 k01, const bf16x8 k10, const bf16x8 k11,
                                                             const u32x2 (&v0)[4], const u32x2 (&v1)[4], int D0, int D1, bool ok0, bool ok1) {
    const f32x4 z4 = {0.f, 0.f, 0.f, 0.f};
    f32x4 s0 = MFMA16(k00, qf[0], z4); s0 = MFMA16(k01, qf[1], s0);
    f32x4 s1 = MFMA16(k10, qf[0], z4); s1 = MFMA16(k11, qf[1], s1);
    bool va[4], vb[4];
#pragma unroll
    for (int j = 0; j < 4; ++j) { va[j] = ok0 && ((unsigned)(D0 + 16 * j) <= (unsigned)(2 * LIM)); vb[j] = ok1 && ((unsigned)(D1 + 16 * j) <= (unsigned)(2 * LIM));
        s0[j] = va[j] ? s0[j] : -1e30f; s1[j] = vb[j] ? s1[j] : -1e30f; }
    float tm = fmaxf(fmaxf(fmaxf(s0[0], s0[1]), fmaxf(s0[2], s0[3])), fmaxf(fmaxf(s1[0], s1[1]), fmaxf(s1[2], s1[3])));
    tm = fmaxf(tm, __shfl_xor(tm, 16)); tm = fmaxf(tm, __shfl_xor(tm, 32));
    const float mn = fmaxf(mrun, tm);
    if (__any(mn > mrun)) { const float sc = __builtin_amdgcn_exp2f(mrun - mn); lsum *= sc;
#pragma unroll
        for (int d = 0; d < 4; ++d) O[d] = O[d] * sc; }
    mrun = mn;
    float pv[8]; float ps = 0.f;
#pragma unroll
    for (int j = 0; j < 4; ++j) { pv[j] = va[j] ? __builtin_amdgcn_exp2f(s0[j] - mn) : 0.f; pv[4 + j] = vb[j] ? __builtin_amdgcn_exp2f(s1[j] - mn) : 0.f; ps += pv[j] + pv[4 + j]; }
    lsum += ps;
    u32x4 pw; pw.x = pk2(pv[0], pv[1]); pw.y = pk2(pv[2], pv[3]); pw.z = pk2(pv[4], pv[5]); pw.w = pk2(pv[6], pv[7]);
    const bf16x8 pb = __builtin_bit_cast(bf16x8, pw);
#pragma unroll
    for (int d = 0; d < 4; ++d) { u32x4 vw; vw.x = v0[d].x; vw.y = v0[d].y; vw.z = v1[d].x; vw.w = v1[d].y; O[d] = MFMA16(__builtin_bit_cast(bf16x8, vw), pb, O[d]); }
}
#define KLD(ptr, lo, hi) do { lo = *(const bf16x8*)(ptr); hi = *(const bf16x8*)((ptr) + 32); } while (0)
#define VLD(ptr, v) do { _Pragma("unroll") for (int d_ = 0; d_ < 4; ++d_) v[d_] = *(const u32x2*)((ptr) + d_ * 64); } while (0)
__device__ __forceinline__ void attn_pair(const Params& p, int b, int h, int p0, int r0, int lane) {
    const int fr = lane & 15, fq = lane >> 4, fK = fr >> 2, jK = fr & 3; const int L0 = p0 >> 4;
    const f32x4 z4 = {0.f, 0.f, 0.f, 0.f};
    bf16* Yrow[2]; bf16x8 qf[2][2]; f32x4 O[2][4]; float mrun[2], lsum[2];
    const bf16* Kb = (const bf16*)(p.ws + WS_AK) + (ptrdiff_t)b * SEQ * 512 + h * 64 + 8 * fq;
    const bf16* Vb = (const bf16*)(p.ws + WS_VT16) + (ptrdiff_t)(b * 8 + h) * 131072 + fr * 4;
#pragma unroll
    for (int u = 0; u < 2; ++u) { const int pq = p0 + 16 * fr + r0 + 4 * u; Yrow[u] = (bf16*)(p.ws + WS_Y) + ((size_t)(b * SEQ + pq)) * 1024 + 512 + h * 64;
        qf[u][0] = *(const bf16x8*)(Yrow[u] + 8 * fq); qf[u][1] = *(const bf16x8*)(Yrow[u] + 32 + 8 * fq); mrun[u] = -1e30f; lsum[u] = 0.f;
#pragma unroll
        for (int d = 0; d < 4; ++d) O[u][d] = z4; }
    {
        const bf16* kp = Kb + (ptrdiff_t)(16 * (L0 - 64 + 4 * fK + jK) + r0) * 512;
        const bf16* vp = Vb + (ptrdiff_t)(r0 * 32 + (L0 >> 2) - 16 + fq) * 256;
        for (int pp = 0; pp < 5; ++pp) { const int T0 = 2 * pp; const int lq = L0 - 64 + 16 * T0;
            if (lq + 31 < 0 || lq >= 128) continue;
            const int D0 = 16 * (-64 + 16 * T0 + 4 * fq - fr) + 1024; const bool ok0 = (unsigned)(lq + 4 * fq) < 128u, ok1 = (unsigned)(lq + 16 + 4 * fq) < 128u;
            const bf16* k0p = kp + (ptrdiff_t)T0 * 256 * 512; const bf16* v0p = vp + (ptrdiff_t)T0 * 4 * 256;
#pragma unroll
            for (int u = 0; u < 2; ++u) { bf16x8 k00, k01, k10, k11; u32x2 v0[4], v1[4];
                KLD(k0p + u * 4 * 512, k00, k01); VLD(v0p + u * 4 * 32 * 256, v0);
                if (pp < 4) { KLD(k0p + u * 4 * 512 + 256 * 512, k10, k11); VLD(v0p + u * 4 * 32 * 256 + 4 * 256, v1); }
                else { k10 = k00; k11 = k01;
#pragma unroll
                    for (int d_ = 0; d_ < 4; ++d_) v1[d_] = v0[d_]; }
                attn_step<1024>(O[u], mrun[u], lsum[u], qf[u], k00, k01, k10, k11, v0, v1, D0, D0 + 256, ok0, ok1 && (pp < 4)); }
        }
    }
    {
        const bf16* kp = Kb + (ptrdiff_t)(16 * (L0 - 16 + jK) + 4 * fK + (r0 & 3)) * 512;
        const bf16* vp = Vb + (ptrdiff_t)((4 * fq + (r0 & 3)) * 32 + (L0 >> 2) - 4) * 256;
        for (int pp = 0; pp < 6; ++pp) { const int T0 = 2 * pp; const int lb = L0 - 16 + 4 * T0;
            const bool ok0 = (unsigned)lb < 128u, ok1 = (unsigned)(lb + 4) < 128u; if (!ok0 && !ok1) continue;
            const int D0 = 16 * (-16 + 4 * T0 - fr) + 4 * fq - (r0 & ~3) + 256;
            const bf16* k0p = kp + (ptrdiff_t)T0 * 64 * 512; const bf16* v0p = vp + (ptrdiff_t)T0 * 256;
            { bf16x8 k00, k01, k10, k11; u32x2 v0[4], v1[4];
                KLD(k0p, k00, k01); KLD(k0p + 64 * 512, k10, k11); VLD(v0p, v0); VLD(v0p + 256, v1);
                attn_step<256>(O[0], mrun[0], lsum[0], qf[0], k00, k01, k10, k11, v0, v1, D0, D0 + 64, ok0, ok1);
                attn_step<256>(O[1], mrun[1], lsum[1], qf[1], k00, k01, k10, k11, v0, v1, D0 - 4, D0 + 60, ok0, ok1); }
        }
    }
#pragma unroll
    for (int u = 0; u < 2; ++u) { float l2 = lsum[u]; l2 += __shfl_xor(l2, 16); l2 += __shfl_xor(l2, 32); const int pq = p0 + 16 * fr + r0 + 4 * u; const size_t qrow = (size_t)(b * SEQ + pq);
        const float* ml = (const float*)(p.ws + WS_P1ML) + (qrow * 8 + h) * 2; const float m1 = ml[0], l1 = ml[1];
        const float m = fmaxf(mrun[u], m1); const float a2 = __builtin_amdgcn_exp2f(mrun[u] - m), a1 = __builtin_amdgcn_exp2f(m1 - m) * l1; const float rden = 1.0f / (l2 * a2 + a1);
        const bf16* o1p = (const bf16*)(p.ws + WS_P1O) + qrow * 512 + h * 64 + 4 * fq;
#pragma unroll
        for (int d = 0; d < 4; ++d) { const u32x2 ow = *(const u32x2*)(o1p + 16 * d); u32x2 w;
            w.x = pk2((O[u][d][0] * a2 + bflo(ow.x) * a1) * rden, (O[u][d][1] * a2 + bfhi(ow.x) * a1) * rden); w.y = pk2((O[u][d][2] * a2 + bflo(ow.y) * a1) * rden, (O[u][d][3] * a2 + bfhi(ow.y) * a1) * rden);
            *(u32x2*)(Yrow[u] + 16 * d + 4 * fq) = w; } }
}
__device__ __forceinline__ void attn_quad_d1(const Params& p, int b, int h, int L, int lane) {
    const int fr = lane & 15, fq = lane >> 4, fK = fr >> 2, jK = fr & 3;
    const f32x4 z4 = {0.f, 0.f, 0.f, 0.f};
    bf16x8 qf[4][2]; f32x4 O[4][4]; float mrun[4], lsum[4];
    const bf16* Kb = (const bf16*)(p.ws + WS_AK) + (ptrdiff_t)b * SEQ * 512 + h * 64 + 8 * fq;
    const bf16* Vb = (const bf16*)(p.ws + WS_VT16) + (ptrdiff_t)(b * 8 + h) * 131072 + fr * 4;
#pragma unroll
    for (int i = 0; i < 4; ++i) { const bf16* qrow = (const bf16*)(p.ws + WS_Y) + ((size_t)(b * SEQ + 16 * (L + i) + fr)) * 1024 + 512 + h * 64;
        qf[i][0] = *(const bf16x8*)(qrow + 8 * fq); qf[i][1] = *(const bf16x8*)(qrow + 32 + 8 * fq); mrun[i] = -1e30f; lsum[i] = 0.f;
#pragma unroll
        for (int d = 0; d < 4; ++d) O[i][d] = z4; }
    const bf16* kp = Kb + (ptrdiff_t)(16 * (L - 4 + jK) + fK) * 512;
    const bf16* vp = Vb + (ptrdiff_t)(fq * 32 + (L >> 2) - 1) * 256;
    for (int kb = 0; kb < 3; ++kb) { const int lb = L - 4 + 4 * kb; if ((unsigned)lb >= 128u) continue;
#pragma unroll
        for (int th = 0; th < 2; ++th) { const int t0 = 2 * th;
            const int D0 = 16 * (-4 + 4 * kb) + 4 * t0 + fq - fr + 64;
            const bf16* k0p = kp + (ptrdiff_t)(64 * kb + 4 * t0) * 512; const bf16* v0p = vp + (ptrdiff_t)(128 * t0 + kb) * 256;
            bf16x8 k00, k01, k10, k11; u32x2 v0[4], v1[4];
            KLD(k0p, k00, k01); KLD(k0p + 4 * 512, k10, k11); VLD(v0p, v0); VLD(v0p + 128 * 256, v1);
#pragma unroll
            for (int i = 0; i < 4; ++i) { attn_step<64>(O[i], mrun[i], lsum[i], qf[i], k00, k01, k10, k11, v0, v1, D0 - 16 * i, D0 - 16 * i + 4, true, true); if (i & 1) __builtin_amdgcn_sched_barrier(0); } }
    }
#pragma unroll
    for (int i = 0; i < 4; ++i) { float l = lsum[i]; l += __shfl_xor(l, 16); l += __shfl_xor(l, 32); const float rl = 1.0f / l; const size_t qrow = (size_t)(b * SEQ + 16 * (L + i) + fr);
        bf16* o1p = (bf16*)(p.ws + WS_P1O) + qrow * 512 + h * 64 + 4 * fq;
#pragma unroll
        for (int d = 0; d < 4; ++d) { u32x2 w; w.x = pk2(O[i][d][0] * rl, O[i][d][1] * rl); w.y = pk2(O[i][d][2] * rl, O[i][d][3] * rl); *(u32x2*)(o1p + 16 * d) = w; }
        if (fq == 0) { float* ml = (float*)(p.ws + WS_P1ML) + (qrow * 8 + h) * 2; ml[0] = mrun[i]; ml[1] = l; } }
}
constexpr int QS_OFF = 0, KS_OFF = 17408, PF_OFF = 34816, PB_OFF = 44032, FL_OFF = 53248, QPITCH = 272, PPITCH = 144;
__device__ __forceinline__ void mout_unit(const Params& p, int layer, int u, LAS unsigned char* lds, int tid, int wave, int lane) {
    const int b = u >> 7, hh = (u >> 5) & 3, pc = u & 31, tok0 = pc * 64;
    const int fr = lane & 15, fq = lane >> 4;
    LAS float* FL = (LAS float*)(lds + FL_OFF);
    const float* Gp = (const float*)(p.ws + WS_G) + (size_t)(b * SEQ + tok0) * 16;
    const float* Mst = (const float*)(p.ws + WS_MST); const float* Nst = (const float*)(p.ws + WS_N);
    const bf16* Ct = (const bf16*)p.out;
    const size_t sid0 = (size_t)((b * 4 + hh) * 2 + 0) * 32 + pc, sid1 = (size_t)((b * 4 + hh) * 2 + 1) * 32 + pc;
    bf16x8 vaf[2], caf[2][4];
    { const bf16* Vr = (const bf16*)(p.ws + WS_VTM) + ((size_t)((b * 4 + hh) * 128 + 16 * wave + fr)) * SEQ + tok0;
#pragma unroll
      for (int ks = 0; ks < 2; ++ks) vaf[ks] = __builtin_nontemporal_load((const bf16x8*)(Vr + 32 * ks + 8 * fq));
#pragma unroll
      for (int d = 0; d < 2; ++d) { const bf16* Cr = Ct + (d ? sid1 : sid0) * 16384 + (size_t)(16 * wave + fr) * 128;
#pragma unroll
          for (int kk = 0; kk < 4; ++kk) caf[d][kk] = __builtin_nontemporal_load((const bf16x8*)(Cr + 32 * kk + 8 * fq)); } }
    if (wave < 2) {
        const int dir = wave; const float li = Gp[lane * 16 + dir * 4 + hh], lf = Gp[lane * 16 + 8 + dir * 4 + hh];
        const float pre = wave_incl_scan_dpp(lf); const float total = __int_as_float(__builtin_amdgcn_readlane(__float_as_int(pre), 63));
        const float bt = dir ? (total - pre + lf) : pre; const float uu = li - bt;
        float pm;
        if (dir == 0) pm = wave_incl_max_dpp(uu); else pm = __shfl(wave_incl_max_dpp(__shfl(uu, 63 - lane)), 63 - lane);
        const float mprev = Mst[dir ? sid1 : sid0]; const float a = bt + mprev; const float mt = fmaxf(a, bt + pm);
        FL[(0 + 2 * dir) * 64 + lane] = bt - mt; FL[(1 + 2 * dir) * 64 + lane] = uu; FL[(4 + dir) * 64 + lane] = __expf(a - mt); FL[(6 + dir) * 64 + lane] = __expf(-mt);
    }
    {
        const bf16* QKm = (const bf16*)(p.ws + WS_QKM); const float* cwl = p.conv_w + (size_t)layer * 5 * 1024;
#pragma unroll
        for (int it4 = 0; it4 < 4; ++it4) { const int it = tid + it4 * NTHR; const int mat = it >> 10, rem = it & 1023, tok = rem >> 4, dg = rem & 15; const int col = mat * 512 + hh * 128 + 8 * dg;
            float a8[8];
#pragma unroll
            for (int j = 0; j < 8; ++j) a8[j] = 0.f;
#pragma unroll
            for (int t = 0; t < 5; ++t) { const int tt = tok0 + tok + t - 2;
                if (tt >= 0 && tt < SEQ) { const u32x4 xx = *(const u32x4*)(QKm + (size_t)(b * SEQ + tt) * 1024 + col);
                    const f32x4 w0 = *(const f32x4*)(cwl + t * 1024 + col), w1 = *(const f32x4*)(cwl + t * 1024 + col + 4);
                    a8[0] = fmaf(w0[0], bflo(xx.x), a8[0]); a8[1] = fmaf(w0[1], bfhi(xx.x), a8[1]); a8[2] = fmaf(w0[2], bflo(xx.y), a8[2]); a8[3] = fmaf(w0[3], bfhi(xx.y), a8[3]);
                    a8[4] = fmaf(w1[0], bflo(xx.z), a8[4]); a8[5] = fmaf(w1[1], bfhi(xx.z), a8[5]); a8[6] = fmaf(w1[2], bflo(xx.w), a8[6]); a8[7] = fmaf(w1[3], bfhi(xx.w), a8[7]); } }
            const float sc = mat ? 0.08838834764831845f : 1.0f;
#pragma unroll
            for (int j = 0; j < 8; ++j) a8[j] = a8[j] * __builtin_amdgcn_rcpf(1.0f + __expf(-a8[j])) * sc;
            u32x4 w; w.x = pk2(a8[0], a8[1]); w.y = pk2(a8[2], a8[3]); w.z = pk2(a8[4], a8[5]); w.w = pk2(a8[6], a8[7]);
            *(LAS u32x4*)(lds + (mat ? KS_OFF : QS_OFF) + tok * QPITCH + dg * 16) = w; }
    }
    __syncthreads();
    if (wave < 2) {
        const float* np = Nst + (wave ? sid1 : sid0) * 128; float acc = 0.f;
#pragma unroll
        for (int dg = 0; dg < 16; ++dg) { const u32x4 xx = *(const LAS u32x4*)(lds + QS_OFF + lane * QPITCH + dg * 16); const f32x4 n0 = *(const f32x4*)(np + 8 * dg), n1 = *(const f32x4*)(np + 8 * dg + 4);
            acc += bflo(xx.x) * n0[0] + bfhi(xx.x) * n0[1] + bflo(xx.y) * n0[2] + bfhi(xx.y) * n0[3] + bflo(xx.z) * n1[0] + bfhi(xx.z) * n1[1] + bflo(xx.w) * n1[2] + bfhi(xx.w) * n1[3]; }
        FL[(16 + wave) * 64 + lane] = acc;
    }
    {
        const int st = wave >> 1, tt0 = 2 * (wave & 1); const f32x4 z4 = {0.f, 0.f, 0.f, 0.f};
        bf16x8 ka[4];
#pragma unroll
        for (int ks = 0; ks < 4; ++ks) ka[ks] = *(const LAS bf16x8*)(lds + KS_OFF + (16 * st + fr) * QPITCH + (32 * ks + 8 * fq) * 2);
#pragma unroll
        for (int q = 0; q < 2; ++q) { const int t = 16 * (tt0 + q) + fr; f32x4 s = z4;
#pragma unroll
            for (int ks = 0; ks < 4; ++ks) { const bf16x8 qb = *(const LAS bf16x8*)(lds + QS_OFF + t * QPITCH + (32 * ks + 8 * fq) * 2); s = MFMA16(ka[ks], qb, s); }
            const float cf = FL[0 * 64 + t], cb = FL[2 * 64 + t]; float pf[4], pb[4]; float rf = 0.f, rb = 0.f;
#pragma unroll
            for (int j = 0; j < 4; ++j) { const int si = 16 * st + 4 * fq + j; const float uf = FL[1 * 64 + si], ub = FL[3 * 64 + si];
                pf[j] = (si <= t) ? s[j] * __expf(cf + uf) : 0.f; pb[j] = (si >= t) ? s[j] * __expf(cb + ub) : 0.f; rf += pf[j]; rb += pb[j]; }
            u32x2 w; w.x = pk2(pf[0], pf[1]); w.y = pk2(pf[2], pf[3]); *(LAS u32x2*)(lds + PF_OFF + t * PPITCH + (16 * st + 4 * fq) * 2) = w;
            w.x = pk2(pb[0], pb[1]); w.y = pk2(pb[2], pb[3]); *(LAS u32x2*)(lds + PB_OFF + t * PPITCH + (16 * st + 4 * fq) * 2) = w;
            rf += __shfl_xor(rf, 16); rf += __shfl_xor(rf, 32); rb += __shfl_xor(rb, 16); rb += __shfl_xor(rb, 32);
            if (fq == 0) { FL[(8 + st) * 64 + t] = rf; FL[(12 + st) * 64 + t] = rb; } }
    }
    __syncthreads();
    f32x4 aI[2][4], aX[2][4];
    {
        const f32x4 z4 = {0.f, 0.f, 0.f, 0.f};
#pragma unroll
        for (int d = 0; d < 2; ++d)
#pragma unroll
            for (int tt = 0; tt < 4; ++tt) { aI[d][tt] = z4; aX[d][tt] = z4; }
#pragma unroll
        for (int ks = 0; ks < 2; ++ks) { const bf16x8 va = vaf[ks];
#pragma unroll
            for (int tt = 0; tt < 4; ++tt) { const bf16x8 pfb = *(const LAS bf16x8*)(lds + PF_OFF + (16 * tt + fr) * PPITCH + (32 * ks + 8 * fq) * 2);
                const bf16x8 pbb = *(const LAS bf16x8*)(lds + PB_OFF + (16 * tt + fr) * PPITCH + (32 * ks + 8 * fq) * 2);
                aI[0][tt] = MFMA16(va, pfb, aI[0][tt]); aI[1][tt] = MFMA16(va, pbb, aI[1][tt]); } }
#pragma unroll
        for (int d = 0; d < 2; ++d) {
#pragma unroll
            for (int kk = 0; kk < 4; ++kk) { const bf16x8 ca = caf[d][kk];
#pragma unroll
                for (int tt = 0; tt < 4; ++tt) { const bf16x8 qb = *(const LAS bf16x8*)(lds + QS_OFF + (16 * tt + fr) * QPITCH + (32 * kk + 8 * fq) * 2); aX[d][tt] = MFMA16(ca, qb, aX[d][tt]); } } }
    }
    f32x4 hs[4];
#pragma unroll
    for (int tt = 0; tt < 4; ++tt) { const int t = 16 * tt + fr; const f32x4 z4 = {0.f, 0.f, 0.f, 0.f}; hs[tt] = z4;
#pragma unroll
        for (int d = 0; d < 2; ++d) { const float in = FL[(4 + d) * 64 + t]; const float den = ((FL[(8 + 4 * d) * 64 + t] + FL[(9 + 4 * d) * 64 + t]) + (FL[(10 + 4 * d) * 64 + t] + FL[(11 + 4 * d) * 64 + t])) + in * FL[(16 + d) * 64 + t];
            const float rd = 1.0f / fmaxf(fabsf(den), FL[(6 + d) * 64 + t]); hs[tt] += (aI[d][tt] + aX[d][tt] * in) * rd; }
        float sq = (hs[tt][0] * hs[tt][0] + hs[tt][1] * hs[tt][1]) + (hs[tt][2] * hs[tt][2] + hs[tt][3] * hs[tt][3]);
        sq += __shfl_xor(sq, 16); sq += __shfl_xor(sq, 32);
        if (fq == 0) FL[(18 + wave) * 64 + t] = sq; }
    __syncthreads();
    {
        const f32x4 hg = *(const f32x4*)(p.head_norm_g + layer * 512 + hh * 128 + 16 * wave + 4 * fq);
#pragma unroll
        for (int tt = 0; tt < 4; ++tt) { const int t = 16 * tt + fr; const float ssq = ((FL[18 * 64 + t] + FL[19 * 64 + t]) + (FL[20 * 64 + t] + FL[21 * 64 + t])) + ((FL[22 * 64 + t] + FL[23 * 64 + t]) + (FL[24 * 64 + t] + FL[25 * 64 + t])); const float rsd = rsqrtf(ssq * (1.0f / 128.0f) + 1e-6f);
            bf16* yp = (bf16*)(p.ws + WS_Y) + (size_t)(b * SEQ + tok0 + t) * 1024 + hh * 128 + 16 * wave + 4 * fq;
            const u32x2 gt = *(const u32x2*)yp;
            u32x2 w; w.x = pk2(hs[tt][0] * rsd * hg[0] * bflo(gt.x), hs[tt][1] * rsd * hg[1] * bfhi(gt.x)); w.y = pk2(hs[tt][2] * rsd * hg[2] * bflo(gt.y), hs[tt][3] * rsd * hg[3] * bfhi(gt.y));
            *(u32x2*)yp = w; }
    }
    __syncthreads();
}

#define XB_TMO      128
#define XB_XCNT(j)  (256  + 64 * (j))
#define XB_XSUB(j)  (1280 + 64 * (j))
#define XB_XGEN(j)  (2304 + 64 * (j))
#define XB_TOP      3328
#define XB_TOPGEN   3392
#define XCD_BAR_WORDS 3456
#define XB_SPIN_CAP (1u << 18)

__device__ __forceinline__ unsigned xb_ld(unsigned* p)              { return __hip_atomic_load(p, __ATOMIC_RELAXED, __HIP_MEMORY_SCOPE_AGENT); }
__device__ __forceinline__ unsigned xb_add(unsigned* p, unsigned v) { return __hip_atomic_fetch_add(p, v, __ATOMIC_RELAXED, __HIP_MEMORY_SCOPE_AGENT); }
__device__ __forceinline__ unsigned xb_xcc_id() { return (unsigned)__builtin_amdgcn_s_getreg((3 << 11) | 20) & 0xFu; }
#define XB_SPIN(cond, bar) do { unsigned _sp = 0; while (cond) { __builtin_amdgcn_s_sleep(1); \
    if ((++_sp & 255u) == 0u) { if (xb_ld(&(bar)[XB_TMO])) break; if (_sp > XB_SPIN_CAP) { atomicAdd(&(bar)[XB_TMO], 1u); break; } } } } while (0)

struct XcdBarrier {
    unsigned* bar; unsigned x;
    volatile LAS unsigned* st;
};

__device__ __forceinline__ XcdBarrier xcd_barrier_post(unsigned* bar, volatile LAS unsigned* st) {
    XcdBarrier b; b.bar = bar; b.x = xb_xcc_id(); b.st = st;
    if (threadIdx.x == 0) (void)xb_add(&bar[XB_XCNT(b.x)], 1u);
    return b;
}
__device__ __forceinline__ void xcd_barrier_complete(unsigned* bar, unsigned x, unsigned& nloc, unsigned& nx) {
    const unsigned G = gridDim.x * gridDim.y * gridDim.z;
    unsigned sum, cnt, mine, sp = 0u;
    for (;;) {
        sum = 0u; cnt = 0u; mine = 0u;
#pragma unroll
        for (unsigned j = 0; j < 16; ++j) { const unsigned c = xb_ld(&bar[XB_XCNT(j)]); sum += c; cnt += (c > 0u) ? 1u : 0u; mine = (j == x) ? c : mine; }
        if (sum == G) break;
        __builtin_amdgcn_s_sleep(1);
        if ((++sp & 255u) == 0u) { if (xb_ld(&bar[XB_TMO])) break; if (sp > XB_SPIN_CAP) { atomicAdd(&bar[XB_TMO], 1u); break; } }
    }
    nloc = mine > 0u ? mine : 1u; nx = cnt > 0u ? cnt : 1u;
}

__device__ __forceinline__ void xcd_barrier(const XcdBarrier& b) {
    asm volatile("s_waitcnt vmcnt(0)" ::: "memory");
    __syncthreads();
    if (threadIdx.x == 0) {
        unsigned* bar = b.bar;
        __builtin_amdgcn_s_waitcnt(0);
        unsigned nloc = b.st[0], nx = b.st[1];
        if (nloc == 0u) { xcd_barrier_complete(bar, b.x, nloc, nx); b.st[0] = nloc; b.st[1] = nx; }
        const unsigned old = xb_add(&bar[XB_XSUB(b.x)], 1u);
        const unsigned gen = old / nloc;
        if (old + 1u == (gen + 1u) * nloc) {
            __builtin_amdgcn_fence(__ATOMIC_RELEASE, "agent");
            asm volatile("s_waitcnt vmcnt(0)" ::: "memory");
            const unsigned og = xb_add(&bar[XB_TOP], 1u);
            const unsigned tg = og / nx;
            if (og + 1u == (tg + 1u) * nx) xb_add(&bar[XB_TOPGEN], 1u);
            else XB_SPIN(xb_ld(&bar[XB_TOPGEN]) == tg, bar);
            __builtin_amdgcn_fence(__ATOMIC_ACQUIRE, "agent");
            xb_add(&bar[XB_XGEN(b.x)], 1u);
            asm volatile("s_waitcnt vmcnt(0)" ::: "memory");
        } else {
            XB_SPIN(xb_ld(&bar[XB_XGEN(b.x)]) == gen, bar);
            __builtin_amdgcn_fence(__ATOMIC_ACQUIRE, "agent");
            asm volatile("s_waitcnt vmcnt(0)" ::: "memory");
        }
    }
    __syncthreads();
}

__global__ void __launch_bounds__(NTHR, 2) fwd_megakernel(Params p) {
    extern __shared__ __attribute__((aligned(16))) unsigned char lds_raw[];
    LAS unsigned char* lds = (LAS unsigned char*)lds_raw;
    cg::grid_group grid = cg::this_grid();
#define GRID_SYNC_CG() do { asm volatile("s_waitcnt vmcnt(0) lgkmcnt(0)" ::: "memory"); grid.sync(); \
        __builtin_amdgcn_fence(__ATOMIC_ACQUIRE, "agent"); asm volatile("s_waitcnt vmcnt(0)" ::: "memory"); __syncthreads(); } while (0)
#define GRID_SYNC() do { XcdBarrier xb_; xb_.bar = (unsigned*)(p.ws + WS_CTL); xb_.x = xb_xcc_id(); xb_.st = (volatile LAS unsigned*)(lds + LDS_MISC); xcd_barrier(xb_); } while (0)
    const int tid = threadIdx.x, lane = tid & 63, wave = __builtin_amdgcn_readfirstlane(tid >> 6), G = gridDim.x, bid = blockIdx.x;
    const int vcu = (G % 8 == 0) ? (bid % 8) * (G / 8) + bid / 8 : bid;
    float* ss = (float*)(p.ws + WS_SSP);
    { volatile LAS unsigned* st0 = (volatile LAS unsigned*)(lds + LDS_MISC); if (threadIdx.x < 2) st0[threadIdx.x] = 0u; __syncthreads(); }
    (void)xcd_barrier_post((unsigned*)(p.ws + WS_CTL), (volatile LAS unsigned*)(lds + LDS_MISC));
    bf16* xb = (bf16*)(p.ws + WS_XB);

    const bool defer = (G == 256);
    p0_prologue(p, lds, wave, lane, G, defer ? -1 : 2 * I_L);
    if (G == 0x7fffffff) GRID_SYNC_CG();
    GRID_SYNC();

    for (int layer = 0; layer < 2; ++layer) {
#define RELANE() int tid = threadIdx.x; asm volatile("" : "+v"(tid)); const int lane = tid & 63, wave = __builtin_amdgcn_readfirstlane(tid >> 6)
        {
            pg8::Gemm g{xb, (const bf16*)(p.ws + WS_WIN) + (size_t)layer * NINP * DM, MROWS, NINP, DM};
            pg8::StaticOrder S; S.init(MROWS, NINP, G, bid);
            pg8::EpiIn E{ss + (size_t)(2 * layer) * MROWS * 16, p.ws, p.gate_i_b + layer * 8, p.gate_f_b + layer * 8};
            static_assert(pg8::EpiIn::O_ROPE == WS_ROPE && pg8::EpiIn::O_G == WS_G && pg8::EpiIn::O_QKM == WS_QKM && pg8::EpiIn::O_KTM == WS_KTM && pg8::EpiIn::O_VTM == WS_VTM && pg8::EpiIn::O_AK == WS_AK && pg8::EpiIn::O_VT16 == WS_VT16 && pg8::EpiIn::O_Y == WS_Y, "ws map");
            pg8::gemm_phase<pg8::EpiIn, pg8::StaticOrder, true, true>(lds, g, S, E);
            if (defer && bid >= 192) { RELANE(); LAS float* scr = (LAS float*)(lds + wave * 16384);
                for (int it = layer * I_L + I_IN + I_OUT + (bid - 192) * NWAVE + wave; it < (layer + 1) * I_L; it += 64 * NWAVE) convert_item(p, it, scr, lane); }
        }
        GRID_SYNC();
        {
            RELANE();
            volatile LAS unsigned* ctr = (volatile LAS unsigned*)(lds + LDS_MISC + 16);
            if (tid == 0) *ctr = 0u;
            const int nU = (512 - vcu + G - 1) / G;
            const bool fast = (G * 2 == 512);
            if (fast && wave < 2) {
                __builtin_amdgcn_s_setprio(3);
                scan_wave(p, layer, vcu * 2 + wave, (LAS float*)(lds + wave * 256), lane, true);
                __builtin_amdgcn_s_setprio(0);
            } else {
                const int w0 = fast ? 2 : 0, nw = fast ? 6 : NWAVE;
                for (int I = wave - w0; I < 4 * nU; I += nw) { const int au = vcu + G * (I >> 2); const int b = au >> 6, h = (au >> 3) & 7, p0 = (au & 7) * 256;
                    attn_quad_d1(p, b, h, (p0 >> 4) + 4 * (I & 3), lane); }
                asm volatile("s_waitcnt vmcnt(0)" ::: "memory");
                __syncthreads();
                if (!fast && wave < 2) for (int sw = vcu * 2 + wave; sw < 512; sw += G * 2) scan_wave(p, layer, sw, (LAS float*)(lds + wave * 256), lane, false);
            }
            {
                const int nQ = 8 * nU;
                for (;;) { unsigned Q = 0; if (lane == 0) Q = atomicAdd((unsigned*)(lds_raw + LDS_MISC + 16), 1u); Q = (unsigned)__builtin_amdgcn_readfirstlane((int)Q);
                    if ((int)Q >= nQ) break;
                    const int au = vcu + G * (int)(Q >> 3); const int b = au >> 6, h = (au >> 3) & 7, p0 = (au & 7) * 256; attn_pair(p, b, h, p0, (int)((Q & 3) + 8 * ((Q >> 2) & 1)), lane); }
            }
        }
        GRID_SYNC();
        { RELANE(); for (int u = vcu; u < 1024; u += G) mout_unit(p, layer, u, lds, tid, wave, lane); }
        GRID_SYNC();
        {
            pg8::Gemm g{(const bf16*)(p.ws + WS_Y), (const bf16*)(p.ws + WS_WOUT) + (size_t)layer * DM * DM, MROWS, DM, DM};
            pg8::StaticOrder S; S.init(MROWS, DM, G, bid);
            pg8::EpiRes E{xb, ss + (size_t)(2 * layer + 1) * MROWS * 16};
            pg8::gemm_phase<pg8::EpiRes, pg8::StaticOrder, true, true>(lds, g, S, E);
        }
        GRID_SYNC();
        {
            pg8::Gemm g{xb, (const bf16*)(p.ws + WS_WUP) + (size_t)layer * FF * DM, MROWS, FF, DM};
            pg8::StaticOrder S; S.init(MROWS, FF, G, bid);
            pg8::EpiUp E{ss + (size_t)(2 * layer + 1) * MROWS * 16, (bf16*)(p.ws + WS_U)};
            pg8::gemm_phase<pg8::EpiUp, pg8::StaticOrder, true, true>(lds, g, S, E);
        }
        GRID_SYNC();
        {
            pg8::Gemm g{(const bf16*)(p.ws + WS_U), (const bf16*)(p.ws + WS_WDN) + (size_t)layer * DM * FF, MROWS, DM, FF};
            pg8::StaticOrder S; S.init(MROWS, DM, G, bid);
            pg8::EpiRes E{xb, ss + (size_t)(2 * layer + 2) * MROWS * 16};
            pg8::gemm_phase<pg8::EpiRes, pg8::StaticOrder, true, true>(lds, g, S, E);
        }
        GRID_SYNC();
    }
    {
        RELANE();
        const int gw = bid * NWAVE + wave, NGW = G * NWAVE;
        for (int m = gw; m < MROWS; m += NGW) { const float rsd = rsqrtf(pg8::row_ss(ss + (size_t)4 * MROWS * 16, m) * (1.0f / 1024.0f) + 1e-6f);
            const u32x2* xr = (const u32x2*)(xb + (size_t)m * DM) + lane; f32x4* orow = (f32x4*)(p.out + (size_t)m * DM) + lane; const f32x4* gr = (const f32x4*)p.final_g + lane;
#pragma unroll
            for (int j = 0; j < 4; ++j) { const u32x2 w = __builtin_nontemporal_load(xr + 64 * j); const f32x4 g4 = gr[64 * j]; f32x4 o; o[0] = bflo(w.x) * rsd * g4[0]; o[1] = bfhi(w.x) * rsd * g4[1]; o[2] = bflo(w.y) * rsd * g4[2]; o[3] = bfhi(w.y) * rsd * g4[3]; __builtin_nontemporal_store(o, orow + 64 * j); } }
    }
}

extern "C" void kernel_launch(void* const* d_in, const int* in_sizes, int n_in, void* d_out, int out_size, void* d_ws, size_t ws_size, hipStream_t stream) {
    static int grid = 0;
    if (grid == 0) {
        int dev = 0, cus = 0, per_cu = 0;
        (void)hipGetDevice(&dev);
        (void)hipDeviceGetAttribute(&cus, hipDeviceAttributeMultiprocessorCount, dev);
        (void)hipFuncSetAttribute((const void*)fwd_megakernel, hipFuncAttributeMaxDynamicSharedMemorySize, LDS_BYTES);
        (void)hipOccupancyMaxActiveBlocksPerMultiprocessor(&per_cu, (const void*)fwd_megakernel, NTHR, LDS_BYTES);
        if (per_cu < 1) per_cu = 1;
        grid = cus * per_cu;
        if (ws_size < WS_END) { fprintf(stderr, "kernel_launch: workspace too small (%zu)\n", ws_size); grid = -1; }
    }
    if (grid < 0) return;
    Params p{};
    p.x = (const float*)d_in[0]; p.norm1_g = (const float*)d_in[1]; p.w_in = (const float*)d_in[2]; p.conv_w = (const float*)d_in[3];
    p.gate_i_b = (const float*)d_in[4]; p.gate_f_b = (const float*)d_in[5]; p.head_norm_g = (const float*)d_in[6]; p.w_out = (const float*)d_in[7];
    p.norm2_g = (const float*)d_in[8]; p.w_up = (const float*)d_in[9]; p.w_down = (const float*)d_in[10]; p.final_g = (const float*)d_in[11];
    p.out = (float*)d_out; p.ws = (unsigned char*)d_ws;
    (void)hipMemsetAsync((char*)d_ws + WS_CTL, 0, CTL_BYTES, stream);
    void* args[] = {&p};
    hipError_t e = hipLaunchCooperativeKernel((void*)fwd_megakernel, dim3(grid), dim3(NTHR), args, LDS_BYTES, stream);
    if (e != hipSuccess) fprintf(stderr, "cooperative launch failed: %s (grid %d)\n", hipGetErrorString(e), grid);
}
```

```cpp
#include <hip/hip_runtime.h>
#include <hip/hip_cooperative_groups.h>
#include <cstdio>
#include <cstdint>
#include <cmath>
namespace cg = cooperative_groups;
namespace pg8 {
#define PG8_LAS __attribute__((address_space(3)))
typedef unsigned short bf16_t;
typedef short bf16x8 __attribute__((ext_vector_type(8)));
typedef float f32x4 __attribute__((ext_vector_type(4)));
typedef unsigned u32x4 __attribute__((ext_vector_type(4)));
constexpr int BM = 256, BK = 64, HALF = 128, HTB = HALF * BK * 2  , STAGE_BYTES = 8 * HTB, NXCD = 8, WGM = 4;

__host__ __device__ __forceinline__ int lds_byte(int r, int c) { const int st = (r >> 4) * 2 + (c >> 5), rr = r & 15, cc = c & 31, ob = rr * 64 + cc * 2; return st * 1024 + (ob ^ (((ob >> 9) & 1) << 5)); }
__host__ __device__ __forceinline__ void stage_rc(int b, int& R, int& C) { const int st = b / 1024, sb = b % 1024, swz = sb ^ (((sb >> 9) & 1) << 5); R = (st >> 1) * 16 + swz / 64; C = (st & 1) * 32 + (swz % 64) / 2; }
__host__ __device__ __forceinline__ int perm32(int rho) { const int n = rho >> 4, i = rho & 15; return 8 * (i >> 2) + 4 * n + (i & 3); }

struct Unit { int pm, pn; };
struct Gemm { const bf16_t* A; const bf16_t* Bt; int M, N, K; };

struct StaticOrder {
    int nM, nN, nwg, G, c;
    __host__ __device__ void init(int M, int N, int G_, int c_) { nM = M / BM; nN = N / BM; nwg = nM * nN; G = G_; c = c_; }
    __host__ __device__ bool next(int i, Unit& u) const {
        const long L = (long)i * G + c; if (L >= nwg) return false;
        int wgid = (int)L; { const int q = nwg / NXCD, r = nwg % NXCD, xcd = wgid % NXCD, off = wgid / NXCD; wgid = (xcd < r ? xcd * (q + 1) : r * (q + 1) + (xcd - r) * q) + off; }
        const int nig = WGM * nN, gid = wgid / nig, fm = gid * WGM, gsz = (nM - fm) < WGM ? (nM - fm) : WGM;
        u.pm = fm + ((wgid % nig) % gsz); u.pn = (wgid % nig) / gsz; return true;
    }
    __device__ __forceinline__ void a_ready(const Unit&) const {}
    __device__ __forceinline__ void done(const Unit&) const {}
};

typedef float f32x2c_t __attribute__((ext_vector_type(2))); typedef __bf16 bf16x2c_t __attribute__((ext_vector_type(2)));
__device__ __forceinline__ unsigned cvt_pk_bf16(float lo, float hi) { f32x2c_t v = {lo, hi}; bf16x2c_t b = __builtin_convertvector(v, bf16x2c_t); return __builtin_bit_cast(unsigned, b); }
typedef float f32x2 __attribute__((ext_vector_type(2)));
__device__ __forceinline__ unsigned short bf16_1(float v) { return (unsigned short)(cvt_pk_bf16(v, v) & 0xffffu); }
__device__ __forceinline__ float row_ss(const float* ssp, int row) { const f32x4* q = (const f32x4*)(ssp + (size_t)row * 16); const f32x4 a = q[0], b = q[1], c = q[2], d = q[3];
    return (((a[0] + a[1]) + (a[2] + a[3])) + ((b[0] + b[1]) + (b[2] + b[3]))) + (((c[0] + c[1]) + (c[2] + c[3])) + ((d[0] + d[1]) + (d[2] + d[3]))); }
__device__ __forceinline__ float row_ss_q(const float* ssp, int row, int fq) { const f32x4 a = *(const f32x4*)(ssp + (size_t)row * 16 + 4 * fq); float t = (a[0] + a[1]) + (a[2] + a[3]);
    t += __shfl_xor(t, 16); t += __shfl_xor(t, 32); return t; }
struct EpiIn {
    static constexpr bool PERM = true, AFTER_DRAIN = false;
    const float* ss; unsigned char* ws; const float* gib; const float* gfb;
    static constexpr size_t O_ROPE = 512 * 1024, O_G = 3u << 20, O_QKM = 120u << 20, O_KTM = 152u << 20, O_VTM = 168u << 20, O_AK = 184u << 20, O_VT16 = 200u << 20, O_Y = 216u << 20;
    __device__ __forceinline__ void operator()(const f32x4 (&acc)[2][2][4][2], const Unit& u, int wr, int wc, int fr_, int fq_) const {
        int fr = fr_, fq = fq_; asm volatile("" : "+v"(fr), "+v"(fq));
        const int pn = u.pn;
        const int rbase = u.pm * BM + wr * 64 + fr;
        float rsv[2][4];
#pragma unroll
        for (int ai = 0; ai < 2; ++ai)
#pragma unroll
            for (int m = 0; m < 4; ++m) rsv[ai][m] = row_ss_q(ss, rbase + ai * HALF + m * 16, fq);
#pragma unroll
        for (int ai = 0; ai < 2; ++ai)
#pragma unroll
            for (int m = 0; m < 4; ++m) rsv[ai][m] = rsqrtf(rsv[ai][m] * (1.0f / 1024.0f) + 1e-6f);
        if (pn < 4) {
            bf16_t* QKm = (bf16_t*)(ws + O_QKM);
#pragma unroll
            for (int ai = 0; ai < 2; ++ai)
#pragma unroll
                for (int m = 0; m < 4; ++m) { const int row = rbase + ai * HALF + m * 16; const float r = rsv[ai][m]; bf16_t* rowp = QKm + (size_t)row * 1024 + pn * 256 + wc * 32 + 8 * fq;
#pragma unroll
                    for (int bj = 0; bj < 2; ++bj) { const f32x4 v0 = acc[ai][bj][m][0] * r, v1 = acc[ai][bj][m][1] * r; u32x4 w;
                        w.x = cvt_pk_bf16(v0[0], v0[1]); w.y = cvt_pk_bf16(v0[2], v0[3]); w.z = cvt_pk_bf16(v1[0], v1[1]); w.w = cvt_pk_bf16(v1[2], v1[3]);
                        *(u32x4*)(rowp + bj * HALF) = w; }
                    asm volatile("" ::: "memory"); }
        }
        if ((pn >= 2 && pn < 6)) {
            const int row0 = u.pm * BM; const int b = row0 >> 11;
            unsigned char* ub = ws + ((pn < 4) ? O_KTM : O_VTM) + ((size_t)(((b * 4 + 2 * (pn & 1)) * 128 + wc * 32) * 2048 + (row0 & 2047) + wr * 64)) * 2;
            const unsigned voff = (unsigned)((8 * fq) * 2048 + fr) * 2u;
#pragma unroll
            for (int ai = 0; ai < 2; ++ai)
#pragma unroll
                for (int m = 0; m < 4; m += 2) { const float r0 = rsv[ai][m], r1 = rsv[ai][m + 1];
#pragma unroll
                    for (int bj = 0; bj < 2; ++bj)
#pragma unroll
                        for (int n = 0; n < 2; ++n)
#pragma unroll
                            for (int j = 0; j < 4; ++j) { const unsigned w = cvt_pk_bf16(acc[ai][bj][m][n][j] * r0, acc[ai][bj][m + 1][n][j] * r1);
                                unsigned char* q = ub + (size_t)(((bj * 128 + 4 * n + j) * 2048 + ai * HALF + m * 16) * 2) + voff;
                                *(bf16_t*)q = (bf16_t)(w & 0xffffu); *(bf16_t*)(q + 32) = (bf16_t)(w >> 16); }
                    asm volatile("" ::: "memory"); }
        } else if (pn == 6 || pn == 7) {
            bf16_t* Y = (bf16_t*)(ws + O_Y);
#pragma unroll
            for (int ai = 0; ai < 2; ++ai)
#pragma unroll
                for (int m = 0; m < 4; ++m) { const int row = rbase + ai * HALF + m * 16; const float r = rsv[ai][m]; bf16_t* rowp = Y + (size_t)row * 1024 + (pn - 6) * 256 + wc * 32 + 8 * fq;
#pragma unroll
                    for (int bj = 0; bj < 2; ++bj) { f32x4 v0 = acc[ai][bj][m][0] * r, v1 = acc[ai][bj][m][1] * r;
#pragma unroll
                        for (int j = 0; j < 4; ++j) { v0[j] = __builtin_amdgcn_rcpf(1.0f + __expf(-v0[j])); v1[j] = __builtin_amdgcn_rcpf(1.0f + __expf(-v1[j])); }
                        u32x4 w; w.x = cvt_pk_bf16(v0[0], v0[1]); w.y = cvt_pk_bf16(v0[2], v0[3]); w.z = cvt_pk_bf16(v1[0], v1[1]); w.w = cvt_pk_bf16(v1[2], v1[3]);
                        *(u32x4*)(rowp + bj * HALF) = w; }
                    asm volatile("" ::: "memory"); }
        } else if (pn >= 8 && pn < 12) {
            const bool isk = pn >= 10; const int head = 4 * (pn & 1) + wc; const float qs = isk ? 1.0f : 0.125f * 1.4426950408889634f;
            const float* ropeC = (const float*)(ws + O_ROPE) + 8 * fq; const float* ropeS = ropeC + 2048 * 32;
            f32x4 tb[2][4];
            { const int pos = rbase & 2047; tb[0][0] = *(const f32x4*)(ropeC + pos * 32); tb[0][1] = *(const f32x4*)(ropeC + pos * 32 + 4); tb[0][2] = *(const f32x4*)(ropeS + pos * 32); tb[0][3] = *(const f32x4*)(ropeS + pos * 32 + 4); }
#pragma unroll
            for (int it = 0; it < 8; ++it) { const int ai = it >> 2, m = it & 3; const int row = rbase + ai * HALF + m * 16; const float r = rsv[ai][m] * qs;
                if (it < 7) { const int pos2 = (rbase + ((it + 1) >> 2) * HALF + ((it + 1) & 3) * 16) & 2047;
                    tb[(it + 1) & 1][0] = *(const f32x4*)(ropeC + pos2 * 32); tb[(it + 1) & 1][1] = *(const f32x4*)(ropeC + pos2 * 32 + 4); tb[(it + 1) & 1][2] = *(const f32x4*)(ropeS + pos2 * 32); tb[(it + 1) & 1][3] = *(const f32x4*)(ropeS + pos2 * 32 + 4); }
                const f32x4 c0 = tb[it & 1][0], c1 = tb[it & 1][1], s0 = tb[it & 1][2], s1 = tb[it & 1][3];
                const f32x4 a0 = acc[ai][0][m][0] * r, a1 = acc[ai][0][m][1] * r, b0 = acc[ai][1][m][0] * r, b1 = acc[ai][1][m][1] * r;
                const f32x4 o10 = a0 * c0 - b0 * s0, o11 = a1 * c1 - b1 * s1, o20 = a0 * s0 + b0 * c0, o21 = a1 * s1 + b1 * c1;
                bf16_t* dst = isk ? ((bf16_t*)(ws + O_AK) + (size_t)row * 512 + head * 64 + 8 * fq) : ((bf16_t*)(ws + O_Y) + (size_t)row * 1024 + 512 + head * 64 + 8 * fq);
                u32x4 w; w.x = cvt_pk_bf16(o10[0], o10[1]); w.y = cvt_pk_bf16(o10[2], o10[3]); w.z = cvt_pk_bf16(o11[0], o11[1]); w.w = cvt_pk_bf16(o11[2], o11[3]);
                *(u32x4*)(dst) = w;
                w.x = cvt_pk_bf16(o20[0], o20[1]); w.y = cvt_pk_bf16(o20[2], o20[3]); w.z = cvt_pk_bf16(o21[0], o21[1]); w.w = cvt_pk_bf16(o21[2], o21[3]);
                *(u32x4*)(dst + 32) = w;
                asm volatile("" ::: "memory"); }
        } else if (pn == 12 || pn == 13) {
            const int row0 = u.pm * BM; const int b = row0 >> 11;
            typedef unsigned u32x2v __attribute__((ext_vector_type(2)));
            unsigned char* ub = ws + O_VT16 + ((size_t)((((b * 8 + 4 * (pn - 12) + (wc >> 1)) * 16 * 32 + ((row0 & 2047) >> 6) + wr) * 256) + (wc & 1) * 128)) * 2;
            const unsigned voff = (unsigned)(fr * 32 * 256 + 8 * fq * 4) * 2u;
#pragma unroll
            for (int ai = 0; ai < 2; ++ai) { const float r0 = rsv[ai][0], r1 = rsv[ai][1], r2 = rsv[ai][2], r3 = rsv[ai][3];
#pragma unroll
                for (int bj = 0; bj < 2; ++bj)
#pragma unroll
                    for (int n = 0; n < 2; ++n)
#pragma unroll
                        for (int j = 0; j < 4; ++j) { u32x2v w; w.x = cvt_pk_bf16(acc[ai][bj][0][n][j] * r0, acc[ai][bj][1][n][j] * r1); w.y = cvt_pk_bf16(acc[ai][bj][2][n][j] * r2, acc[ai][bj][3][n][j] * r3);
                            *(u32x2v*)(ub + (size_t)((bj * 262144 + 2 * ai * 256 + (4 * n + j) * 4) * 2) + voff) = w; }
                asm volatile("" ::: "memory"); }
        } else if (pn == 14) {
            if (wc == 0 && fq < 2) {
                float* G = (float*)(ws + O_G);
#pragma unroll
                for (int ai = 0; ai < 2; ++ai)
#pragma unroll
                    for (int m = 0; m < 4; ++m) { const int row = rbase + ai * HALF + m * 16; const float r = rsv[ai][m];
#pragma unroll
                        for (int n = 0; n < 2; ++n) { f32x4 v = acc[ai][0][m][n] * r; f32x4 o;
#pragma unroll
                            for (int j = 0; j < 4; ++j) { const int c8 = 4 * n + j;
                                if (fq == 0) o[j] = v[j] + gib[c8];
                                else { const float x = v[j] + gfb[c8]; o[j] = fminf(x, 0.0f) - __logf(1.0f + __expf(-fabsf(x))); } }
                            *(f32x4*)(G + (size_t)row * 16 + 8 * fq + 4 * n) = o; }
                        asm volatile("" ::: "memory"); }
            }
        }
    }
};
struct EpiRes {
    static constexpr bool PERM = true, AFTER_DRAIN = false;
    bf16_t* xb; float* ssn;
    __device__ __forceinline__ void operator()(const f32x4 (&acc)[2][2][4][2], const Unit& u, int wr, int wc, int fr, int fq) const {
        const int col0 = u.pn * BM + wc * 32 + 8 * fq;
#pragma unroll
        for (int ai = 0; ai < 2; ++ai)
#pragma unroll
            for (int m = 0; m < 4; ++m) { const int row = u.pm * BM + ai * HALF + wr * 64 + m * 16 + fr; bf16_t* rp = xb + (size_t)row * 1024 + col0; float sq = 0.f;
#pragma unroll
                for (int bj = 0; bj < 2; ++bj) { const u32x4 b = *(const u32x4*)(rp + bj * HALF);
                    const f32x4 v0 = acc[ai][bj][m][0], v1 = acc[ai][bj][m][1];
                    const float o0 = __uint_as_float(b.x << 16) + v0[0], o1 = __uint_as_float(b.x & 0xffff0000u) + v0[1], o2 = __uint_as_float(b.y << 16) + v0[2], o3 = __uint_as_float(b.y & 0xffff0000u) + v0[3];
                    const float o4 = __uint_as_float(b.z << 16) + v1[0], o5 = __uint_as_float(b.z & 0xffff0000u) + v1[1], o6 = __uint_as_float(b.w << 16) + v1[2], o7 = __uint_as_float(b.w & 0xffff0000u) + v1[3];
                    u32x4 w; w.x = cvt_pk_bf16(o0, o1); w.y = cvt_pk_bf16(o2, o3); w.z = cvt_pk_bf16(o4, o5); w.w = cvt_pk_bf16(o6, o7);
                    *(u32x4*)(rp + bj * HALF) = w;
                    sq += ((o0 * o0 + o1 * o1) + (o2 * o2 + o3 * o3)) + ((o4 * o4 + o5 * o5) + (o6 * o6 + o7 * o7)); }
                sq += __shfl_xor(sq, 16); sq += __shfl_xor(sq, 32);
                if (fq == 0) ssn[(size_t)row * 16 + u.pn * 4 + wc] = sq; }
    }
};
struct EpiUp {
    static constexpr bool PERM = true, AFTER_DRAIN = false;
    const float* ss; bf16_t* U;
    __device__ __forceinline__ void operator()(const f32x4 (&acc)[2][2][4][2], const Unit& u, int wr, int wc, int fr, int fq) const {
        const int rbase = u.pm * BM + wr * 64 + fr;
        float rsv[2][4];
#pragma unroll
        for (int ai = 0; ai < 2; ++ai)
#pragma unroll
            for (int m = 0; m < 4; ++m) rsv[ai][m] = row_ss_q(ss, rbase + ai * HALF + m * 16, fq);
#pragma unroll
        for (int ai = 0; ai < 2; ++ai)
#pragma unroll
            for (int m = 0; m < 4; ++m) { const int row = rbase + ai * HALF + m * 16; const float r = rsqrtf(rsv[ai][m] * (1.0f / 1024.0f) + 1e-6f);
                bf16_t* rowp = U + (size_t)row * 4096 + u.pn * BM + wc * 32 + 8 * fq;
#pragma unroll
                for (int bj = 0; bj < 2; ++bj) { f32x4 v0 = acc[ai][bj][m][0] * r, v1 = acc[ai][bj][m][1] * r;
#pragma unroll
                    for (int j = 0; j < 4; ++j) { v0[j] = fmaxf(v0[j], 0.f); v0[j] *= v0[j]; v1[j] = fmaxf(v1[j], 0.f); v1[j] *= v1[j]; }
                    u32x4 w; w.x = cvt_pk_bf16(v0[0], v0[1]); w.y = cvt_pk_bf16(v0[2], v0[3]); w.z = cvt_pk_bf16(v1[0], v1[1]); w.w = cvt_pk_bf16(v1[2], v1[3]);
                    *(u32x4*)(rowp + bj * HALF) = w; } }
    }
};
template <class Epi, class Sched, bool ALIGN_EPI = false, bool SP2 = false>
__device__ __forceinline__ void gemm_phase(PG8_LAS unsigned char* lds, const Gemm g, const Sched& S, const Epi& E) {
    int tid_ = threadIdx.x; asm volatile("" : "+v"(tid_));
    const int tid = tid_, wid = __builtin_amdgcn_readfirstlane(tid >> 6), lane = tid & 63, wr = wid >> 2, wc = wid & 3, fr = lane & 15, fq = lane >> 4;
    const int K = g.K, nt = K / BK;
    unsigned voffA[2], voffB[2];
#pragma unroll
    for (int i = 0; i < 2; ++i) { int R, C; stage_rc(tid * 16 + i * 8192, R, C); const int Rb = Epi::PERM ? ((R & ~31) + perm32(R & 31)) : R;
        voffA[i] = (unsigned)(R * K + C) * 2u; voffB[i] = (unsigned)(Rb * K + C) * 2u; }
    const size_t kstep = (size_t)(BK * 2);
    const size_t hstep = (size_t)HALF * K * 2;
    const size_t tstep = 2 * hstep;
    const unsigned ldsw = (unsigned)wid * 1024u;
    const int aoff = lds_byte(wr * 64 + fr, fq * 8), boff = lds_byte(wc * 32 + fr, fq * 8);
#define PG8_SA(b, h) (((b) * 2 + (h)) * HTB)
#define PG8_SB(b, h) ((4 + (b) * 2 + (h)) * HTB)
#define PG8_STAGE(bufoff, gbase, voff) do { _Pragma("unroll") for (int _i = 0; _i < 2; ++_i) \
        __builtin_amdgcn_global_load_lds((const unsigned*)((const char*)(gbase) + (voff)[_i]), (PG8_LAS unsigned*)(lds + (bufoff) + ldsw + _i * 8192), 16, 0, 0); } while (0)
#define PG8_LDA(dst, b, h) do { _Pragma("unroll") for (int m = 0; m < 4; ++m) _Pragma("unroll") for (int k = 0; k < 2; ++k) dst[m][k] = *(const PG8_LAS bf16x8*)(lds + PG8_SA(b, h) + aoff + m * 2048 + k * 1024); } while (0)
#define PG8_LDB(dst, b, h) do { _Pragma("unroll") for (int n = 0; n < 2; ++n) _Pragma("unroll") for (int k = 0; k < 2; ++k) dst[n][k] = *(const PG8_LAS bf16x8*)(lds + PG8_SB(b, h) + boff + n * 2048 + k * 1024); } while (0)
#define PG8_MMA(ai, bj, At, Bt) do { __builtin_amdgcn_s_setprio(1); _Pragma("unroll") for (int m = 0; m < 4; ++m) _Pragma("unroll") for (int n = 0; n < 2; ++n) _Pragma("unroll") for (int k = 0; k < 2; ++k) \
        acc[ai][bj][m][n] = __builtin_amdgcn_mfma_f32_16x16x32_bf16(Bt[n][k], At[m][k], acc[ai][bj][m][n], 0, 0, 0); __builtin_amdgcn_s_setprio(0); } while (0)
#define PG8_WAIT_V(n) asm volatile("s_waitcnt vmcnt(" #n ")" ::: "memory")
#define PG8_WAIT_L(n) asm volatile("s_waitcnt lgkmcnt(" #n ")" ::: "memory")
#define PG8_BAR __builtin_amdgcn_s_barrier()
#define PG8_SCHED __builtin_amdgcn_sched_barrier(0)
    Unit cur, nxt; int ui = 0;
    if (!S.next(0, cur)) return;
    f32x4 acc[2][2][4][2];
#pragma unroll
    for (int a = 0; a < 2; ++a)
#pragma unroll
        for (int b = 0; b < 2; ++b)
#pragma unroll
            for (int m = 0; m < 4; ++m)
#pragma unroll
                for (int n = 0; n < 2; ++n) acc[a][b][m][n] = (f32x4){0.f, 0.f, 0.f, 0.f};
    bf16x8 At[4][2], B0[2][2], B1[2][2];
    const char* cA = (const char*)g.A + (size_t)cur.pm * tstep; const char* cB = (const char*)g.Bt + (size_t)cur.pn * tstep;
    S.a_ready(cur);
    if constexpr (SP2) {
        PG8_STAGE(PG8_SB(0, 0), cB, voffB); PG8_STAGE(PG8_SB(0, 1), cB + hstep, voffB); PG8_STAGE(PG8_SA(0, 0), cA, voffA); PG8_STAGE(PG8_SA(0, 1), cA + hstep, voffA);
        if (wr == 1) PG8_BAR;
        PG8_WAIT_V(2); PG8_BAR;
        PG8_STAGE(PG8_SB(1, 0), cB + kstep, voffB); PG8_STAGE(PG8_SA(1, 0), cA + kstep, voffA); PG8_STAGE(PG8_SB(1, 1), cB + hstep + kstep, voffB);
        PG8_WAIT_V(6); PG8_BAR;
    } else {
        PG8_STAGE(PG8_SB(0, 0), cB, voffB); PG8_STAGE(PG8_SA(0, 0), cA, voffA); PG8_STAGE(PG8_SB(0, 1), cB + hstep, voffB); PG8_STAGE(PG8_SA(0, 1), cA + hstep, voffA);
        if (wr == 1) PG8_BAR;
        PG8_WAIT_V(4); PG8_BAR;
        PG8_STAGE(PG8_SB(1, 0), cB + kstep, voffB); PG8_STAGE(PG8_SA(1, 0), cA + kstep, voffA); PG8_STAGE(PG8_SB(1, 1), cB + hstep + kstep, voffB);
        PG8_WAIT_V(6); PG8_BAR;
    }
    for (;;) {
        const bool has_next = S.next(ui + 1, nxt);
        const char* nA = has_next ? (const char*)g.A + (size_t)nxt.pm * tstep : cA; const char* nB = has_next ? (const char*)g.Bt + (size_t)nxt.pn * tstep : cB;
        for (int t = 0; t < nt; t += 2) {
            const bool last = (t == nt - 2);
            const char* a1 = cA + (size_t)(t + 1) * kstep;
            const char* a2 = last ? nA : cA + (size_t)(t + 2) * kstep; const char* b2 = last ? nB : cB + (size_t)(t + 2) * kstep;
            const char* a3 = a2 + kstep; const char* b3 = b2 + kstep;
            if (last && has_next) S.a_ready(nxt);
            if constexpr (SP2) {
            PG8_LDB(B0, 0, 0); PG8_LDB(B1, 0, 1); PG8_SCHED; PG8_LDA(At, 0, 0); PG8_STAGE(PG8_SA(1, 1), a1 + hstep, voffA);
            PG8_WAIT_V(8); PG8_WAIT_L(0); PG8_BAR; PG8_MMA(0, 0, At, B0); PG8_MMA(0, 1, At, B1); PG8_BAR; PG8_SCHED;
            PG8_LDA(At, 0, 1); PG8_STAGE(PG8_SB(0, 0), b2, voffB); PG8_STAGE(PG8_SB(0, 1), b2 + hstep, voffB); PG8_STAGE(PG8_SA(0, 0), a2, voffA);
            PG8_WAIT_V(8); PG8_WAIT_L(0); PG8_BAR; PG8_MMA(1, 0, At, B0); PG8_MMA(1, 1, At, B1); PG8_BAR; PG8_SCHED;
            PG8_LDB(B0, 1, 0); PG8_LDB(B1, 1, 1); PG8_SCHED; PG8_LDA(At, 1, 0); PG8_STAGE(PG8_SA(0, 1), a2 + hstep, voffA);
            PG8_WAIT_V(8); PG8_WAIT_L(0); PG8_BAR; PG8_MMA(0, 0, At, B0); PG8_MMA(0, 1, At, B1); PG8_BAR; PG8_SCHED;
            PG8_LDA(At, 1, 1); PG8_STAGE(PG8_SB(1, 0), b3, voffB); PG8_STAGE(PG8_SB(1, 1), b3 + hstep, voffB); PG8_STAGE(PG8_SA(1, 0), a3, voffA);
            PG8_WAIT_V(8); PG8_WAIT_L(0); PG8_BAR; PG8_MMA(1, 0, At, B0); PG8_MMA(1, 1, At, B1); PG8_BAR; PG8_SCHED;
            } else {
            PG8_LDB(B0, 0, 0); PG8_SCHED; PG8_LDA(At, 0, 0); PG8_STAGE(PG8_SA(1, 1), a1 + hstep, voffA);
            PG8_WAIT_L(8); PG8_BAR; PG8_WAIT_L(0); PG8_MMA(0, 0, At, B0); PG8_BAR; PG8_SCHED;
            PG8_LDB(B1, 0, 1); PG8_STAGE(PG8_SB(0, 0), b2, voffB);
            PG8_BAR; PG8_WAIT_L(0); PG8_MMA(0, 1, At, B1); PG8_BAR;
            PG8_LDA(At, 0, 1); PG8_STAGE(PG8_SA(0, 0), a2, voffA);
            PG8_BAR; PG8_WAIT_L(0); PG8_MMA(1, 0, At, B0); PG8_BAR; PG8_SCHED;
            PG8_STAGE(PG8_SB(0, 1), b2 + hstep, voffB);
            PG8_WAIT_V(6); PG8_BAR; PG8_MMA(1, 1, At, B1); PG8_BAR;
            PG8_LDB(B0, 1, 0); PG8_SCHED; PG8_LDA(At, 1, 0); PG8_STAGE(PG8_SA(0, 1), a2 + hstep, voffA);
            PG8_WAIT_L(8); PG8_BAR; PG8_WAIT_L(0); PG8_MMA(0, 0, At, B0); PG8_BAR; PG8_SCHED;
            PG8_LDB(B1, 1, 1); PG8_STAGE(PG8_SB(1, 0), b3, voffB);
            PG8_BAR; PG8_WAIT_L(0); PG8_MMA(0, 1, At, B1); PG8_BAR;
            PG8_LDA(At, 1, 1); PG8_STAGE(PG8_SA(1, 0), a3, voffA);
            PG8_BAR; PG8_WAIT_L(0); PG8_MMA(1, 0, At, B0); PG8_BAR; PG8_SCHED;
            PG8_STAGE(PG8_SB(1, 1), b3 + hstep, voffB);
            PG8_WAIT_V(6); PG8_BAR; PG8_MMA(1, 1, At, B1); PG8_BAR;
            }
        }
        if constexpr (ALIGN_EPI) { if (wr == 0) PG8_BAR; }
        if constexpr (!Epi::AFTER_DRAIN) { E(acc, cur, wr, wc, fr, fq); S.done(cur); }
        if (!has_next) break;
#pragma unroll
        for (int a = 0; a < 2; ++a)
#pragma unroll
            for (int b = 0; b < 2; ++b)
#pragma unroll
                for (int m = 0; m < 4; ++m)
#pragma unroll
                    for (int n = 0; n < 2; ++n) acc[a][b][m][n] = (f32x4){0.f, 0.f, 0.f, 0.f};
        cur = nxt; cA = nA; cB = nB; ++ui;
        if constexpr (ALIGN_EPI) { if (wr == 1) PG8_BAR; }
    }
    PG8_WAIT_V(0);
    if constexpr (!ALIGN_EPI) { if (wr == 0) PG8_BAR; }
    PG8_BAR;
    if constexpr (Epi::AFTER_DRAIN) { E.fused(acc, cur, wr, wc, fr, fq, lds, wid, lane); S.done(cur); }
#undef PG8_SA
#undef PG8_SB
#undef PG8_STAGE
#undef PG8_LDA
#undef PG8_LDB
#undef PG8_MMA
#undef PG8_WAIT_V
#undef PG8_WAIT_L
#undef PG8_BAR
#undef PG8_SCHED
}
}
#define LAS __attribute__((address_space(3)))
typedef unsigned short bf16;
typedef short bf16x8 __attribute__((ext_vector_type(8)));
typedef float f32x4 __attribute__((ext_vector_type(4)));
typedef unsigned u32x4 __attribute__((ext_vector_type(4)));
typedef unsigned u32x2 __attribute__((ext_vector_type(2)));
constexpr int SEQ = 2048, DM = 1024, MROWS = 16384, FF = 4096, NINP = 3840, NINL = 3600, NTHR = 512, NWAVE = 8;
constexpr size_t MiB = 1u << 20;
constexpr size_t WS_SS = 0, WS_ROPE = 512 * 1024, WS_N = 1 * MiB, WS_MST = 2 * MiB, WS_G = 3 * MiB;
constexpr size_t WS_WIN = 4 * MiB, WS_WOUT = 19 * MiB, WS_WUP = 23 * MiB, WS_WDN = 39 * MiB;
constexpr size_t WS_XB = 56 * MiB;
constexpr size_t WS_SSP = 88 * MiB;
constexpr size_t WS_P1O = 93 * MiB, WS_P1ML = 109 * MiB;
constexpr size_t WS_U = 120 * MiB;
constexpr size_t WS_QKM = 120 * MiB, WS_KTM = 152 * MiB, WS_VTM = 168 * MiB, WS_AK = 184 * MiB, WS_VT16 = 200 * MiB, WS_Y = 216 * MiB, WS_END = 248 * MiB;
constexpr size_t WS_CTL = 2 * MiB + 256 * 1024, CTL_BYTES = 16384;
constexpr int LDS_BYTES = 147456, LDS_MISC = 131072 + 320;

struct Params {
    const float *x, *norm1_g, *w_in, *conv_w, *gate_i_b, *gate_f_b, *head_norm_g, *w_out, *norm2_g, *w_up, *w_down, *final_g;
    float* out; unsigned char* ws;
};

__device__ __forceinline__ unsigned pk2(float lo, float hi) { return pg8::cvt_pk_bf16(lo, hi); }
__device__ __forceinline__ float bflo(unsigned w) { return __uint_as_float(w << 16); }
__device__ __forceinline__ float bfhi(unsigned w) { return __uint_as_float(w & 0xffff0000u); }
__device__ __forceinline__ float wave_sum(float v) {
#pragma unroll
    for (int o = 1; o < 64; o <<= 1) v += __shfl_xor(v, o);
    return v;
}
__device__ __forceinline__ float wave_max(float v) {
#pragma unroll
    for (int o = 1; o < 64; o <<= 1) v = fmaxf(v, __shfl_xor(v, o));
    return v;
}
__device__ __forceinline__ float wave_incl_scan(float v, int lane) {
#pragma unroll
    for (int o = 1; o < 64; o <<= 1) { const float t = __shfl_up(v, o); if (lane >= o) v += t; }
    return v;
}

#define DPP_STEP_ADD(v, ctrl, rm) do { const int t_ = __builtin_amdgcn_update_dpp(0, __float_as_int(v), (ctrl), (rm), 0xf, false); v += __int_as_float(t_); } while (0)
#define DPP_STEP_MAX(v, ctrl, rm) do { const int t_ = __builtin_amdgcn_update_dpp((int)0xff800000, __float_as_int(v), (ctrl), (rm), 0xf, false); v = fmaxf(v, __int_as_float(t_)); } while (0)
__device__ __forceinline__ float wave_incl_scan_dpp(float v) {
    DPP_STEP_ADD(v, 0x111, 0xf); DPP_STEP_ADD(v, 0x112, 0xf); DPP_STEP_ADD(v, 0x114, 0xf); DPP_STEP_ADD(v, 0x118, 0xf); DPP_STEP_ADD(v, 0x142, 0xa); DPP_STEP_ADD(v, 0x143, 0xc);
    return v;
}
__device__ __forceinline__ float wave_incl_max_dpp(float v) {
    DPP_STEP_MAX(v, 0x111, 0xf); DPP_STEP_MAX(v, 0x112, 0xf); DPP_STEP_MAX(v, 0x114, 0xf); DPP_STEP_MAX(v, 0x118, 0xf); DPP_STEP_MAX(v, 0x142, 0xa); DPP_STEP_MAX(v, 0x143, 0xc);
    return v;
}
__device__ __forceinline__ float wave_max_dpp(float v) {
    DPP_STEP_MAX(v, 0x111, 0xf); DPP_STEP_MAX(v, 0x112, 0xf); DPP_STEP_MAX(v, 0x114, 0xf); DPP_STEP_MAX(v, 0x118, 0xf); DPP_STEP_MAX(v, 0x142, 0xa); DPP_STEP_MAX(v, 0x143, 0xc);
    return __int_as_float(__builtin_amdgcn_readlane(__float_as_int(v), 63));
}
#define MFMA16(a, b, c) __builtin_amdgcn_mfma_f32_16x16x32_bf16((a), (b), (c), 0, 0, 0)

__device__ __forceinline__ int win_src_col(int nb, int& nvalid) {
    nvalid = 32;
    if (nb < 2048) return nb;
    if (nb < 3072) { int xx = nb - 2048; const int isk = xx >> 9; xx &= 511; const int T = xx >> 8, bj = (xx >> 7) & 1, hl = (xx >> 5) & 3; return 2064 + isk * 512 + 64 * (4 * T + hl) + 32 * bj; }
    if (nb < 3584) return 3088 + (nb - 3072);
    if (nb == 3584) { nvalid = 16; return 2048; }
    nvalid = 0; return 0;
}
__device__ __forceinline__ void transpose_item(const float* W, int K, int Nsrc, int src_col, int nvalid, const float* g, bf16* WT, int dst_row, int k0, LAS float* scr, int lane) {
    const int c = lane & 31;
    float wv[32];
#pragma unroll
    for (int i = 0; i < 32; ++i) { const int kk = 2 * i + (lane >> 5); wv[i] = (c < nvalid) ? __builtin_nontemporal_load(W + (size_t)(k0 + kk) * Nsrc + src_col + c) : 0.f; }
    if (g) {
#pragma unroll
        for (int i = 0; i < 32; ++i) wv[i] *= g[k0 + 2 * i + (lane >> 5)]; }
#pragma unroll
    for (int i = 0; i < 32; ++i) scr[(2 * i + (lane >> 5)) * 33 + c] = wv[i];
    asm volatile("s_waitcnt lgkmcnt(0)" ::: "memory");
    const int ch = lane & 7;
#pragma unroll
    for (int j = 0; j < 4; ++j) { const int n = (lane >> 3) + 8 * j; const LAS float* s = scr + (8 * ch) * 33 + n;
        u32x4 o; o.x = pk2(s[0 * 33], s[1 * 33]); o.y = pk2(s[2 * 33], s[3 * 33]); o.z = pk2(s[4 * 33], s[5 * 33]); o.w = pk2(s[6 * 33], s[7 * 33]);
        *(u32x4*)(WT + (size_t)(dst_row + n) * K + k0 + 8 * ch) = o; }
    asm volatile("s_waitcnt lgkmcnt(0)" ::: "memory");
}
constexpr int I_IN = 16 * (NINP / 32), I_OUT = 16 * 32, I_UP = 16 * 128, I_DN = 64 * 32, I_L = I_IN + I_OUT + I_UP + I_DN;
__device__ __forceinline__ void convert_item(const Params& p, int it, LAS float* scr, int lane) {
    const int l = it / I_L; int r = it % I_L;
    if (r < I_IN) { const int nblk = NINP / 32, kb = r / nblk, nb = (r % nblk) * 32; int nv; const int sc = win_src_col(nb, nv);
        transpose_item(p.w_in + (size_t)l * DM * NINL, DM, NINL, sc, nv, p.norm1_g + l * DM, (bf16*)(p.ws + WS_WIN) + (size_t)l * NINP * DM, nb, kb * 64, scr, lane); return; }
    r -= I_IN;
    if (r < I_OUT) { const int kb = r / 32, nb = (r % 32) * 32;
        transpose_item(p.w_out + (size_t)l * DM * DM, DM, DM, nb, 32, nullptr, (bf16*)(p.ws + WS_WOUT) + (size_t)l * DM * DM, nb, kb * 64, scr, lane); return; }
    r -= I_OUT;
    if (r < I_UP) { const int kb = r / 128, nb = (r % 128) * 32;
        transpose_item(p.w_up + (size_t)l * DM * FF, DM, FF, nb, 32, p.norm2_g + l * DM, (bf16*)(p.ws + WS_WUP) + (size_t)l * FF * DM, nb, kb * 64, scr, lane); return; }
    r -= I_UP;
    { const int kb = r / 32, nb = (r % 32) * 32;
        transpose_item(p.w_down + (size_t)l * FF * DM, FF, DM, nb, 32, nullptr, (bf16*)(p.ws + WS_WDN) + (size_t)l * DM * FF, nb, kb * 64, scr, lane); }
}
__device__ __forceinline__ void p0_prologue(const Params& p, LAS unsigned char* lds, int wave, int lane, int G, int n_items) {
    LAS float* scr = (LAS float*)(lds + wave * 16384);
    const int gw = blockIdx.x * NWAVE + wave, NGW = G * NWAVE;
    if (n_items < 0) { constexpr int I_A = I_IN + I_OUT;
        for (int j = gw; j < 2 * I_A; j += NGW) convert_item(p, (j / I_A) * I_L + (j % I_A), scr, lane); }
    else for (int it = gw; it < n_items; it += NGW) convert_item(p, it, scr, lane);
    float* ss = (float*)(p.ws + WS_SSP); bf16* xb = (bf16*)(p.ws + WS_XB);
    for (int m0 = gw; m0 < MROWS; m0 += 2 * NGW) {
        f32x4 v[2][4];
#pragma unroll
        for (int q = 0; q < 2; ++q) { const int m = (m0 + q * NGW < MROWS) ? m0 + q * NGW : m0; const f32x4* xr = (const f32x4*)(p.x + (size_t)m * DM) + lane;
#pragma unroll
            for (int j = 0; j < 4; ++j) v[q][j] = __builtin_nontemporal_load(xr + 64 * j); }
#pragma unroll
        for (int q = 0; q < 2; ++q) { const int m = m0 + q * NGW; if (m < MROWS) { float s = 0.f; u32x2* o8 = (u32x2*)(xb + (size_t)m * DM) + lane;
#pragma unroll
            for (int j = 0; j < 4; ++j) { const f32x4 t = v[q][j]; s += (t[0] * t[0] + t[1] * t[1]) + (t[2] * t[2] + t[3] * t[3]); u32x2 w; w.x = pk2(t[0], t[1]); w.y = pk2(t[2], t[3]); o8[64 * j] = w; }
            s = wave_sum(s); if (lane < 16) ss[(size_t)m * 16 + lane] = (lane == 0) ? s : 0.f; } }
    }
    const int gt = blockIdx.x * NTHR + threadIdx.x, NGT = G * NTHR;
    float* rc = (float*)(p.ws + WS_ROPE); float* rsn = rc + SEQ * 32;
    for (int i = gt; i < SEQ * 32; i += NGT) { const int pos = i >> 5, fi = i & 31;
        const float inv = exp2f(-(float)fi * (13.287712379549449f / 32.0f)); const float ang = (float)pos * inv;
        const float n = rintf(ang * 0.15915494309189535f); float rr = fmaf(-n, 6.2831854820251465f, ang); rr = fmaf(-n, -1.7484555e-7f, rr);
        rc[i] = __cosf(rr); rsn[i] = __sinf(rr); }
}

struct ScanLd { u32x4 kc[2]; unsigned kb[2], ka[2]; float li, lf; };
__device__ __forceinline__ void scan_load(ScanLd& L, const bf16* Krow, const bf16* Vrow, const float* Gp, int tok0, int fq, int lane, int gcol) {
    L.li = Gp[(size_t)(tok0 + lane) * 16 + gcol]; L.lf = Gp[(size_t)(tok0 + lane) * 16 + 8 + gcol];
#pragma unroll
    for (int ks = 0; ks < 2; ++ks) { const int base = tok0 + 32 * ks + 8 * fq;
        L.kc[ks] = __builtin_nontemporal_load((const u32x4*)(Krow + base));
        L.kb[ks] = (base >= 2) ? *(const unsigned*)(Krow + base - 2) : 0u;
        L.ka[ks] = (base + 8 < SEQ) ? *(const unsigned*)(Krow + base + 8) : 0u; }
}
__device__ __forceinline__ void scan_wave(const Params& p, int layer, int sw, LAS float* wl, int lane, bool bar_mid) {
    const int ksl = sw & 7, dir = (sw >> 3) & 1, hh = (sw >> 4) & 3, b = sw >> 6;
    const int fr = lane & 15, fq = lane >> 4, kdim = 16 * ksl + fr;
    const float* cw = p.conv_w + (size_t)layer * 5 * 1024 + 512 + hh * 128 + kdim;
    float cwt[5];
#pragma unroll
    for (int t = 0; t < 5; ++t) cwt[t] = cw[t * 1024];
    const bf16* Krow = (const bf16*)(p.ws + WS_KTM) + ((size_t)((b * 4 + hh) * 128 + kdim)) * SEQ;
    const bf16* Vrow = (const bf16*)(p.ws + WS_VTM) + ((size_t)((b * 4 + hh) * 128 + fr)) * SEQ;
    const float* Gp = (const float*)(p.ws + WS_G) + (size_t)b * SEQ * 16;
    const int gcol = dir * 4 + hh;
    bf16* Ct = (bf16*)p.out; float* Nst = (float*)(p.ws + WS_N); float* Mst = (float*)(p.ws + WS_MST);
    const f32x4 z4 = {0.f, 0.f, 0.f, 0.f};
    f32x4 C[8], CN = z4; float mrun = -1e30f;
#pragma unroll
    for (int nt = 0; nt < 8; ++nt) C[nt] = z4;
    const bf16x8 ones = {0x3F80, 0x3F80, 0x3F80, 0x3F80, 0x3F80, 0x3F80, 0x3F80, 0x3F80};
    ScanLd cur, nxt;
    scan_load(cur, Krow, Vrow, Gp, (dir ? 31 : 0) * 64, fq, lane, gcol);
    for (int cs = 0; cs < 32; ++cs) {
        if (bar_mid && cs == 11) __syncthreads();
        const int pc = dir ? 31 - cs : cs;
        bf16x8 vv[8][2];
#pragma unroll
        for (int ks = 0; ks < 2; ++ks)
#pragma unroll
            for (int nt = 0; nt < 8; ++nt) vv[nt][ks] = *(const bf16x8*)(Vrow + (size_t)nt * 16 * SEQ + pc * 64 + 32 * ks + 8 * fq);
        if (cs + 1 < 32) scan_load(nxt, Krow, Vrow, Gp, (dir ? 30 - cs : cs + 1) * 64, fq, lane, gcol); else nxt = cur;
        const float pre = wave_incl_scan_dpp(cur.lf); const float total = __int_as_float(__builtin_amdgcn_readlane(__float_as_int(pre), 63));
        const float g = dir ? (pre - cur.lf + cur.li) : (total - pre + cur.li);
        const float gmax = wave_max_dpp(g);
        const float mn = fmaxf(total + mrun, gmax); const float decay = __expf(total + mrun - mn); const float w = __expf(g - mn);
        const size_t sidx = (size_t)((b * 4 + hh) * 2 + dir) * 32 + pc;
        { bf16* Cd = Ct + sidx * 16384 + (size_t)fr * 128 + 16 * ksl + 4 * fq;
#pragma unroll
          for (int nt = 0; nt < 8; ++nt) { u32x2 w0; w0.x = pk2(C[nt][0], C[nt][1]); w0.y = pk2(C[nt][2], C[nt][3]); __builtin_nontemporal_store(w0, (u32x2*)(Cd + nt * 16 * 128)); }
          if (fr == 0) *(f32x4*)(Nst + sidx * 128 + 16 * ksl + 4 * fq) = CN;
          if (ksl == 0 && lane == 0) Mst[sidx] = mrun; }
        wl[lane] = w;
        asm volatile("s_waitcnt lgkmcnt(0)" ::: "memory");
        bf16x8 afr[2];
#pragma unroll
        for (int ks = 0; ks < 2; ++ks) {
            const f32x4 wa = *(const LAS f32x4*)(wl + 32 * ks + 8 * fq), wb = *(const LAS f32x4*)(wl + 32 * ks + 8 * fq + 4);
            float r[12]; r[0] = bflo(cur.kb[ks]); r[1] = bfhi(cur.kb[ks]);
#pragma unroll
            for (int q = 0; q < 4; ++q) { r[2 + 2 * q] = bflo(cur.kc[ks][q]); r[3 + 2 * q] = bfhi(cur.kc[ks][q]); }
            r[10] = bflo(cur.ka[ks]); r[11] = bfhi(cur.ka[ks]);
            float o[8];
#pragma unroll
            for (int j = 0; j < 8; ++j) { float a = 0.f;
#pragma unroll
                for (int t = 0; t < 5; ++t) a = fmaf(cwt[t], r[j + t], a);
                a = a * __builtin_amdgcn_rcpf(1.0f + __expf(-a)); o[j] = a * 0.08838834764831845f * (j < 4 ? wa[j] : wb[j - 4]); }
            u32x4 pw; pw.x = pk2(o[0], o[1]); pw.y = pk2(o[2], o[3]); pw.z = pk2(o[4], o[5]); pw.w = pk2(o[6], o[7]);
            afr[ks] = __builtin_bit_cast(bf16x8, pw);
        }
        asm volatile("" ::: "memory");
        CN = CN * decay;
#pragma unroll
        for (int nt = 0; nt < 8; ++nt) { C[nt] = C[nt] * decay; C[nt] = MFMA16(afr[0], vv[nt][0], C[nt]); C[nt] = MFMA16(afr[1], vv[nt][1], C[nt]); }
        CN = MFMA16(afr[0], ones, CN); CN = MFMA16(afr[1], ones, CN);
        mrun = mn; cur = nxt;
    }
}

__device__ __forceinline__ void tile_par(int T, int f, int r, int L0, int& R, int& Lb, int& dsh) {
    if (T < 10) { dsh = 4; R = r; Lb = L0 - 64 + 16 * T + 4 * f; }
    else if (T < 22) { dsh = 2; R = 4 * f + (r & 3); Lb = L0 - 16 + 4 * (T - 10); }
    else { const int xx = T - 22; dsh = 0; R = 4 * (xx & 3) + f; Lb = L0 - 4 + 4 * (xx >> 2); }
}
template <int LIM> __device__ __forceinline__ void attn_step(f32x4 (&O)[4], float& mrun, float& lsum, const bf16x8 (&qf)[2], const bf16x8 k00, const bf16x8 k01, const bf16x8 k10, const bf16x8 k11,
                                                             const u32x2 (&v0)[4], const u32x2 (&v1)[4], int D0, int D1, bool ok0, bool ok1) {
    const f32x4 z4 = {0.f, 0.f, 0.f, 0.f};
    f32x4 s0 = MFMA16(k00, qf[0], z4); s0 = MFMA16(k01, qf[1], s0);
    f32x4 s1 = MFMA16(k10, qf[0], z4); s1 = MFMA16(k11, qf[1], s1);
    bool va[4], vb[4];
#pragma unroll
    for (int j = 0; j < 4; ++j) { va[j] = ok0 && ((unsigned)(D0 + 16 * j) <= (unsigned)(2 * LIM)); vb[j] = ok1 && ((unsigned)(D1 + 16 * j) <= (unsigned)(2 * LIM));
        s0[j] = va[j] ? s0[j] : -1e30f; s1[j] = vb[j] ? s1[j] : -1e30f; }
    float tm = fmaxf(fmaxf(fmaxf(s0[0], s0[1]), fmaxf(s0[2], s0[3])), fmaxf(fmaxf(s1[0], s1[1]), fmaxf(s1[2], s1[3])));
    tm = fmaxf(tm, __shfl_xor(tm, 16)); tm = fmaxf(tm, __shfl_xor(tm, 32));
    const float mn = fmaxf(mrun, tm);
    if (__any(mn > mrun)) { const float sc = __builtin_amdgcn_exp2f(mrun - mn); lsum *= sc;
#pragma unroll
        for (int d = 0; d < 4; ++d) O[d] = O[d] * sc; }
    mrun = mn;
    float pv[8]; float ps = 0.f;
#pragma unroll
    for (int j = 0; j < 4; ++j) { pv[j] = va[j] ? __builtin_amdgcn_exp2f(s0[j] - mn) : 0.f; pv[4 + j] = vb[j] ? __builtin_amdgcn_exp2f(s1[j] - mn) : 0.f; ps += pv[j] + pv[4 + j]; }
    lsum += ps;
    u32x4 pw; pw.x = pk2(pv[0], pv[1]); pw.y = pk2(pv[2], pv[3]); pw.z = pk2(pv[4], pv[5]); pw.w = pk2(pv[6], pv[7]);
    const bf16x8 pb = __builtin_bit_cast(bf16x8, pw);
#pragma unroll
    for (int d = 0; d < 4; ++d) { u32x4 vw; vw.x = v0[d].x; vw.y = v0[d].y; vw.z = v1[d].x; vw.w = v1[d].y; O[d] = MFMA16(__builtin_bit_cast(bf16x8, vw), pb, O[d]); }
}
#define KLD(ptr, lo, hi) do { lo = *(const bf16x8*)(ptr); hi = *(const bf16x8*)((ptr) + 32); } while (0)
#define VLD(ptr, v) do { _Pragma("unroll") for (int d_ = 0; d_ < 4; ++d_) v[d_] = *(const u32x2*)((ptr) + d_ * 64); } while (0)
__device__ __forceinline__ void attn_pair(const Params& p, int b, int h, int p0, int r0, int lane) {
    const int fr = lane & 15, fq = lane >> 4, fK = fr >> 2, jK = fr & 3; const int L0 = p0 >> 4;
    const f32x4 z4 = {0.f, 0.f, 0.f, 0.f};
    bf16* Yrow[2]; bf16x8 qf[2][2]; f32x4 O[2][4]; float mrun[2], lsum[2];
    const bf16* Kb = (const bf16*)(p.ws + WS_AK) + (ptrdiff_t)b * SEQ * 512 + h * 64 + 8 * fq;
    const bf16* Vb = (const bf16*)(p.ws + WS_VT16) + (ptrdiff_t)(b * 8 + h) * 131072 + fr * 4;
#pragma unroll
    for (int u = 0; u < 2; ++u) { const int pq = p0 + 16 * fr + r0 + 4 * u; Yrow[u] = (bf16*)(p.ws + WS_Y) + ((size_t)(b * SEQ + pq)) * 1024 + 512 + h * 64;
        qf[u][0] = *(const bf16x8*)(Yrow[u] + 8 * fq); qf[u][1] = *(const bf16x8*)(Yrow[u] + 32 + 8 * fq); mrun[u] = -1e30f; lsum[u] = 0.f;
#pragma unroll
        for (int d = 0; d < 4; ++d) O[u][d] = z4; }
    {
        const bf16* kp = Kb + (ptrdiff_t)(16 * (L0 - 64 + 4 * fK + jK) + r0) * 512;
        const bf16* vp = Vb + (ptrdiff_t)(r0 * 32 + (L0 >> 2) - 16 + fq) * 256;
        for (int pp = 0; pp < 5; ++pp) { const int T0 = 2 * pp; const int lq = L0 - 64 + 16 * T0;
            if (lq + 31 < 0 || lq >= 128) continue;
            const int D0 = 16 * (-64 + 16 * T0 + 4 * fq - fr) + 1024; const bool ok0 = (unsigned)(lq + 4 * fq) < 128u, ok1 = (unsigned)(lq + 16 + 4 * fq) < 128u;
            const bf16* k0p = kp + (ptrdiff_t)T0 * 256 * 512; const bf16* v0p = vp + (ptrdiff_t)T0 * 4 * 256;
#pragma unroll
            for (int u = 0; u < 2; ++u) { bf16x8 k00, k01, k10, k11; u32x2 v0[4], v1[4];
                KLD(k0p + u * 4 * 512, k00, k01); VLD(v0p + u * 4 * 32 * 256, v0);
                if (pp < 4) { KLD(k0p + u * 4 * 512 + 256 * 512, k10, k11); VLD(v0p + u * 4 * 32 * 256 + 4 * 256, v1); }
                else { k10 = k00; k11 = k01;
#pragma unroll
                    for (int d_ = 0; d_ < 4; ++d_) v1[d_] = v0[d_]; }
                attn_step<1024>(O[u], mrun[u], lsum[u], qf[u], k00, k01, k10, k11, v0, v1, D0, D0 + 256, ok0, ok1 && (pp < 4)); }
        }
    }
    {
        const bf16* kp = Kb + (ptrdiff_t)(16 * (L0 - 16 + jK) + 4 * fK + (r0 & 3)) * 512;
        const bf16* vp = Vb + (ptrdiff_t)((4 * fq + (r0 & 3)) * 32 + (L0 >> 2) - 4) * 256;
        for (int pp = 0; pp < 6; ++pp) { const int T0 = 2 * pp; const int lb = L0 - 16 + 4 * T0;
            const bool ok0 = (unsigned)lb < 128u, ok1 = (unsigned)(lb + 4) < 128u; if (!ok0 && !ok1) continue;
            const int D0 = 16 * (-16 + 4 * T0 - fr) + 4 * fq - (r0 & ~3) + 256;
            const bf16* k0p = kp + (ptrdiff_t)T0 * 64 * 512; const bf16* v0p = vp + (ptrdiff_t)T0 * 256;
            { bf16x8 k00, k01, k10, k11; u32x2 v0[4], v1[4];
                KLD(k0p, k00, k01); KLD(k0p + 64 * 512, k10, k11); VLD(v0p, v0); VLD(v0p + 256, v1);
                attn_step<256>(O[0], mrun[0], lsum[0], qf[0], k00, k01, k10, k11, v0, v1, D0, D0 + 64, ok0, ok1);
                attn_step<256>(O[1], mrun[1], lsum[1], qf[1], k00, k01, k10, k11, v0, v1, D0 - 4, D0 + 60, ok0, ok1); }
        }
    }
#pragma unroll
    for (int u = 0; u < 2; ++u) { float l2 = lsum[u]; l2 += __shfl_xor(l2, 16); l2 += __shfl_xor(l2, 32); const int pq = p0 + 16 * fr + r0 + 4 * u; const size_t qrow = (size_t)(b * SEQ + pq);
        const float* ml = (const float*)(p.ws + WS_P1ML) + (qrow * 8 + h) * 2; const float m1 = ml[0], l1 = ml[1];
        const float m = fmaxf(mrun[u], m1); const float a2 = __builtin_amdgcn_exp2f(mrun[u] - m), a1 = __builtin_amdgcn_exp2f(m1 - m) * l1; const float rden = 1.0f / (l2 * a2 + a1);
        const bf16* o1p = (const bf16*)(p.ws + WS_P1O) + qrow * 512 + h * 64 + 4 * fq;
#pragma unroll
        for (int d = 0; d < 4; ++d) { const u32x2 ow = *(const u32x2*)(o1p + 16 * d); u32x2 w;
            w.x = pk2((O[u][d][0] * a2 + bflo(ow.x) * a1) * rden, (O[u][d][1] * a2 + bfhi(ow.x) * a1) * rden); w.y = pk2((O[u][d][2] * a2 + bflo(ow.y) * a1) * rden, (O[u][d][3] * a2 + bfhi(ow.y) * a1) * rden);
            *(u32x2*)(Yrow[u] + 16 * d + 4 * fq) = w; } }
}
__device__ __forceinline__ void attn_quad_d1(const Params& p, int b, int h, int L, int lane) {
    const int fr = lane & 15, fq = lane >> 4, fK = fr >> 2, jK = fr & 3;
    const f32x4 z4 = {0.f, 0.f, 0.f, 0.f};
    bf16x8 qf[4][2]; f32x4 O[4][4]; float mrun[4], lsum[4];
    const bf16* Kb = (const bf16*)(p.ws + WS_AK) + (ptrdiff_t)b * SEQ * 512 + h * 64 + 8 * fq;
    const bf16* Vb = (const bf16*)(p.ws + WS_VT16) + (ptrdiff_t)(b * 8 + h) * 131072 + fr * 4;
#pragma unroll
    for (int i = 0; i < 4; ++i) { const bf16* qrow = (const bf16*)(p.ws + WS_Y) + ((size_t)(b * SEQ + 16 * (L + i) + fr)) * 1024 + 512 + h * 64;
        qf[i][0] = *(const bf16x8*)(qrow + 8 * fq); qf[i][1] = *(const bf16x8*)(qrow + 32 + 8 * fq); mrun[i] = -1e30f; lsum[i] = 0.f;
#pragma unroll
        for (int d = 0; d < 4; ++d) O[i][d] = z4; }
    const bf16* kp = Kb + (ptrdiff_t)(16 * (L - 4 + jK) + fK) * 512;
    const bf16* vp = Vb + (ptrdiff_t)(fq * 32 + (L >> 2) - 1) * 256;
    for (int kb = 0; kb < 3; ++kb) { const int lb = L - 4 + 4 * kb; if ((unsigned)lb >= 128u) continue;
#pragma unroll
        for (int th = 0; th < 2; ++th) { const int t0 = 2 * th;
            const int D0 = 16 * (-4 + 4 * kb) + 4 * t0 + fq - fr + 64;
            const bf16* k0p = kp + (ptrdiff_t)(64 * kb + 4 * t0) * 512; const bf16* v0p = vp + (ptrdiff_t)(128 * t0 + kb) * 256;
            bf16x8 k00, k01, k10, k11; u32x2 v0[4], v1[4];
            KLD(k0p, k00, k01); KLD(k0p + 4 * 512, k10, k11); VLD(v0p, v0); VLD(v0p + 128 * 256, v1);
#pragma unroll
            for (int i = 0; i < 4; ++i) { attn_step<64>(O[i], mrun[i], lsum[i], qf[i], k00, k01, k10, k11, v0, v1, D0 - 16 * i, D0 - 16 * i + 4, true, true); if (i & 1) __builtin_amdgcn_sched_barrier(0); } }
    }
#pragma unroll
    for (int i = 0; i < 4; ++i) { float l = lsum[i]; l += __shfl_xor(l, 16); l += __shfl_xor(l, 32); const float rl = 1.0f / l; const size_t qrow = (size_t)(b * SEQ + 16 * (L + i) + fr);
        bf16* o1p = (bf16*)(p.ws + WS_P1O) + qrow * 512 + h * 64 + 4 * fq;
#pragma unroll
        for (int d = 0; d < 4; ++d) { u32x2 w; w.x = pk2(O[i][d][0] * rl, O[i][d][1] * rl); w.y = pk2(O[i][d][2] * rl, O[i][d][3] * rl); *(u32x2*)(o1p + 16 * d) = w; }
        if (fq == 0) { float* ml = (float*)(p.ws + WS_P1ML) + (qrow * 8 + h) * 2; ml[0] = mrun[i]; ml[1] = l; } }
}
constexpr int QS_OFF = 0, KS_OFF = 17408, PF_OFF = 34816, PB_OFF = 44032, FL_OFF = 53248, QPITCH = 272, PPITCH = 144;
__device__ __forceinline__ void mout_unit(const Params& p, int layer, int u, LAS unsigned char* lds, int tid, int wave, int lane) {
    const int b = u >> 7, hh = (u >> 5) & 3, pc = u & 31, tok0 = pc * 64;
    const int fr = lane & 15, fq = lane >> 4;
    LAS float* FL = (LAS float*)(lds + FL_OFF);
    const float* Gp = (const float*)(p.ws + WS_G) + (size_t)(b * SEQ + tok0) * 16;
    const float* Mst = (const float*)(p.ws + WS_MST); const float* Nst = (const float*)(p.ws + WS_N);
    const bf16* Ct = (const bf16*)p.out;
    const size_t sid0 = (size_t)((b * 4 + hh) * 2 + 0) * 32 + pc, sid1 = (size_t)((b * 4 + hh) * 2 + 1) * 32 + pc;
    bf16x8 vaf[2], caf[2][4];
    { const bf16* Vr = (const bf16*)(p.ws + WS_VTM) + ((size_t)((b * 4 + hh) * 128 + 16 * wave + fr)) * SEQ + tok0;
#pragma unroll
      for (int ks = 0; ks < 2; ++ks) vaf[ks] = __builtin_nontemporal_load((const bf16x8*)(Vr + 32 * ks + 8 * fq));
#pragma unroll
      for (int d = 0; d < 2; ++d) { const bf16* Cr = Ct + (d ? sid1 : sid0) * 16384 + (size_t)(16 * wave + fr) * 128;
#pragma unroll
          for (int kk = 0; kk < 4; ++kk) caf[d][kk] = __builtin_nontemporal_load((const bf16x8*)(Cr + 32 * kk + 8 * fq)); } }
    if (wave < 2) {
        const int dir = wave; const float li = Gp[lane * 16 + dir * 4 + hh], lf = Gp[lane * 16 + 8 + dir * 4 + hh];
        const float pre = wave_incl_scan_dpp(lf); const float total = __int_as_float(__builtin_amdgcn_readlane(__float_as_int(pre), 63));
        const float bt = dir ? (total - pre + lf) : pre; const float uu = li - bt;
        float pm;
        if (dir == 0) pm = wave_incl_max_dpp(uu); else pm = __shfl(wave_incl_max_dpp(__shfl(uu, 63 - lane)), 63 - lane);
        const float mprev = Mst[dir ? sid1 : sid0]; const float a = bt + mprev; const float mt = fmaxf(a, bt + pm);
        FL[(0 + 2 * dir) * 64 + lane] = bt - mt; FL[(1 + 2 * dir) * 64 + lane] = uu; FL[(4 + dir) * 64 + lane] = __expf(a - mt); FL[(6 + dir) * 64 + lane] = __expf(-mt);
    }
    {
        const bf16* QKm = (const bf16*)(p.ws + WS_QKM); const float* cwl = p.conv_w + (size_t)layer * 5 * 1024;
#pragma unroll
        for (int it4 = 0; it4 < 4; ++it4) { const int it = tid + it4 * NTHR; const int mat = it >> 10, rem = it & 1023, tok = rem >> 4, dg = rem & 15; const int col = mat * 512 + hh * 128 + 8 * dg;
            float a8[8];
#pragma unroll
            for (int j = 0; j < 8; ++j) a8[j] = 0.f;
#pragma unroll
            for (int t = 0; t < 5; ++t) { const int tt = tok0 + tok + t - 2;
                if (tt >= 0 && tt < SEQ) { const u32x4 xx = *(const u32x4*)(QKm + (size_t)(b * SEQ + tt) * 1024 + col);
                    const f32x4 w0 = *(const f32x4*)(cwl + t * 1024 + col), w1 = *(const f32x4*)(cwl + t * 1024 + col + 4);
                    a8[0] = fmaf(w0[0], bflo(xx.x), a8[0]); a8[1] = fmaf(w0[1], bfhi(xx.x), a8[1]); a8[2] = fmaf(w0[2], bflo(xx.y), a8[2]); a8[3] = fmaf(w0[3], bfhi(xx.y), a8[3]);
                    a8[4] = fmaf(w1[0], bflo(xx.z), a8[4]); a8[5] = fmaf(w1[1], bfhi(xx.z), a8[5]); a8[6] = fmaf(w1[2], bflo(xx.w), a8[6]); a8[7] = fmaf(w1[3], bfhi(xx.w), a8[7]); } }
            const float sc = mat ? 0.08838834764831845f : 1.0f;
#pragma unroll
            for (int j = 0; j < 8; ++j) a8[j] = a8[j] * __builtin_amdgcn_rcpf(1.0f + __expf(-a8[j])) * sc;
            u32x4 w; w.x = pk2(a8[0], a8[1]); w.y = pk2(a8[2], a8[3]); w.z = pk2(a8[4], a8[5]); w.w = pk2(a8[6], a8[7]);
            *(LAS u32x4*)(lds + (mat ? KS_OFF : QS_OFF) + tok * QPITCH + dg * 16) = w; }
    }
    __syncthreads();
    if (wave < 2) {
        const float* np = Nst + (wave ? sid1 : sid0) * 128; float acc = 0.f;
#pragma unroll
        for (int dg = 0; dg < 16; ++dg) { const u32x4 xx = *(const LAS u32x4*)(lds + QS_OFF + lane * QPITCH + dg * 16); const f32x4 n0 = *(const f32x4*)(np + 8 * dg), n1 = *(const f32x4*)(np + 8 * dg + 4);
            acc += bflo(xx.x) * n0[0] + bfhi(xx.x) * n0[1] + bflo(xx.y) * n0[2] + bfhi(xx.y) * n0[3] + bflo(xx.z) * n1[0] + bfhi(xx.z) * n1[1] + bflo(xx.w) * n1[2] + bfhi(xx.w) * n1[3]; }
        FL[(16 + wave) * 64 + lane] = acc;
    }
    {
        const int st = wave >> 1, tt0 = 2 * (wave & 1); const f32x4 z4 = {0.f, 0.f, 0.f, 0.f};
        bf16x8 ka[4];
#pragma unroll
        for (int ks = 0; ks < 4; ++ks) ka[ks] = *(const LAS bf16x8*)(lds + KS_OFF + (16 * st + fr) * QPITCH + (32 * ks + 8 * fq) * 2);
#pragma unroll
        for (int q = 0; q < 2; ++q) { const int t = 16 * (tt0 + q) + fr; f32x4 s = z4;
#pragma unroll
            for (int ks = 0; ks < 4; ++ks) { const bf16x8 qb = *(const LAS bf16x8*)(lds + QS_OFF + t * QPITCH + (32 * ks + 8 * fq) * 2); s = MFMA16(ka[ks], qb, s); }
            const float cf = FL[0 * 64 + t], cb = FL[2 * 64 + t]; float pf[4], pb[4]; float rf = 0.f, rb = 0.f;
#pragma unroll
            for (int j = 0; j < 4; ++j) { const int si = 16 * st + 4 * fq + j; const float uf = FL[1 * 64 + si], ub = FL[3 * 64 + si];
                pf[j] = (si <= t) ? s[j] * __expf(cf + uf) : 0.f; pb[j] = (si >= t) ? s[j] * __expf(cb + ub) : 0.f; rf += pf[j]; rb += pb[j]; }
            u32x2 w; w.x = pk2(pf[0], pf[1]); w.y = pk2(pf[2], pf[3]); *(LAS u32x2*)(lds + PF_OFF + t * PPITCH + (16 * st + 4 * fq) * 2) = w;
            w.x = pk2(pb[0], pb[1]); w.y = pk2(pb[2], pb[3]); *(LAS u32x2*)(lds + PB_OFF + t * PPITCH + (16 * st + 4 * fq) * 2) = w;
            rf += __shfl_xor(rf, 16); rf += __shfl_xor(rf, 32); rb += __shfl_xor(rb, 16); rb += __shfl_xor(rb, 32);
            if (fq == 0) { FL[(8 + st) * 64 + t] = rf; FL[(12 + st) * 64 + t] = rb; } }
    }
    __syncthreads();
    f32x4 aI[2][4], aX[2][4];
    {
        const f32x4 z4 = {0.f, 0.f, 0.f, 0.f};
#pragma unroll
        for (int d = 0; d < 2; ++d)
#pragma unroll
            for (int tt = 0; tt < 4; ++tt) { aI[d][tt] = z4; aX[d][tt] = z4; }
#pragma unroll
        for (int ks = 0; ks < 2; ++ks) { const bf16x8 va = vaf[ks];
#pragma unroll
            for (int tt = 0; tt < 4; ++tt) { const bf16x8 pfb = *(const LAS bf16x8*)(lds + PF_OFF + (16 * tt + fr) * PPITCH + (32 * ks + 8 * fq) * 2);
                const bf16x8 pbb = *(const LAS bf16x8*)(lds + PB_OFF + (16 * tt + fr) * PPITCH + (32 * ks + 8 * fq) * 2);
                aI[0][tt] = MFMA16(va, pfb, aI[0][tt]); aI[1][tt] = MFMA16(va, pbb, aI[1][tt]); } }
#pragma unroll
        for (int d = 0; d < 2; ++d) {
#pragma unroll
            for (int kk = 0; kk < 4; ++kk) { const bf16x8 ca = caf[d][kk];
#pragma unroll
                for (int tt = 0; tt < 4; ++tt) { const bf16x8 qb = *(const LAS bf16x8*)(lds + QS_OFF + (16 * tt + fr) * QPITCH + (32 * kk + 8 * fq) * 2); aX[d][tt] = MFMA16(ca, qb, aX[d][tt]); } } }
    }
    f32x4 hs[4];
#pragma unroll
    for (int tt = 0; tt < 4; ++tt) { const int t = 16 * tt + fr; const f32x4 z4 = {0.f, 0.f, 0.f, 0.f}; hs[tt] = z4;
#pragma unroll
        for (int d = 0; d < 2; ++d) { const float in = FL[(4 + d) * 64 + t]; const float den = ((FL[(8 + 4 * d) * 64 + t] + FL[(9 + 4 * d) * 64 + t]) + (FL[(10 + 4 * d) * 64 + t] + FL[(11 + 4 * d) * 64 + t])) + in * FL[(16 + d) * 64 + t];
            const float rd = 1.0f / fmaxf(fabsf(den), FL[(6 + d) * 64 + t]); hs[tt] += (aI[d][tt] + aX[d][tt] * in) * rd; }
        float sq = (hs[tt][0] * hs[tt][0] + hs[tt][1] * hs[tt][1]) + (hs[tt][2] * hs[tt][2] + hs[tt][3] * hs[tt][3]);
        sq += __shfl_xor(sq, 16); sq += __shfl_xor(sq, 32);
        if (fq == 0) FL[(18 + wave) * 64 + t] = sq; }
    __syncthreads();
    {
        const f32x4 hg = *(const f32x4*)(p.head_norm_g + layer * 512 + hh * 128 + 16 * wave + 4 * fq);
#pragma unroll
        for (int tt = 0; tt < 4; ++tt) { const int t = 16 * tt + fr; const float ssq = ((FL[18 * 64 + t] + FL[19 * 64 + t]) + (FL[20 * 64 + t] + FL[21 * 64 + t])) + ((FL[22 * 64 + t] + FL[23 * 64 + t]) + (FL[24 * 64 + t] + FL[25 * 64 + t])); const float rsd = rsqrtf(ssq * (1.0f / 128.0f) + 1e-6f);
            bf16* yp = (bf16*)(p.ws + WS_Y) + (size_t)(b * SEQ + tok0 + t) * 1024 + hh * 128 + 16 * wave + 4 * fq;
            const u32x2 gt = *(const u32x2*)yp;
            u32x2 w; w.x = pk2(hs[tt][0] * rsd * hg[0] * bflo(gt.x), hs[tt][1] * rsd * hg[1] * bfhi(gt.x)); w.y = pk2(hs[tt][2] * rsd * hg[2] * bflo(gt.y), hs[tt][3] * rsd * hg[3] * bfhi(gt.y));
            *(u32x2*)yp = w; }
    }
    __syncthreads();
}

#define XB_TMO      128
#define XB_XCNT(j)  (256  + 64 * (j))
#define XB_XSUB(j)  (1280 + 64 * (j))
#define XB_XGEN(j)  (2304 + 64 * (j))
#define XB_TOP      3328
#define XB_TOPGEN   3392
#define XCD_BAR_WORDS 3456
#define XB_SPIN_CAP (1u << 18)

__device__ __forceinline__ unsigned xb_ld(unsigned* p)              { return __hip_atomic_load(p, __ATOMIC_RELAXED, __HIP_MEMORY_SCOPE_AGENT); }
__device__ __forceinline__ unsigned xb_add(unsigned* p, unsigned v) { return __hip_atomic_fetch_add(p, v, __ATOMIC_RELAXED, __HIP_MEMORY_SCOPE_AGENT); }
__device__ __forceinline__ unsigned xb_xcc_id() { return (unsigned)__builtin_amdgcn_s_getreg((3 << 11) | 20) & 0xFu; }
#define XB_SPIN(cond, bar) do { unsigned _sp = 0; while (cond) { __builtin_amdgcn_s_sleep(1); \
    if ((++_sp & 255u) == 0u) { if (xb_ld(&(bar)[XB_TMO])) break; if (_sp > XB_SPIN_CAP) { atomicAdd(&(bar)[XB_TMO], 1u); break; } } } } while (0)

struct XcdBarrier {
    unsigned* bar; unsigned x;
    volatile LAS unsigned* st;
};

__device__ __forceinline__ XcdBarrier xcd_barrier_post(unsigned* bar, volatile LAS unsigned* st) {
    XcdBarrier b; b.bar = bar; b.x = xb_xcc_id(); b.st = st;
    if (threadIdx.x == 0) (void)xb_add(&bar[XB_XCNT(b.x)], 1u);
    return b;
}
__device__ __forceinline__ void xcd_barrier_complete(unsigned* bar, unsigned x, unsigned& nloc, unsigned& nx) {
    const unsigned G = gridDim.x * gridDim.y * gridDim.z;
    unsigned sum, cnt, mine, sp = 0u;
    for (;;) {
        sum = 0u; cnt = 0u; mine = 0u;
#pragma unroll
        for (unsigned j = 0; j < 16; ++j) { const unsigned c = xb_ld(&bar[XB_XCNT(j)]); sum += c; cnt += (c > 0u) ? 1u : 0u; mine = (j == x) ? c : mine; }
        if (sum == G) break;
        __builtin_amdgcn_s_sleep(1);
        if ((++sp & 255u) == 0u) { if (xb_ld(&bar[XB_TMO])) break; if (sp > XB_SPIN_CAP) { atomicAdd(&bar[XB_TMO], 1u); break; } }
    }
    nloc = mine > 0u ? mine : 1u; nx = cnt > 0u ? cnt : 1u;
}

__device__ __forceinline__ void xcd_barrier(const XcdBarrier& b) {
    asm volatile("s_waitcnt vmcnt(0)" ::: "memory");
    __syncthreads();
    if (threadIdx.x == 0) {
        unsigned* bar = b.bar;
        __builtin_amdgcn_s_waitcnt(0);
        unsigned nloc = b.st[0], nx = b.st[1];
        if (nloc == 0u) { xcd_barrier_complete(bar, b.x, nloc, nx); b.st[0] = nloc; b.st[1] = nx; }
        const unsigned old = xb_add(&bar[XB_XSUB(b.x)], 1u);
        const unsigned gen = old / nloc;
        if (old + 1u == (gen + 1u) * nloc) {
            __builtin_amdgcn_fence(__ATOMIC_RELEASE, "agent");
            asm volatile("s_waitcnt vmcnt(0)" ::: "memory");
            const unsigned og = xb_add(&bar[XB_TOP], 1u);
            const unsigned tg = og / nx;
            if (og + 1u == (tg + 1u) * nx) xb_add(&bar[XB_TOPGEN], 1u);
            else XB_SPIN(xb_ld(&bar[XB_TOPGEN]) == tg, bar);
            __builtin_amdgcn_fence(__ATOMIC_ACQUIRE, "agent");
            xb_add(&bar[XB_XGEN(b.x)], 1u);
            asm volatile("s_waitcnt vmcnt(0)" ::: "memory");
        } else {
            XB_SPIN(xb_ld(&bar[XB_XGEN(b.x)]) == gen, bar);
            __builtin_amdgcn_fence(__ATOMIC_ACQUIRE, "agent");
            asm volatile("s_waitcnt vmcnt(0)" ::: "memory");
        }
    }
    __syncthreads();
}

__global__ void __launch_bounds__(NTHR, 2) fwd_megakernel(Params p) {
    extern __shared__ __attribute__((aligned(16))) unsigned char lds_raw[];
    LAS unsigned char* lds = (LAS unsigned char*)lds_raw;
    cg::grid_group grid = cg::this_grid();
#define GRID_SYNC_CG() do { asm volatile("s_waitcnt vmcnt(0) lgkmcnt(0)" ::: "memory"); grid.sync(); \
        __builtin_amdgcn_fence(__ATOMIC_ACQUIRE, "agent"); asm volatile("s_waitcnt vmcnt(0)" ::: "memory"); __syncthreads(); } while (0)
#define GRID_SYNC() do { XcdBarrier xb_; xb_.bar = (unsigned*)(p.ws + WS_CTL); xb_.x = xb_xcc_id(); xb_.st = (volatile LAS unsigned*)(lds + LDS_MISC); xcd_barrier(xb_); } while (0)
    const int tid = threadIdx.x, lane = tid & 63, wave = __builtin_amdgcn_readfirstlane(tid >> 6), G = gridDim.x, bid = blockIdx.x;
    const int vcu = (G % 8 == 0) ? (bid % 8) * (G / 8) + bid / 8 : bid;
    float* ss = (float*)(p.ws + WS_SSP);
    { volatile LAS unsigned* st0 = (volatile LAS unsigned*)(lds + LDS_MISC); if (threadIdx.x < 2) st0[threadIdx.x] = 0u; __syncthreads(); }
    (void)xcd_barrier_post((unsigned*)(p.ws + WS_CTL), (volatile LAS unsigned*)(lds + LDS_MISC));
    bf16* xb = (bf16*)(p.ws + WS_XB);

    const bool defer = (G == 256);
    p0_prologue(p, lds, wave, lane, G, defer ? -1 : 2 * I_L);
    if (G == 0x7fffffff) GRID_SYNC_CG();
    GRID_SYNC();

    for (int layer = 0; layer < 2; ++layer) {
#define RELANE() int tid = threadIdx.x; asm volatile("" : "+v"(tid)); const int lane = tid & 63, wave = __builtin_amdgcn_readfirstlane(tid >> 6)
        {
            pg8::Gemm g{xb, (const bf16*)(p.ws + WS_WIN) + (size_t)layer * NINP * DM, MROWS, NINP, DM};
            pg8::StaticOrder S; S.init(MROWS, NINP, G, bid);
            pg8::EpiIn E{ss + (size_t)(2 * layer) * MROWS * 16, p.ws, p.gate_i_b + layer * 8, p.gate_f_b + layer * 8};
            static_assert(pg8::EpiIn::O_ROPE == WS_ROPE && pg8::EpiIn::O_G == WS_G && pg8::EpiIn::O_QKM == WS_QKM && pg8::EpiIn::O_KTM == WS_KTM && pg8::EpiIn::O_VTM == WS_VTM && pg8::EpiIn::O_AK == WS_AK && pg8::EpiIn::O_VT16 == WS_VT16 && pg8::EpiIn::O_Y == WS_Y, "ws map");
            pg8::gemm_phase<pg8::EpiIn, pg8::StaticOrder, true, true>(lds, g, S, E);
            if (defer && bid >= 192) { RELANE(); LAS float* scr = (LAS float*)(lds + wave * 16384);
                for (int it = layer * I_L + I_IN + I_OUT + (bid - 192) * NWAVE + wave; it < (layer + 1) * I_L; it += 64 * NWAVE) convert_item(p, it, scr, lane); }
        }
        GRID_SYNC();
        {
            RELANE();
            volatile LAS unsigned* ctr = (volatile LAS unsigned*)(lds + LDS_MISC + 16);
            if (tid == 0) *ctr = 0u;
            const int nU = (512 - vcu + G - 1) / G;
            const bool fast = (G * 2 == 512);
            if (fast && wave < 2) {
                __builtin_amdgcn_s_setprio(3);
                scan_wave(p, layer, vcu * 2 + wave, (LAS float*)(lds + wave * 256), lane, true);
                __builtin_amdgcn_s_setprio(0);
            } else {
                const int w0 = fast ? 2 : 0, nw = fast ? 6 : NWAVE;
                for (int I = wave - w0; I < 4 * nU; I += nw) { const int au = vcu + G * (I >> 2); const int b = au >> 6, h = (au >> 3) & 7, p0 = (au & 7) * 256;
                    attn_quad_d1(p, b, h, (p0 >> 4) + 4 * (I & 3), lane); }
                asm volatile("s_waitcnt vmcnt(0)" ::: "memory");
                __syncthreads();
                if (!fast && wave < 2) for (int sw = vcu * 2 + wave; sw < 512; sw += G * 2) scan_wave(p, layer, sw, (LAS float*)(lds + wave * 256), lane, false);
            }
            {
                const int nQ = 8 * nU;
                for (;;) { unsigned Q = 0; if (lane == 0) Q = atomicAdd((unsigned*)(lds_raw + LDS_MISC + 16), 1u); Q = (unsigned)__builtin_amdgcn_readfirstlane((int)Q);
                    if ((int)Q >= nQ) break;
                    const int au = vcu + G * (int)(Q >> 3); const int b = au >> 6, h = (au >> 3) & 7, p0 = (au & 7) * 256; attn_pair(p, b, h, p0, (int)((Q & 3) + 8 * ((Q >> 2) & 1)), lane); }
            }
        }
        GRID_SYNC();
        { RELANE(); for (int u = vcu; u < 1024; u += G) mout_unit(p, layer, u, lds, tid, wave, lane); }
        GRID_SYNC();
        {
            pg8::Gemm g{(const bf16*)(p.ws + WS_Y), (const bf16*)(p.ws + WS_WOUT) + (size_t)layer * DM * DM, MROWS, DM, DM};
            pg8::StaticOrder S; S.init(MROWS, DM, G, bid);
            pg8::EpiRes E{xb, ss + (size_t)(2 * layer + 1) * MROWS * 16};
            pg8::gemm_phase<pg8::EpiRes, pg8::StaticOrder, true, true>(lds, g, S, E);
        }
        GRID_SYNC();
        {
            pg8::Gemm g{xb, (const bf16*)(p.ws + WS_WUP) + (size_t)layer * FF * DM, MROWS, FF, DM};
            pg8::StaticOrder S; S.init(MROWS, FF, G, bid);
            pg8::EpiUp E{ss + (size_t)(2 * layer + 1) * MROWS * 16, (bf16*)(p.ws + WS_U)};
            pg8::gemm_phase<pg8::EpiUp, pg8::StaticOrder, true, true>(lds, g, S, E);
        }
        GRID_SYNC();
        {
            pg8::Gemm g{(const bf16*)(p.ws + WS_U), (const bf16*)(p.ws + WS_WDN) + (size_t)layer * DM * FF, MROWS, DM, FF};
            pg8::StaticOrder S; S.init(MROWS, DM, G, bid);
            pg8::EpiRes E{xb, ss + (size_t)(2 * layer + 2) * MROWS * 16};
            pg8::gemm_phase<pg8::EpiRes, pg8::StaticOrder, true, true>(lds, g, S, E);
        }
        GRID_SYNC();
    }
    {
        RELANE();
        const int gw = bid * NWAVE + wave, NGW = G * NWAVE;
        for (int m = gw; m < MROWS; m += NGW) { const float rsd = rsqrtf(pg8::row_ss(ss + (size_t)4 * MROWS * 16, m) * (1.0f / 1024.0f) + 1e-6f);
            const u32x2* xr = (const u32x2*)(xb + (size_t)m * DM) + lane; f32x4* orow = (f32x4*)(p.out + (size_t)m * DM) + lane; const f32x4* gr = (const f32x4*)p.final_g + lane;
#pragma unroll
            for (int j = 0; j < 4; ++j) { const u32x2 w = __builtin_nontemporal_load(xr + 64 * j); const f32x4 g4 = gr[64 * j]; f32x4 o; o[0] = bflo(w.x) * rsd * g4[0]; o[1] = bfhi(w.x) * rsd * g4[1]; o[2] = bflo(w.y) * rsd * g4[2]; o[3] = bfhi(w.y) * rsd * g4[3]; __builtin_nontemporal_store(o, orow + 64 * j); } }
    }
}

extern "C" void kernel_launch(void* const* d_in, const int* in_sizes, int n_in, void* d_out, int out_size, void* d_ws, size_t ws_size, hipStream_t stream) {
    static int grid = 0;
    if (grid == 0) {
        int dev = 0, cus = 0, per_cu = 0;
        (void)hipGetDevice(&dev);
        (void)hipDeviceGetAttribute(&cus, hipDeviceAttributeMultiprocessorCount, dev);
        (void)hipFuncSetAttribute((const void*)fwd_megakernel, hipFuncAttributeMaxDynamicSharedMemorySize, LDS_BYTES);
        (void)hipOccupancyMaxActiveBlocksPerMultiprocessor(&per_cu, (const void*)fwd_megakernel, NTHR, LDS_BYTES);
        if (per_cu < 1) per_cu = 1;
        grid = cus * per_cu;
        if (ws_size < WS_END) { fprintf(stderr, "kernel_launch: workspace too small (%zu)\n", ws_size); grid = -1; }
    }
    if (grid < 0) return;
    Params p{};
    p.x = (const float*)d_in[0]; p.norm1_g = (const float*)d_in[1]; p.w_in = (const float*)d_in[2]; p.conv_w = (const float*)d_in[3];
    p.gate_i_b = (const float*)d_in[4]; p.gate_f_b = (const float*)d_in[5]; p.head_norm_g = (const float*)d_in[6]; p.w_out = (const float*)d_in[7];
    p.norm2_g = (const float*)d_in[8]; p.w_up = (const float*)d_in[9]; p.w_down = (const float*)d_in[10]; p.final_g = (const float*)d_in[11];
    p.out = (float*)d_out; p.ws = (unsigned char*)d_ws;
    (void)hipMemsetAsync((char*)d_ws + WS_CTL, 0, CTL_BYTES, stream);
    void* args[] = {&p};
    hipError_t e = hipLaunchCooperativeKernel((void*)fwd_megakernel, dim3(grid), dim3(NTHR), args, LDS_BYTES, stream);
    if (e != hipSuccess) fprintf(stderr, "cooperative launch failed: %s (grid %d)\n", hipGetErrorString(e), grid);
}
```
